# Optimizing an MI355X kernel written in HIP

```python
import math
import jax, jax.numpy as jnp
from jax import lax
import numpy as np

D_MODEL = 2048
BATCH = 1
SEQ = 8192
DEPTH = 1
DEC_BATCH = 32
DEC_SEQ = 16
PAST_LEN = 1024

CHUNK = 64
ATT_HEADS = 8
QK_DIM = 64
V_DIM = 2 * QK_DIM
D_ATT = ATT_HEADS * V_DIM
QK_W = ATT_HEADS * 2 * QK_DIM
SSM_HEADS = 16
SSM_HEAD_DIM = 64
D_SSM = SSM_HEADS * SSM_HEAD_DIM
SSM_GROUPS = 2
SSM_STATE = 128
SSM_CONV = 4
SSD_CHUNK = CHUNK
CONV_DIM = D_SSM + 2 * SSM_GROUPS * SSM_STATE
D_MIX = D_ATT + D_SSM
IN_SPLITS = (QK_W, 2 * QK_W, 2 * QK_W + D_ATT, 2 * QK_W + D_ATT + D_SSM, 2 * QK_W + D_ATT + D_SSM + CONV_DIM)
D_IN_PROJ = 2 * QK_W + D_ATT + D_SSM + CONV_DIM + SSM_HEADS
D_FF = 5632
FFN_CONV = 3
Q_BLOCK = 128
DENSE_SWEEP_MIN_KEYS = 2048
EPS = 1e-6

kernel_name = 'hymba_diffattn_mamba2_convffn_stream_step'


def alibi_slopes():
    return jnp.asarray(2.0 ** (-8.0 * np.arange(1, ATT_HEADS + 1) / ATT_HEADS), dtype=jnp.float32)


def rmsnorm(x, g):
    xf = x.astype(jnp.float32)
    xf = xf * lax.rsqrt(jnp.mean(xf * xf, axis=-1, keepdims=True) + EPS)
    return (xf * g.astype(jnp.float32)).astype(x.dtype)


def causal_dwconv(x, prev, w, b):
    width = w.shape[0]
    length = x.shape[1]
    xp = jnp.concatenate([prev.astype(x.dtype), x], axis=1)
    y = b
    for tap in range(width):
        y = y + xp[:, tap:tap + length] * w[tap]
    return y, xp[:, xp.shape[1] - (width - 1):]


def diff_attend(q, k, v, q_pos, k_pos, lam):
    s = jnp.einsum('bqhmd,bkhmd->bhmqk', q, k).astype(jnp.float32) * (QK_DIM ** -0.5)
    dist = jnp.abs(q_pos[:, None] - k_pos[None, :]).astype(jnp.float32)
    s = s - (alibi_slopes()[:, None, None] * dist)[None, :, None]
    visible = (k_pos // CHUNK)[None, :] <= (q_pos // CHUNK)[:, None]
    s = jnp.where(visible, s, -jnp.inf)
    p = jax.nn.softmax(s, axis=-1)
    a = p[:, :, 0] - lam * p[:, :, 1]
    return jnp.einsum('bhqk,bkhv->bqhv', a.astype(v.dtype), v)


def diff_attention(q, k, v, q_pos, k_pos, lam):
    bsz, lq = q.shape[:2]
    if lq % Q_BLOCK == 0 and k.shape[1] >= DENSE_SWEEP_MIN_KEYS:
        nb = lq // Q_BLOCK
        qb = jnp.swapaxes(q.reshape(bsz, nb, Q_BLOCK, ATT_HEADS, 2, QK_DIM), 0, 1)
        pb = q_pos.reshape(nb, Q_BLOCK)
        ob = lax.map(lambda qp: diff_attend(qp[0], k, v, qp[1], k_pos, lam), (qb, pb))
        return jnp.swapaxes(ob, 0, 1).reshape(bsz, lq, ATT_HEADS, V_DIM)
    return diff_attend(q, k, v, q_pos, k_pos, lam)


def ssd_scan(x, dt, a, bm, cm, h0, chunk):
    bsz, length, nh, hd = x.shape
    nc = length // chunk
    f32 = jnp.float32
    la = (dt.astype(f32) * a.astype(f32)).reshape(bsz, nc, chunk, nh)
    acum = jnp.cumsum(la, axis=2)
    xdt = (x.astype(f32) * dt.astype(f32)[..., None]).reshape(bsz, nc, chunk, nh, hd)
    bc = bm.astype(f32).reshape(bsz, nc, chunk, nh, -1)
    cc = cm.astype(f32).reshape(bsz, nc, chunk, nh, -1)
    tri = jnp.tril(jnp.ones((chunk, chunk), dtype=bool))
    seg = acum[:, :, :, None, :] - acum[:, :, None, :, :]
    decay_ts = jnp.exp(jnp.where(tri[None, None, :, :, None], seg, -jnp.inf))
    cb = jnp.einsum('bcthn,bcshn->bctsh', cc, bc)
    y_intra = jnp.einsum('bctsh,bcshp->bcthp', cb * decay_ts, xdt)
    decay_end = jnp.exp(acum[:, :, -1:, :] - acum)
    s_chunk = jnp.einsum('bcshn,bcsh,bcshp->bchpn', bc, decay_end, xdt)
    chunk_decay = jnp.exp(acum[:, :, -1, :])

    def step(h, inp):
        dec, s_c = inp
        return dec[:, :, None, None] * h + s_c, h

    h_last, h_prev = lax.scan(step, h0.astype(f32),
                              (jnp.swapaxes(chunk_decay, 0, 1), jnp.swapaxes(s_chunk, 0, 1)))
    h_prev = jnp.swapaxes(h_prev, 0, 1)
    y_inter = jnp.einsum('bcthn,bchpn,bcth->bcthp', cc, h_prev, jnp.exp(acum))
    y = (y_intra + y_inter).reshape(bsz, length, nh, hd)
    return y.astype(x.dtype), h_last.astype(h0.dtype)


def hybrid_layer(x, k_past, v_past, conv_prev, ssm_prev, ffn_prev,
                 norm_mix_g, w_in, lambda_q1, lambda_k1, lambda_q2, lambda_k2, attn_subln_g,
                 conv_w, conv_b, dt_bias, a_log, d_skip, ssm_norm_g, w_out,
                 norm_ffn_g, w_gate, w_up, ffn_conv_w, ffn_conv_b, w_down, lam_init):
    f32 = jnp.float32
    bsz, length, _ = x.shape
    past = k_past.shape[1]
    h = rmsnorm(x, norm_mix_g)
    proj = h @ w_in
    q, k_new, v_new, z, xbc, dt_raw = jnp.split(proj, IN_SPLITS, axis=-1)

    q = q.reshape(bsz, length, ATT_HEADS, 2, QK_DIM)
    k_new = k_new.reshape(bsz, length, ATT_HEADS, 2 * QK_DIM)
    v_new = v_new.reshape(bsz, length, ATT_HEADS, V_DIM)
    k_all = jnp.concatenate([k_past.astype(x.dtype), k_new], axis=1).reshape(bsz, past + length, ATT_HEADS, 2, QK_DIM)
    v_all = jnp.concatenate([v_past.astype(x.dtype), v_new], axis=1)
    q_pos = past + jnp.arange(length, dtype=jnp.int32)
    k_pos = jnp.arange(past + length, dtype=jnp.int32)
    lam = (jnp.exp(jnp.sum(lambda_q1.astype(f32) * lambda_k1.astype(f32)))
           - jnp.exp(jnp.sum(lambda_q2.astype(f32) * lambda_k2.astype(f32))) + lam_init)
    o = diff_attention(q, k_all, v_all, q_pos, k_pos, lam)
    o = (rmsnorm(o, attn_subln_g) * (1.0 - lam_init)).reshape(bsz, length, D_ATT)

    xbc, conv_new = causal_dwconv(xbc, conv_prev, conv_w, conv_b)
    xbc = jax.nn.silu(xbc)
    xs, bm, cm = jnp.split(xbc, (D_SSM, D_SSM + SSM_GROUPS * SSM_STATE), axis=-1)
    xs = xs.reshape(bsz, length, SSM_HEADS, SSM_HEAD_DIM)
    heads_per_group = SSM_HEADS // SSM_GROUPS
    bm = jnp.repeat(bm.reshape(bsz, length, SSM_GROUPS, SSM_STATE), heads_per_group, axis=2)
    cm = jnp.repeat(cm.reshape(bsz, length, SSM_GROUPS, SSM_STATE), heads_per_group, axis=2)
    dt = jax.nn.softplus((dt_raw + dt_bias).astype(f32))
    a = -jnp.exp(a_log.astype(f32))
    chunk = SSD_CHUNK if length % SSD_CHUNK == 0 else length
    y, ssm_new = ssd_scan(xs, dt, a, bm, cm, ssm_prev, chunk)
    y = (y + d_skip[:, None] * xs).reshape(bsz, length, D_SSM) * jax.nn.silu(z)
    y = rmsnorm(y.reshape(bsz, length, SSM_GROUPS, D_SSM // SSM_GROUPS),
                ssm_norm_g.reshape(SSM_GROUPS, D_SSM // SSM_GROUPS)).reshape(bsz, length, D_SSM)

    x = x + jnp.concatenate([o, y], axis=-1) @ w_out

    hf = rmsnorm(x, norm_ffn_g)
    gate, ffn_new = causal_dwconv(hf @ w_gate, ffn_prev, ffn_conv_w, ffn_conv_b)
    x = x + (jax.nn.silu(gate) * (hf @ w_up)) @ w_down
    return x, k_new, v_new, conv_new, ssm_new, ffn_new


def setup_inputs(seed: int = 0) -> dict:
    key = jax.random.key(seed)
    ks = jax.random.split(key, 32)
    f32 = jnp.float32

    def nrm(k, shape, scale):
        return scale * jax.random.normal(k, shape, f32)

    dt0 = jnp.exp(jax.random.uniform(ks[20], (DEPTH, SSM_HEADS), f32, math.log(1e-3), math.log(1e-1)))
    return {
        'x_prompt': nrm(ks[0], (BATCH, SEQ, D_MODEL), 1.0),
        'x_sample': nrm(ks[1], (DEC_BATCH, DEC_SEQ, D_MODEL), 1.0),
        'cache_k': nrm(ks[2], (DEPTH, DEC_BATCH, PAST_LEN, ATT_HEADS, 2 * QK_DIM), 1.0),
        'cache_v': nrm(ks[3], (DEPTH, DEC_BATCH, PAST_LEN, ATT_HEADS, V_DIM), 1.0),
        'state_ssm_conv': nrm(ks[4], (DEPTH, DEC_BATCH, SSM_CONV - 1, CONV_DIM), 1.0),
        'state_ssm': nrm(ks[5], (DEPTH, DEC_BATCH, SSM_HEADS, SSM_HEAD_DIM, SSM_STATE), 0.1),
        'state_ffn_conv': nrm(ks[6], (DEPTH, DEC_BATCH, FFN_CONV - 1, D_FF), 1.0),
        'norm_mix_g': 1.0 + nrm(ks[7], (DEPTH, D_MODEL), 0.02),
        'w_in': nrm(ks[8], (DEPTH, D_MODEL, D_IN_PROJ), D_MODEL ** -0.5),
        'lambda_q1': nrm(ks[9], (DEPTH, QK_DIM), 0.1),
        'lambda_k1': nrm(ks[10], (DEPTH, QK_DIM), 0.1),
        'lambda_q2': nrm(ks[11], (DEPTH, QK_DIM), 0.1),
        'lambda_k2': nrm(ks[12], (DEPTH, QK_DIM), 0.1),
        'attn_subln_g': 1.0 + nrm(ks[13], (DEPTH, V_DIM), 0.02),
        'conv_w': nrm(ks[14], (DEPTH, SSM_CONV, CONV_DIM), SSM_CONV ** -0.5),
        'conv_b': nrm(ks[15], (DEPTH, CONV_DIM), 0.01),
        'dt_bias': dt0 + jnp.log(-jnp.expm1(-dt0)),
        'a_log': jnp.log(jax.random.uniform(ks[16], (DEPTH, SSM_HEADS), f32, 1.0, 16.0)),
        'd_skip': 1.0 + nrm(ks[17], (DEPTH, SSM_HEADS), 0.02),
        'ssm_norm_g': 1.0 + nrm(ks[18], (DEPTH, D_SSM), 0.02),
        'w_out': nrm(ks[19], (DEPTH, D_MIX, D_MODEL), D_MIX ** -0.5),
        'norm_ffn_g': 1.0 + nrm(ks[21], (DEPTH, D_MODEL), 0.02),
        'w_gate': nrm(ks[22], (DEPTH, D_MODEL, D_FF), D_MODEL ** -0.5),
        'w_up': nrm(ks[23], (DEPTH, D_MODEL, D_FF), D_MODEL ** -0.5),
        'ffn_conv_w': nrm(ks[24], (DEPTH, FFN_CONV, D_FF), FFN_CONV ** -0.5),
        'ffn_conv_b': nrm(ks[25], (DEPTH, D_FF), 0.01),
        'w_down': nrm(ks[26], (DEPTH, D_FF, D_MODEL), D_FF ** -0.5),
        'norm_final_g': 1.0 + nrm(ks[27], (D_MODEL,), 0.02),
    }


def reference(x_prompt, x_sample, cache_k, cache_v, state_ssm_conv, state_ssm, state_ffn_conv,
              norm_mix_g, w_in, lambda_q1, lambda_k1, lambda_q2, lambda_k2, attn_subln_g,
              conv_w, conv_b, dt_bias, a_log, d_skip, ssm_norm_g, w_out,
              norm_ffn_g, w_gate, w_up, ffn_conv_w, ffn_conv_b, w_down, norm_final_g):
    bsz = x_prompt.shape[0]
    xp, xs = x_prompt, x_sample
    kp_l, vp_l, cp_l, sp_l, fp_l = [], [], [], [], []
    ks_l, vs_l, cs_l, ss_l, fs_l = [], [], [], [], []
    for layer in range(DEPTH):
        lam_init = 0.8 - 0.6 * math.exp(-0.3 * layer)
        weights = (norm_mix_g[layer], w_in[layer], lambda_q1[layer], lambda_k1[layer],
                   lambda_q2[layer], lambda_k2[layer], attn_subln_g[layer],
                   conv_w[layer], conv_b[layer], dt_bias[layer], a_log[layer], d_skip[layer],
                   ssm_norm_g[layer], w_out[layer], norm_ffn_g[layer], w_gate[layer], w_up[layer],
                   ffn_conv_w[layer], ffn_conv_b[layer], w_down[layer])
        xp, kp, vp, cp, sp, fp = hybrid_layer(
            xp,
            jnp.zeros((bsz, 0, ATT_HEADS, 2 * QK_DIM), xp.dtype),
            jnp.zeros((bsz, 0, ATT_HEADS, V_DIM), xp.dtype),
            jnp.zeros((bsz, SSM_CONV - 1, CONV_DIM), xp.dtype),
            jnp.zeros((bsz, SSM_HEADS, SSM_HEAD_DIM, SSM_STATE), state_ssm.dtype),
            jnp.zeros((bsz, FFN_CONV - 1, D_FF), xp.dtype),
            *weights, lam_init)
        xs, k_s, v_s, c_s, s_s, f_s = hybrid_layer(
            xs, cache_k[layer], cache_v[layer], state_ssm_conv[layer], state_ssm[layer],
            state_ffn_conv[layer], *weights, lam_init)
        kp_l.append(kp); vp_l.append(vp); cp_l.append(cp); sp_l.append(sp); fp_l.append(fp)
        ks_l.append(k_s); vs_l.append(v_s); cs_l.append(c_s); ss_l.append(s_s); fs_l.append(f_s)
    y_prompt = rmsnorm(xp, norm_final_g)
    y_sample = rmsnorm(xs, norm_final_g)
    return (y_prompt, y_sample,
            jnp.stack(kp_l), jnp.stack(vp_l), jnp.stack(cp_l), jnp.stack(sp_l), jnp.stack(fp_l),
            jnp.stack(ks_l), jnp.stack(vs_l), jnp.stack(cs_l), jnp.stack(ss_l), jnp.stack(fs_l))
```

```cpp
#include <hip/hip_runtime.h>
#include <hip/hip_bf16.h>
#include <cstdio>
#include <cstdint>

#ifndef MK_N_LAUNCHES
#define MK_N_LAUNCHES 1
#endif

namespace pg8 {
#define PG8_LAS __attribute__((address_space(3)))
typedef unsigned short bf16_t;
typedef short bf16x8 __attribute__((ext_vector_type(8)));
typedef float f32x4 __attribute__((ext_vector_type(4)));
typedef unsigned u32x4 __attribute__((ext_vector_type(4)));
constexpr int BM = 256, BK = 64, HALF = 128, HTB = HALF * BK * 2, STAGE_BYTES = 8 * HTB, NXCD = 8, WGM = 8;

__host__ __device__ __forceinline__ int lds_byte(int r, int c) { const int st = (r >> 4) * 2 + (c >> 5), rr = r & 15, cc = c & 31, ob = rr * 64 + cc * 2; return st * 1024 + (ob ^ (((ob >> 9) & 1) << 5)); }
__host__ __device__ __forceinline__ void stage_rc(int b, int& R, int& C) { const int st = b / 1024, sb = b % 1024, swz = sb ^ (((sb >> 9) & 1) << 5); R = (st >> 1) * 16 + swz / 64; C = (st & 1) * 32 + (swz % 64) / 2; }
__host__ __device__ __forceinline__ int perm32(int rho) { const int n = rho >> 4, i = rho & 15; return 8 * (i >> 2) + 4 * n + (i & 3); }

struct Unit { int pm, pn; };
struct Gemm { const bf16_t* A; const bf16_t* Bt; int M, N, K; };

struct StaticOrder {
    int nM, nN, nwg, G, c;
    __host__ __device__ void init(int M, int N, int G_, int c_) { nM = M / BM; nN = N / BM; nwg = nM * nN; G = G_; c = c_; }
    __host__ __device__ bool next(int i, Unit& u) const {
        const long L = (long)i * G + c; if (L >= nwg) return false;
        int wgid = (int)L; { const int q = nwg / NXCD, r = nwg % NXCD, xcd = wgid % NXCD, off = wgid / NXCD; wgid = (xcd < r ? xcd * (q + 1) : r * (q + 1) + (xcd - r) * q) + off; }
        const int nig = WGM * nN, gid = wgid / nig, fm = gid * WGM, gsz = (nM - fm) < WGM ? (nM - fm) : WGM;
        u.pm = fm + ((wgid % nig) % gsz); u.pn = (wgid % nig) / gsz; return true;
    }
    __device__ __forceinline__ void a_ready(const Unit&) const {}
    __device__ __forceinline__ void done(const Unit&) const {}
};

__device__ __forceinline__ unsigned cvt_pk_bf16(float lo, float hi) { unsigned r; asm volatile("v_cvt_pk_bf16_f32 %0, %1, %2" : "=v"(r) : "v"(lo), "v"(hi)); return r; }

template <class Epi, class Sched, bool ALIGN_EPI = false, bool SP2 = false>
__device__ __forceinline__ void gemm_phase(PG8_LAS unsigned char* lds, const Gemm g, const Sched& S, const Epi& E) {
    const int tid = threadIdx.x, wid = __builtin_amdgcn_readfirstlane(tid >> 6), lane = tid & 63, wr = wid >> 2, wc = wid & 3, fr = lane & 15, fq = lane >> 4;
    const int K = g.K, nt = K / BK;
    unsigned voffA[2], voffB[2];
#pragma unroll
    for (int i = 0; i < 2; ++i) { int R, C; stage_rc(tid * 16 + i * 8192, R, C); const int Rb = Epi::PERM ? ((R & ~31) + perm32(R & 31)) : R;
        voffA[i] = (unsigned)(R * K + C) * 2u; voffB[i] = (unsigned)(Rb * K + C) * 2u; }
    const size_t kstep = (size_t)(BK * 2);
    const size_t hstep = (size_t)HALF * K * 2;
    const size_t tstep = 2 * hstep;
    const unsigned ldsw = (unsigned)wid * 1024u;
    const int aoff = lds_byte(wr * 64 + fr, fq * 8), boff = lds_byte(wc * 32 + fr, fq * 8);
#define PG8_SA(b, h) (((b) * 2 + (h)) * HTB)
#define PG8_SB(b, h) ((4 + (b) * 2 + (h)) * HTB)
#define PG8_STAGE(bufoff, gbase, voff) do { _Pragma("unroll") for (int _i = 0; _i < 2; ++_i) \
        __builtin_amdgcn_global_load_lds((const unsigned*)((const char*)(gbase) + (voff)[_i]), (PG8_LAS unsigned*)(lds + (bufoff) + ldsw + _i * 8192), 16, 0, 0); } while (0)
#define PG8_LDA(dst, b, h) do { _Pragma("unroll") for (int m = 0; m < 4; ++m) _Pragma("unroll") for (int k = 0; k < 2; ++k) dst[m][k] = *(const PG8_LAS bf16x8*)(lds + PG8_SA(b, h) + aoff + m * 2048 + k * 1024); } while (0)
#define PG8_LDB(dst, b, h) do { _Pragma("unroll") for (int n = 0; n < 2; ++n) _Pragma("unroll") for (int k = 0; k < 2; ++k) dst[n][k] = *(const PG8_LAS bf16x8*)(lds + PG8_SB(b, h) + boff + n * 2048 + k * 1024); } while (0)
#define PG8_MMA(ai, bj, At, Bt) do { __builtin_amdgcn_s_setprio(1); _Pragma("unroll") for (int m = 0; m < 4; ++m) _Pragma("unroll") for (int n = 0; n < 2; ++n) _Pragma("unroll") for (int k = 0; k < 2; ++k) \
        acc[ai][bj][m][n] = __builtin_amdgcn_mfma_f32_16x16x32_bf16(Bt[n][k], At[m][k], acc[ai][bj][m][n], 0, 0, 0); __builtin_amdgcn_s_setprio(0); } while (0)
#define PG8_WAIT_V(n) asm volatile("s_waitcnt vmcnt(" #n ")" ::: "memory")
#define PG8_WAIT_L(n) asm volatile("s_waitcnt lgkmcnt(" #n ")" ::: "memory")
#define PG8_BAR __builtin_amdgcn_s_barrier()
#define PG8_SCHED __builtin_amdgcn_sched_barrier(0)
    Unit cur, nxt; int ui = 0;
    if (!S.next(0, cur)) return;
    f32x4 acc[2][2][4][2];
#pragma unroll
    for (int a = 0; a < 2; ++a)
#pragma unroll
        for (int b = 0; b < 2; ++b)
#pragma unroll
            for (int m = 0; m < 4; ++m)
#pragma unroll
                for (int n = 0; n < 2; ++n) acc[a][b][m][n] = (f32x4){0.f, 0.f, 0.f, 0.f};
    bf16x8 At[4][2], B0[2][2], B1[2][2];
    const char* cA = (const char*)g.A + (size_t)cur.pm * tstep; const char* cB = (const char*)g.Bt + (size_t)cur.pn * tstep;
    S.a_ready(cur);
    if constexpr (SP2) {
        PG8_STAGE(PG8_SB(0, 0), cB, voffB); PG8_STAGE(PG8_SB(0, 1), cB + hstep, voffB); PG8_STAGE(PG8_SA(0, 0), cA, voffA); PG8_STAGE(PG8_SA(0, 1), cA + hstep, voffA);
        if (wr == 1) PG8_BAR;
        PG8_WAIT_V(2); PG8_BAR;
        PG8_STAGE(PG8_SB(1, 0), cB + kstep, voffB); PG8_STAGE(PG8_SA(1, 0), cA + kstep, voffA); PG8_STAGE(PG8_SB(1, 1), cB + hstep + kstep, voffB);
        PG8_WAIT_V(6); PG8_BAR;
    } else {
        PG8_STAGE(PG8_SB(0, 0), cB, voffB); PG8_STAGE(PG8_SA(0, 0), cA, voffA); PG8_STAGE(PG8_SB(0, 1), cB + hstep, voffB); PG8_STAGE(PG8_SA(0, 1), cA + hstep, voffA);
        if (wr == 1) PG8_BAR;
        PG8_WAIT_V(4); PG8_BAR;
        PG8_STAGE(PG8_SB(1, 0), cB + kstep, voffB); PG8_STAGE(PG8_SA(1, 0), cA + kstep, voffA); PG8_STAGE(PG8_SB(1, 1), cB + hstep + kstep, voffB);
        PG8_WAIT_V(6); PG8_BAR;
    }
    for (;;) {
        const bool has_next = S.next(ui + 1, nxt);
        const char* nA = has_next ? (const char*)g.A + (size_t)nxt.pm * tstep : cA; const char* nB = has_next ? (const char*)g.Bt + (size_t)nxt.pn * tstep : cB;
        for (int t = 0; t < nt; t += 2) {
            const bool last = (t == nt - 2);
            const char* a1 = cA + (size_t)(t + 1) * kstep;
            const char* a2 = last ? nA : cA + (size_t)(t + 2) * kstep; const char* b2 = last ? nB : cB + (size_t)(t + 2) * kstep;
            const char* a3 = a2 + kstep; const char* b3 = b2 + kstep;
            if (last && has_next) S.a_ready(nxt);
            if constexpr (SP2) {
            PG8_LDB(B0, 0, 0); PG8_LDB(B1, 0, 1); PG8_SCHED; PG8_LDA(At, 0, 0); PG8_STAGE(PG8_SA(1, 1), a1 + hstep, voffA);
            PG8_WAIT_V(8); PG8_WAIT_L(0); PG8_BAR; PG8_MMA(0, 0, At, B0); PG8_MMA(0, 1, At, B1); PG8_BAR; PG8_SCHED;
            PG8_LDA(At, 0, 1); PG8_STAGE(PG8_SB(0, 0), b2, voffB); PG8_STAGE(PG8_SB(0, 1), b2 + hstep, voffB); PG8_STAGE(PG8_SA(0, 0), a2, voffA);
            PG8_WAIT_V(8); PG8_WAIT_L(0); PG8_BAR; PG8_MMA(1, 0, At, B0); PG8_MMA(1, 1, At, B1); PG8_BAR; PG8_SCHED;
            PG8_LDB(B0, 1, 0); PG8_LDB(B1, 1, 1); PG8_SCHED; PG8_LDA(At, 1, 0); PG8_STAGE(PG8_SA(0, 1), a2 + hstep, voffA);
            PG8_WAIT_V(8); PG8_WAIT_L(0); PG8_BAR; PG8_MMA(0, 0, At, B0); PG8_MMA(0, 1, At, B1); PG8_BAR; PG8_SCHED;
            PG8_LDA(At, 1, 1); PG8_STAGE(PG8_SB(1, 0), b3, voffB); PG8_STAGE(PG8_SB(1, 1), b3 + hstep, voffB); PG8_STAGE(PG8_SA(1, 0), a3, voffA);
            PG8_WAIT_V(8); PG8_WAIT_L(0); PG8_BAR; PG8_MMA(1, 0, At, B0); PG8_MMA(1, 1, At, B1); PG8_BAR; PG8_SCHED;
            } else {
            PG8_LDB(B0, 0, 0); PG8_SCHED; PG8_LDA(At, 0, 0); PG8_STAGE(PG8_SA(1, 1), a1 + hstep, voffA);
            PG8_WAIT_L(8); PG8_BAR; PG8_WAIT_L(0); PG8_MMA(0, 0, At, B0); PG8_BAR; PG8_SCHED;
            PG8_LDB(B1, 0, 1); PG8_STAGE(PG8_SB(0, 0), b2, voffB);
            PG8_BAR; PG8_WAIT_L(0); PG8_MMA(0, 1, At, B1); PG8_BAR;
            PG8_LDA(At, 0, 1); PG8_STAGE(PG8_SA(0, 0), a2, voffA);
            PG8_BAR; PG8_WAIT_L(0); PG8_MMA(1, 0, At, B0); PG8_BAR; PG8_SCHED;
            PG8_STAGE(PG8_SB(0, 1), b2 + hstep, voffB);
            PG8_WAIT_V(6); PG8_BAR; PG8_MMA(1, 1, At, B1); PG8_BAR;
            PG8_LDB(B0, 1, 0); PG8_SCHED; PG8_LDA(At, 1, 0); PG8_STAGE(PG8_SA(0, 1), a2 + hstep, voffA);
            PG8_WAIT_L(8); PG8_BAR; PG8_WAIT_L(0); PG8_MMA(0, 0, At, B0); PG8_BAR; PG8_SCHED;
            PG8_LDB(B1, 1, 1); PG8_STAGE(PG8_SB(1, 0), b3, voffB);
            PG8_BAR; PG8_WAIT_L(0); PG8_MMA(0, 1, At, B1); PG8_BAR;
            PG8_LDA(At, 1, 1); PG8_STAGE(PG8_SA(1, 0), a3, voffA);
            PG8_BAR; PG8_WAIT_L(0); PG8_MMA(1, 0, At, B0); PG8_BAR; PG8_SCHED;
            PG8_STAGE(PG8_SB(1, 1), b3 + hstep, voffB);
            PG8_WAIT_V(6); PG8_BAR; PG8_MMA(1, 1, At, B1); PG8_BAR;
            }
        }
        if constexpr (ALIGN_EPI) { if (wr == 0) PG8_BAR; }
        if constexpr (!Epi::AFTER_DRAIN) { E(acc, cur, wr, wc, fr, fq); S.done(cur); }
        if (!has_next) break;
#pragma unroll
        for (int a = 0; a < 2; ++a)
#pragma unroll
            for (int b = 0; b < 2; ++b)
#pragma unroll
                for (int m = 0; m < 4; ++m)
#pragma unroll
                    for (int n = 0; n < 2; ++n) acc[a][b][m][n] = (f32x4){0.f, 0.f, 0.f, 0.f};
        cur = nxt; cA = nA; cB = nB; ++ui;
        if constexpr (ALIGN_EPI) { if (wr == 1) PG8_BAR; }
    }
    PG8_WAIT_V(0);
    if constexpr (!ALIGN_EPI) { if (wr == 0) PG8_BAR; }
    PG8_BAR;
#undef PG8_SA
#undef PG8_SB
#undef PG8_STAGE
#undef PG8_LDA
#undef PG8_LDB
#undef PG8_MMA
#undef PG8_WAIT_V
#undef PG8_WAIT_L
#undef PG8_BAR
#undef PG8_SCHED
}
}

constexpr int NWAVES = 8;
constexpr int MP = 8192, MS = 512, MT = MP + MS;
constexpr int DM = 2048, NPROJ = 5632, DIN = 5648, DFF = 5632, NH = 8, NSH = 16;
constexpr int NCHUNK = 128 + 32;
constexpr float EPS = 1e-6f;
constexpr float LOG2E = 1.4426950408889634f;
constexpr float QSCALE = 0.125f * LOG2E;
constexpr float LAM_INIT = 0.2f;

constexpr size_t O_Y = 0, O_KP = 17825792, O_VP = 26214400, O_CP = 34603008, O_SP = 34607616, O_FP = 34738688,
                 O_KS = 34749952, O_VS = 35274240, O_CS = 35798528, O_SS = 35945984, O_FS = 40140288, O_END = 40500736;

constexpr size_t MiB = 1u << 20;
constexpr size_t WS_CTL = 0, CTL_ZERO_BYTES = 1 * MiB;
constexpr size_t WS_WIN = 2 * MiB, WS_WOUT = 24 * MiB, WS_WGU = 32 * MiB, WS_WDN = 76 * MiB, WS_XN = 98 * MiB;
constexpr size_t WS_Q = 132 * MiB, WS_K = 150 * MiB, WS_V = 168 * MiB, WS_Z = 186 * MiB, WS_XBC = 204 * MiB, WS_DT = 230 * MiB;
constexpr size_t WS_ACUM = 235 * MiB, WS_CD = 236 * MiB, WS_CB = 237 * MiB, WS_A2 = 243 * MiB, WS_SCH = 277 * MiB, WS_HPREV = 357 * MiB, WS_YP = 397 * MiB;
constexpr size_t WS_RS1 = 437 * MiB, WS_RS2 = 439 * MiB, WS_END = 441 * MiB;
constexpr size_t WS_HID = 132 * MiB, WS_G = 226 * MiB, WS_U = 320 * MiB;
static_assert(WS_U + (size_t)MT * DFF * 2 <= WS_RS1, "ffn overlay");
constexpr int CW_BAR = 4096;

constexpr int LDS_BYTES = 147456, LDSCTL_OFF = 146432;

#define GAS __attribute__((address_space(1)))
#define LAS __attribute__((address_space(3)))
typedef unsigned short bf16;
typedef unsigned v4u __attribute__((ext_vector_type(4)));
typedef unsigned v2u __attribute__((ext_vector_type(2)));
typedef float f32x4 __attribute__((ext_vector_type(4)));
typedef float f32x8 __attribute__((ext_vector_type(8)));
typedef float f32x16 __attribute__((ext_vector_type(16)));
typedef short bf16x8 __attribute__((ext_vector_type(8)));
typedef short s16x4 __attribute__((ext_vector_type(4)));
typedef GAS unsigned gu32;

__device__ __forceinline__ unsigned f2bf(float f) { unsigned u = __builtin_bit_cast(unsigned, f); return (u + 0x7fffu + ((u >> 16) & 1u)) >> 16; }
__device__ __forceinline__ unsigned pk2(float lo, float hi) { return pg8::cvt_pk_bf16(lo, hi); }
__device__ __forceinline__ float bf2f(unsigned short b) { return __builtin_bit_cast(float, (unsigned)b << 16); }
__device__ __forceinline__ float bflo(unsigned w) { return __builtin_bit_cast(float, w << 16); }
__device__ __forceinline__ float bfhi(unsigned w) { return __builtin_bit_cast(float, w & 0xffff0000u); }
__device__ __forceinline__ float wave_sum(float v) {
#pragma unroll
    for (int o = 1; o < 64; o <<= 1) v += __shfl_xor(v, o);
    return v;
}
__device__ __forceinline__ float siluf(float x) { return x / (1.f + __expf(-x)); }

#define XB_TMO      128
#define XB_XCNT(j)  (256  + 64 * (j))
#define XB_XSUB(j)  (1280 + 64 * (j))
#define XB_XGEN(j)  (2304 + 64 * (j))
#define XB_TOP      3328
#define XB_TOPGEN   3392
#define XCD_BAR_WORDS 3456
#define XB_SPIN_CAP (1u << 18)
__device__ __forceinline__ unsigned xb_ld(unsigned* p)              { return __hip_atomic_load(p, __ATOMIC_RELAXED, __HIP_MEMORY_SCOPE_AGENT); }
__device__ __forceinline__ unsigned xb_add(unsigned* p, unsigned v) { return __hip_atomic_fetch_add(p, v, __ATOMIC_RELAXED, __HIP_MEMORY_SCOPE_AGENT); }
__device__ __forceinline__ unsigned xb_xcc_id() { return (unsigned)__builtin_amdgcn_s_getreg((3 << 11) | 20) & 0xFu; }
#define XB_SPIN(cond, bar) do { unsigned _sp = 0; while (cond) { __builtin_amdgcn_s_sleep(1); \
    if ((++_sp & 255u) == 0u) { if (xb_ld(&(bar)[XB_TMO])) break; if (_sp > XB_SPIN_CAP) { atomicAdd(&(bar)[XB_TMO], 1u); break; } } } } while (0)
struct XcdBarrier { unsigned* bar; unsigned x; volatile LAS unsigned* st; };
__device__ __forceinline__ XcdBarrier xcd_barrier_post(unsigned* bar, volatile LAS unsigned* st) {
    XcdBarrier b; b.bar = bar; b.x = xb_xcc_id(); b.st = st;
    if (threadIdx.x == 0) (void)xb_add(&bar[XB_XCNT(b.x)], 1u);
    return b;
}
__device__ __forceinline__ void xcd_barrier_complete(unsigned* bar, unsigned x, unsigned& nloc, unsigned& nx) {
    const unsigned G = gridDim.x * gridDim.y * gridDim.z;
    unsigned sum, cnt, mine, sp = 0u;
    for (;;) {
        sum = 0u; cnt = 0u; mine = 0u;
#pragma unroll
        for (unsigned j = 0; j < 16; ++j) { const unsigned c = xb_ld(&bar[XB_XCNT(j)]); sum += c; cnt += (c > 0u) ? 1u : 0u; mine = (j == x) ? c : mine; }
        if (sum == G) break;
        __builtin_amdgcn_s_sleep(1);
        if ((++sp & 255u) == 0u) { if (xb_ld(&bar[XB_TMO])) break; if (sp > XB_SPIN_CAP) { atomicAdd(&bar[XB_TMO], 1u); break; } }
    }
    nloc = mine > 0u ? mine : 1u; nx = cnt > 0u ? cnt : 1u;
}
__device__ __forceinline__ void xcd_barrier(const XcdBarrier& b) {
    asm volatile("s_waitcnt vmcnt(0)" ::: "memory");
    __syncthreads();
    if (threadIdx.x == 0) {
        unsigned* bar = b.bar;
        __builtin_amdgcn_s_waitcnt(0);
        unsigned nloc = b.st[0], nx = b.st[1];
        if (nloc == 0u) { xcd_barrier_complete(bar, b.x, nloc, nx); b.st[0] = nloc; b.st[1] = nx; }
        const unsigned old = xb_add(&bar[XB_XSUB(b.x)], 1u);
        const unsigned gen = old / nloc;
        if (old + 1u == (gen + 1u) * nloc) {
            __builtin_amdgcn_fence(__ATOMIC_RELEASE, "agent");
            asm volatile("s_waitcnt vmcnt(0)" ::: "memory");
            const unsigned og = xb_add(&bar[XB_TOP], 1u);
            const unsigned tg = og / nx;
            if (og + 1u == (tg + 1u) * nx) xb_add(&bar[XB_TOPGEN], 1u);
            else XB_SPIN(xb_ld(&bar[XB_TOPGEN]) == tg, bar);
            __builtin_amdgcn_fence(__ATOMIC_ACQUIRE, "agent");
            xb_add(&bar[XB_XGEN(b.x)], 1u);
            asm volatile("s_waitcnt vmcnt(0)" ::: "memory");
        } else {
            XB_SPIN(xb_ld(&bar[XB_XGEN(b.x)]) == gen, bar);
            __builtin_amdgcn_fence(__ATOMIC_ACQUIRE, "agent");
            asm volatile("s_waitcnt vmcnt(0)" ::: "memory");
        }
    }
    __syncthreads();
}

struct Args {
    const float* in[28];
    float* out; unsigned char* ws;
    int ph_lo, ph_hi, li, pad;
};
enum { I_XP = 0, I_XS, I_CK, I_CV, I_SCONV, I_SSM, I_SFFN, I_GMIX, I_WIN, I_LQ1, I_LK1, I_LQ2, I_LK2, I_GSUB, I_CONVW, I_CONVB, I_DTB, I_ALOG, I_DSKIP,
       I_GSSM, I_WOUT, I_GFFN, I_WGATE, I_WUP, I_FCW, I_FCB, I_WDOWN, I_GFIN };

__device__ __forceinline__ void p0_transpose_item(const float* W, int ldw, int K, int k0, int n0, const float* g, bf16* WT, int rowbase, LAS float* scr, int lane) {
#pragma unroll 8
    for (int i = 0; i < 32; ++i) { const int kk = 2 * i + (lane >> 5); float v = W[(size_t)(k0 + kk) * ldw + n0 + (lane & 31)]; if (g) v *= g[k0 + kk]; scr[kk * 33 + (lane & 31)] = v; }
    asm volatile("s_waitcnt lgkmcnt(0)" ::: "memory");
    const int c = lane & 7;
#pragma unroll
    for (int j = 0; j < 4; ++j) { const int n = (lane >> 3) + 8 * j; const LAS float* s = scr + (8 * c) * 33 + n;
        v4u o; o.x = pk2(s[0 * 33], s[1 * 33]); o.y = pk2(s[2 * 33], s[3 * 33]); o.z = pk2(s[4 * 33], s[5 * 33]); o.w = pk2(s[6 * 33], s[7 * 33]);
        *(GAS v4u*)(WT + (size_t)(rowbase + n) * K + k0 + 8 * c) = o; }
    asm volatile("s_waitcnt lgkmcnt(0)" ::: "memory");
}

struct EpiInProj {
    static constexpr bool PERM = true, AFTER_DRAIN = false;
    bf16 *Q, *K, *V, *Z, *XBC; float* out;
    __device__ __forceinline__ void operator()(const pg8::f32x4 (&acc)[2][2][4][2], const pg8::Unit& u, int wr, int wc, int fr, int fq) const {
        const int region = u.pn >> 2;
        const int row0 = u.pm * 256 + wr * 64 + fr;
        const int cl = wc * 32 + 8 * fq;
#pragma unroll
        for (int ai = 0; ai < 2; ++ai)
#pragma unroll
            for (int m = 0; m < 4; ++m) {
                const int row = row0 + ai * 128 + m * 16;
#pragma unroll
                for (int bj = 0; bj < 2; ++bj) {
                    f32x4 v0 = acc[ai][bj][m][0], v1 = acc[ai][bj][m][1];
                    if (region < 4) {
                        const int c = (u.pn & 3) * 256 + bj * 128 + cl;
                        if (region == 0) { v0 = v0 * QSCALE; v1 = v1 * QSCALE; }
                        v4u w; w.x = pk2(v0[0], v0[1]); w.y = pk2(v0[2], v0[3]); w.z = pk2(v1[0], v1[1]); w.w = pk2(v1[2], v1[3]);
                        bf16* dst = region == 0 ? Q : region == 1 ? K : region == 2 ? V : Z;
                        *(v4u*)(dst + (size_t)row * 1024 + c) = w;
                        if (region == 1 || region == 2) {
                            float* o = out + (row < MP ? (region == 1 ? O_KP : O_VP) + (size_t)row * 1024 : (region == 1 ? O_KS : O_VS) + (size_t)(row - MP) * 1024) + c;
                            *(f32x4*)o = v0; *(f32x4*)(o + 4) = v1;
                        }
                    } else {
                        const int c = (u.pn - 16) * 256 + bj * 128 + cl;
                        v4u w; w.x = pk2(v0[0], v0[1]); w.y = pk2(v0[2], v0[3]); w.z = pk2(v1[0], v1[1]); w.w = pk2(v1[2], v1[3]);
                        *(v4u*)(XBC + (size_t)row * 1536 + c) = w;
                        if (row >= MP - 3) {
                            float* o = nullptr;
                            if (row < MP) o = out + O_CP + (size_t)(row - (MP - 3)) * 1536 + c;
                            else { const int rr = row - MP, i = rr & 15; if (i >= 13) o = out + O_CS + (size_t)((rr >> 4) * 3 + (i - 13)) * 1536 + c; }
                            if (o) { *(f32x4*)o = v0; *(f32x4*)(o + 4) = v1; }
                        }
                    }
                }
            }
    }
};

struct EpiOutProj {
    static constexpr bool PERM = true, AFTER_DRAIN = false;
    const float* xp; const float* xs; float* out; bf16* x1b; float* rs;
    __device__ __forceinline__ void operator()(const pg8::f32x4 (&acc)[2][2][4][2], const pg8::Unit& u, int wr, int wc, int fr, int fq) const {
        const int row0 = u.pm * 256 + wr * 64 + fr;
#pragma unroll
        for (int ai = 0; ai < 2; ++ai)
#pragma unroll
            for (int m = 0; m < 4; ++m) {
                const int row = row0 + ai * 128 + m * 16;
                const float* xr = row < MP ? xp + (size_t)row * DM : xs + (size_t)(row - MP) * DM;
                float ss = 0.f;
#pragma unroll
                for (int bj = 0; bj < 2; ++bj) {
                    const int c = u.pn * 256 + bj * 128 + wc * 32 + 8 * fq;
                    const f32x4 v0 = acc[ai][bj][m][0] + *(const f32x4*)(xr + c), v1 = acc[ai][bj][m][1] + *(const f32x4*)(xr + c + 4);
                    float* o = out + (size_t)row * DM + c; *(f32x4*)o = v0; *(f32x4*)(o + 4) = v1;
                    v4u w; w.x = pk2(v0[0], v0[1]); w.y = pk2(v0[2], v0[3]); w.z = pk2(v1[0], v1[1]); w.w = pk2(v1[2], v1[3]);
                    *(v4u*)(x1b + (size_t)row * DM + c) = w;
                    ss += (v0[0] * v0[0] + v0[1] * v0[1]) + (v0[2] * v0[2] + v0[3] * v0[3]) + (v1[0] * v1[0] + v1[1] * v1[1]) + (v1[2] * v1[2] + v1[3] * v1[3]);
                }
                ss += __shfl_xor(ss, 16); ss += __shfl_xor(ss, 32);
                if (fq == 0) rs[(size_t)row * 32 + u.pn * 4 + wc] = ss;
            }
    }
};

__device__ __forceinline__ float row_rstd(const float* rs, int row, int fq) {
    const f32x4 a = *(const f32x4*)(rs + (size_t)row * 32 + fq * 8), b = *(const f32x4*)(rs + (size_t)row * 32 + fq * 8 + 4);
    float t = (a[0] + a[1]) + (a[2] + a[3]) + (b[0] + b[1]) + (b[2] + b[3]);
    t += __shfl_xor(t, 16); t += __shfl_xor(t, 32);
    return 1.0f / sqrtf(t * (1.0f / DM) + EPS);
}

struct EpiGateUp {
    static constexpr bool PERM = true, AFTER_DRAIN = false;
    bf16 *G, *U; const float* rs; float* out;
    __device__ __forceinline__ void operator()(const pg8::f32x4 (&acc)[2][2][4][2], const pg8::Unit& u, int wr, int wc, int fr, int fq) const {
        const int row0 = u.pm * 256 + wr * 64 + fr;
        const int c = u.pn * 128 + wc * 32 + 8 * fq;
#pragma unroll
        for (int ai = 0; ai < 2; ++ai)
#pragma unroll
            for (int m = 0; m < 4; ++m) {
                const int row = row0 + ai * 128 + m * 16;
                const float rstd = row_rstd(rs, row, fq);
                const f32x4 g0 = acc[ai][0][m][0] * rstd, g1 = acc[ai][0][m][1] * rstd, u0 = acc[ai][1][m][0] * rstd, u1 = acc[ai][1][m][1] * rstd;
                v4u w; w.x = pk2(g0[0], g0[1]); w.y = pk2(g0[2], g0[3]); w.z = pk2(g1[0], g1[1]); w.w = pk2(g1[2], g1[3]);
                *(v4u*)(G + (size_t)row * DFF + c) = w;
                w.x = pk2(u0[0], u0[1]); w.y = pk2(u0[2], u0[3]); w.z = pk2(u1[0], u1[1]); w.w = pk2(u1[2], u1[3]);
                *(v4u*)(U + (size_t)row * DFF + c) = w;
                if (row >= MP - 2) {
                    float* o = nullptr;
                    if (row < MP) o = out + O_FP + (size_t)(row - (MP - 2)) * DFF + c;
                    else { const int rr = row - MP, i = rr & 15; if (i >= 14) o = out + O_FS + (size_t)((rr >> 4) * 2 + (i - 14)) * DFF + c; }
                    if (o) { *(f32x4*)o = g0; *(f32x4*)(o + 4) = g1; }
                }
            }
    }
};

struct EpiDown {
    static constexpr bool PERM = true, AFTER_DRAIN = false;
    float* out; float* rs;
    __device__ __forceinline__ void operator()(const pg8::f32x4 (&acc)[2][2][4][2], const pg8::Unit& u, int wr, int wc, int fr, int fq) const {
        const int row0 = u.pm * 256 + wr * 64 + fr;
#pragma unroll
        for (int ai = 0; ai < 2; ++ai)
#pragma unroll
            for (int m = 0; m < 4; ++m) {
                const int row = row0 + ai * 128 + m * 16;
                float ss = 0.f;
#pragma unroll
                for (int bj = 0; bj < 2; ++bj) {
                    const int c = u.pn * 256 + bj * 128 + wc * 32 + 8 * fq;
                    float* o = out + (size_t)row * DM + c;
                    const f32x4 v0 = acc[ai][bj][m][0] + *(const f32x4*)o, v1 = acc[ai][bj][m][1] + *(const f32x4*)(o + 4);
                    *(f32x4*)o = v0; *(f32x4*)(o + 4) = v1;
                    ss += (v0[0] * v0[0] + v0[1] * v0[1]) + (v0[2] * v0[2] + v0[3] * v0[3]) + (v1[0] * v1[0] + v1[1] * v1[1]) + (v1[2] * v1[2] + v1[3] * v1[3]);
                }
                ss += __shfl_xor(ss, 16); ss += __shfl_xor(ss, 32);
                if (fq == 0) rs[(size_t)row * 32 + u.pn * 4 + wc] = ss;
            }
    }
};

__device__ __forceinline__ int crow(int r, int hi) { return (r & 3) + 8 * (r >> 2) + 4 * hi; }
#define MFMA32(a, b, c) __builtin_amdgcn_mfma_f32_32x32x16_bf16((a), (b), (c), 0, 0, 0)

constexpr int SL_XT = 0, SL_XT_ROW = 144, SL_XT_HEAD = 64 * 144;
constexpr int SL_BN = 73728, SL_N_ROW = 272;
constexpr int SL_CN = SL_BN + 64 * 272;
constexpr int SL_BT = SL_CN + 64 * 272, SL_BT_ROW = 144;
constexpr int SL_DT = SL_BT + 128 * 144;
constexpr int SL_AC = SL_DT + 2048;
constexpr int SL_W = SL_AC + 2048;
constexpr int SL_END = SL_W + 2048;
static_assert(SL_END <= LDSCTL_OFF, "ssd lds");

struct SsdUnit { int cid, g, T, rbase, batch; };
__device__ __forceinline__ SsdUnit ssd_unit(int u) {
    SsdUnit s;
    if (u < 256) { s.cid = u >> 1; s.g = u & 1; s.T = 64; s.rbase = 64 * s.cid; s.batch = -1; }
    else { const int v = u - 256; s.batch = v >> 1; s.g = v & 1; s.cid = 128 + s.batch; s.T = 16; s.rbase = MP + 16 * s.batch; }
    return s;
}

__device__ __forceinline__ void ssd_local(const Args& A, LAS unsigned char* lds, int u) {
    const SsdUnit su = ssd_unit(u);
    const int tid = threadIdx.x, lane = tid & 63, wid = __builtin_amdgcn_readfirstlane(tid >> 6), r32 = lane & 31, hi = lane >> 5;
    unsigned char* ws = A.ws;
    const bf16* XBC = (const bf16*)(ws + WS_XBC);
    const float* DT = (const float*)(ws + WS_DT);
    if (tid < 384) {
        const int cg = tid % 96, tq = tid / 96, t0 = 16 * tq;
        int col; if (cg < 64) col = 512 * su.g + 8 * cg; else if (cg < 80) col = 1024 + 128 * su.g + 8 * (cg - 64); else col = 1280 + 128 * su.g + 8 * (cg - 80);
        const float* cw = A.in[I_CONVW]; const float* cbias = A.in[I_CONVB];
        float w0[8], w1[8], w2[8], w3[8], bb[8];
#pragma unroll
        for (int e = 0; e < 8; ++e) { w0[e] = cw[col + e]; w1[e] = cw[1536 + col + e]; w2[e] = cw[2 * 1536 + col + e]; w3[e] = cw[3 * 1536 + col + e]; bb[e] = cbias[col + e]; }
        float h0[8], h1[8], h2[8];
#pragma unroll
        for (int k = 0; k < 3; ++k) {
            const int t = t0 - 3 + k; float v[8];
            if (t >= 0 || (su.batch < 0 && su.cid > 0)) {
                const v4u raw = *(const v4u*)(XBC + (size_t)(su.rbase + t) * 1536 + col);
                v[0] = bflo(raw.x); v[1] = bfhi(raw.x); v[2] = bflo(raw.y); v[3] = bfhi(raw.y); v[4] = bflo(raw.z); v[5] = bfhi(raw.z); v[6] = bflo(raw.w); v[7] = bfhi(raw.w);
            } else if (su.batch >= 0) {
                const float* sp = A.in[I_SCONV] + ((size_t)su.batch * 3 + (3 + t)) * 1536 + col;
                const f32x4 a = *(const f32x4*)sp, b = *(const f32x4*)(sp + 4);
                v[0] = a[0]; v[1] = a[1]; v[2] = a[2]; v[3] = a[3]; v[4] = b[0]; v[5] = b[1]; v[6] = b[2]; v[7] = b[3];
            } else {
#pragma unroll
                for (int e = 0; e < 8; ++e) v[e] = 0.f;
            }
#pragma unroll
            for (int e = 0; e < 8; ++e) { if (k == 0) h0[e] = v[e]; else if (k == 1) h1[e] = v[e]; else h2[e] = v[e]; }
        }
        for (int tt = 0; tt < 16; ++tt) {
            const int t = t0 + tt; float o[8];
            if (t < su.T) {
                const v4u raw = *(const v4u*)(XBC + (size_t)(su.rbase + t) * 1536 + col);
                float v[8]; v[0] = bflo(raw.x); v[1] = bfhi(raw.x); v[2] = bflo(raw.y); v[3] = bfhi(raw.y); v[4] = bflo(raw.z); v[5] = bfhi(raw.z); v[6] = bflo(raw.w); v[7] = bfhi(raw.w);
#pragma unroll
                for (int e = 0; e < 8; ++e) { const float y = bb[e] + w0[e] * h0[e] + w1[e] * h1[e] + w2[e] * h2[e] + w3[e] * v[e]; o[e] = siluf(y); h0[e] = h1[e]; h1[e] = h2[e]; h2[e] = v[e]; }
            } else {
#pragma unroll
                for (int e = 0; e < 8; ++e) o[e] = 0.f;
            }
            if (cg < 64) {
                LAS unsigned short* xt = (LAS unsigned short*)(lds + SL_XT + (cg >> 3) * SL_XT_HEAD + (8 * (cg & 7)) * SL_XT_ROW + t * 2);
#pragma unroll
                for (int e = 0; e < 8; ++e) xt[e * (SL_XT_ROW / 2)] = (unsigned short)f2bf(o[e]);
            } else {
                v4u w; w.x = pk2(o[0], o[1]); w.y = pk2(o[2], o[3]); w.z = pk2(o[4], o[5]); w.w = pk2(o[6], o[7]);
                const int n0 = 8 * ((cg - 64) & 15);
                if (cg < 80) {
                    *(LAS v4u*)(lds + SL_BN + t * SL_N_ROW + n0 * 2) = w;
                    LAS unsigned short* bt = (LAS unsigned short*)(lds + SL_BT + n0 * SL_BT_ROW + t * 2);
#pragma unroll
                    for (int e = 0; e < 8; ++e) bt[e * (SL_BT_ROW / 2)] = (unsigned short)f2bf(o[e]);
                } else {
                    *(LAS v4u*)(lds + SL_CN + t * SL_N_ROW + n0 * 2) = w;
                    *(v4u*)((bf16*)(ws + WS_CB) + ((size_t)su.cid * 64 + t) * 256 + su.g * 128 + n0) = w;
                }
            }
        }
    }
    {
        const int h = 8 * su.g + wid;
        const float dt = lane < su.T ? DT[(size_t)(su.rbase + lane) * 16 + h] : 0.f;
        const float a = -__expf(A.in[I_ALOG][h]);
        float x = dt * a;
#pragma unroll
        for (int off = 1; off < 64; off <<= 1) { const float v = __shfl_up(x, off); if (lane >= off) x += v; }
        const float tot = __shfl(x, 63);
        LAS float* dl = (LAS float*)(lds + SL_DT) + wid * 64; LAS float* al = (LAS float*)(lds + SL_AC) + wid * 64; LAS float* wl = (LAS float*)(lds + SL_W) + wid * 64;
        dl[lane] = dt; al[lane] = x; wl[lane] = __expf(tot - x) * dt;
        ((float*)(ws + WS_ACUM))[((size_t)su.cid * 16 + h) * 64 + lane] = x;
        if (lane == 63) ((float*)(ws + WS_CD))[su.cid * 16 + h] = __expf(tot);
    }
    __syncthreads();
    {
        const int h = 8 * su.g + wid;
        const float dskip = A.in[I_DSKIP][h];
        const LAS unsigned char* bn = lds + SL_BN; const LAS unsigned char* cn = lds + SL_CN; const LAS unsigned char* bt = lds + SL_BT;
        const LAS unsigned char* xt = lds + SL_XT + wid * SL_XT_HEAD;
        const LAS float* dl = (const LAS float*)(lds + SL_DT) + wid * 64; const LAS float* al = (const LAS float*)(lds + SL_AC) + wid * 64; const LAS float* wl = (const LAS float*)(lds + SL_W) + wid * 64;
        f32x16 cb00 = {}, cb01 = {}, cb11 = {};
#pragma unroll
        for (int ks = 0; ks < 8; ++ks) {
            const int kb = (16 * ks + 8 * hi) * 2;
            const bf16x8 b0 = *(const LAS bf16x8*)(bn + r32 * SL_N_ROW + kb), b1 = *(const LAS bf16x8*)(bn + (32 + r32) * SL_N_ROW + kb);
            const bf16x8 c0 = *(const LAS bf16x8*)(cn + r32 * SL_N_ROW + kb), c1 = *(const LAS bf16x8*)(cn + (32 + r32) * SL_N_ROW + kb);
            cb00 = MFMA32(b0, c0, cb00); cb01 = MFMA32(b0, c1, cb01); cb11 = MFMA32(b1, c1, cb11);
        }
        const float at0 = al[r32], at1 = al[32 + r32];
        bf16x8 X00[2], X01[2], X11[2];
        {
            float m00[16], m01[16], m11[16];
#pragma unroll
            for (int r = 0; r < 16; ++r) {
                const int s0 = crow(r, hi), s1 = 32 + s0;
                const float as0 = al[s0], as1 = al[s1], ds0 = dl[s0], ds1 = dl[s1];
                float v = (s0 <= r32) ? cb00[r] * __expf(at0 - as0) * ds0 : 0.f; if (s0 == r32) v += dskip; m00[r] = v;
                m01[r] = cb01[r] * __expf(at1 - as0) * ds0;
                v = (s0 <= r32) ? cb11[r] * __expf(at1 - as1) * ds1 : 0.f; if (s0 == r32) v += dskip; m11[r] = v;
            }
#pragma unroll
            for (int sp = 0; sp < 2; ++sp) {
                v4u w;
                w.x = pk2(m00[8 * sp + 0], m00[8 * sp + 1]); w.y = pk2(m00[8 * sp + 2], m00[8 * sp + 3]); w.z = pk2(m00[8 * sp + 4], m00[8 * sp + 5]); w.w = pk2(m00[8 * sp + 6], m00[8 * sp + 7]); X00[sp] = __builtin_bit_cast(bf16x8, w);
                w.x = pk2(m01[8 * sp + 0], m01[8 * sp + 1]); w.y = pk2(m01[8 * sp + 2], m01[8 * sp + 3]); w.z = pk2(m01[8 * sp + 4], m01[8 * sp + 5]); w.w = pk2(m01[8 * sp + 6], m01[8 * sp + 7]); X01[sp] = __builtin_bit_cast(bf16x8, w);
                w.x = pk2(m11[8 * sp + 0], m11[8 * sp + 1]); w.y = pk2(m11[8 * sp + 2], m11[8 * sp + 3]); w.z = pk2(m11[8 * sp + 4], m11[8 * sp + 5]); w.w = pk2(m11[8 * sp + 6], m11[8 * sp + 7]); X11[sp] = __builtin_bit_cast(bf16x8, w);
            }
        }
        float* yp = (float*)(ws + WS_YP) + ((size_t)su.cid * 16 + h) * 4096 + lane;
#pragma unroll
        for (int pi = 0; pi < 2; ++pi) {
            f32x16 y0 = {}, y1 = {};
#pragma unroll
            for (int i = 0; i < 2; ++i)
#pragma unroll
                for (int sp = 0; sp < 2; ++sp) {
                    const LAS unsigned char* ap = xt + (32 * pi + r32) * SL_XT_ROW + (32 * i + 16 * sp + 4 * hi) * 2;
                    const v2u lo = *(const LAS v2u*)ap, hh = *(const LAS v2u*)(ap + 16);
                    const v4u aw = {lo.x, lo.y, hh.x, hh.y}; const bf16x8 af = __builtin_bit_cast(bf16x8, aw);
                    if (i == 0) { y0 = MFMA32(af, X00[sp], y0); y1 = MFMA32(af, X01[sp], y1); }
                    else y1 = MFMA32(af, X11[sp], y1);
                }
#pragma unroll
            for (int r = 0; r < 16; ++r) { yp[((pi * 2 + 0) * 16 + r) * 64] = y0[r]; yp[((pi * 2 + 1) * 16 + r) * 64] = y1[r]; }
        }
        float* sch = (float*)(ws + WS_SCH) + ((size_t)su.cid * 16 + h) * 8192;
#pragma unroll
        for (int pi = 0; pi < 2; ++pi) {
            f32x16 s0 = {}, s1 = {}, s2 = {}, s3 = {};
#pragma unroll
            for (int ks = 0; ks < 4; ++ks) {
                const int sb = 16 * ks + 8 * hi;
                const v4u raw = *(const LAS v4u*)(xt + (32 * pi + r32) * SL_XT_ROW + sb * 2);
                const f32x4 wa = *(const LAS f32x4*)(wl + sb), wb = *(const LAS f32x4*)(wl + sb + 4);
                v4u aw; aw.x = pk2(bflo(raw.x) * wa[0], bfhi(raw.x) * wa[1]); aw.y = pk2(bflo(raw.y) * wa[2], bfhi(raw.y) * wa[3]);
                aw.z = pk2(bflo(raw.z) * wb[0], bfhi(raw.z) * wb[1]); aw.w = pk2(bflo(raw.w) * wb[2], bfhi(raw.w) * wb[3]);
                const bf16x8 af = __builtin_bit_cast(bf16x8, aw);
                const bf16x8 q0 = *(const LAS bf16x8*)(bt + (0 + r32) * SL_BT_ROW + sb * 2), q1 = *(const LAS bf16x8*)(bt + (32 + r32) * SL_BT_ROW + sb * 2);
                const bf16x8 q2 = *(const LAS bf16x8*)(bt + (64 + r32) * SL_BT_ROW + sb * 2), q3 = *(const LAS bf16x8*)(bt + (96 + r32) * SL_BT_ROW + sb * 2);
                s0 = MFMA32(af, q0, s0); s1 = MFMA32(af, q1, s1); s2 = MFMA32(af, q2, s2); s3 = MFMA32(af, q3, s3);
            }
#pragma unroll
            for (int r = 0; r < 16; ++r) { float* o = sch + (size_t)(32 * pi + crow(r, hi)) * 128 + r32; o[0] = s0[r]; o[32] = s1[r]; o[64] = s2[r]; o[96] = s3[r]; }
        }
    }
    __syncthreads();
}

__device__ __forceinline__ void ssd_scan(const Args& A, int gtid, int gthreads) {
    unsigned char* ws = A.ws;
    const float* SCH = (const float*)(ws + WS_SCH); const float* CD = (const float*)(ws + WS_CD); bf16* HP = (bf16*)(ws + WS_HPREV);
    for (int e = gtid; e < 131072; e += gthreads) {
        const int h = e >> 13;
        float st = 0.f;
        for (int c0 = 0; c0 < 128; c0 += 8) {
            float s[8], d[8];
#pragma unroll
            for (int k = 0; k < 8; ++k) { s[k] = SCH[(size_t)(c0 + k) * 131072 + e]; d[k] = CD[(c0 + k) * 16 + h]; }
#pragma unroll
            for (int k = 0; k < 8; ++k) { HP[(size_t)(c0 + k) * 131072 + e] = (bf16)f2bf(st); st = d[k] * st + s[k]; }
        }
        A.out[O_SP + e] = st;
        for (int b0 = 0; b0 < 32; b0 += 8) {
            float s[8], d[8], h0[8];
#pragma unroll
            for (int k = 0; k < 8; ++k) { s[k] = SCH[(size_t)(128 + b0 + k) * 131072 + e]; d[k] = CD[(128 + b0 + k) * 16 + h]; h0[k] = A.in[I_SSM][(size_t)(b0 + k) * 131072 + e]; }
#pragma unroll
            for (int k = 0; k < 8; ++k) { HP[(size_t)(128 + b0 + k) * 131072 + e] = (bf16)f2bf(h0[k]); A.out[O_SS + (size_t)(b0 + k) * 131072 + e] = d[k] * h0[k] + s[k]; }
        }
    }
}

__device__ __forceinline__ void ssd_out(const Args& A, LAS unsigned char* lds, int u) {
    const SsdUnit su = ssd_unit(u);
    const int tid = threadIdx.x, lane = tid & 63, wid = __builtin_amdgcn_readfirstlane(tid >> 6), r32 = lane & 31, hi = lane >> 5;
    unsigned char* ws = A.ws;
    const int h = 8 * su.g + wid;
    const bf16* HP = (const bf16*)(ws + WS_HPREV) + ((size_t)su.cid * 16 + h) * 8192;
    const bf16* CB = (const bf16*)(ws + WS_CB) + (size_t)su.cid * 64 * 256 + su.g * 128;
    f32x16 acc[2][2] = {};
#pragma unroll
    for (int ks = 0; ks < 8; ++ks) {
        const int kb = 16 * ks + 8 * hi;
        const bf16x8 a0 = *(const bf16x8*)(HP + (size_t)r32 * 128 + kb), a1 = *(const bf16x8*)(HP + (size_t)(32 + r32) * 128 + kb);
        const bf16x8 b0 = *(const bf16x8*)(CB + (size_t)r32 * 256 + kb), b1 = *(const bf16x8*)(CB + (size_t)(32 + r32) * 256 + kb);
        acc[0][0] = MFMA32(a0, b0, acc[0][0]); acc[0][1] = MFMA32(a0, b1, acc[0][1]); acc[1][0] = MFMA32(a1, b0, acc[1][0]); acc[1][1] = MFMA32(a1, b1, acc[1][1]);
    }
    const float* acum = (const float*)(ws + WS_ACUM) + ((size_t)su.cid * 16 + h) * 64;
    const float* yp = (const float*)(ws + WS_YP) + ((size_t)su.cid * 16 + h) * 4096 + lane;
    const bf16* Z = (const bf16*)(ws + WS_Z);
    float ssq[2] = {0.f, 0.f};
#pragma unroll
    for (int j = 0; j < 2; ++j) {
        const int t = 32 * j + r32;
        const float ea = __expf(acum[t]);
        const bool tv = t < su.T;
        const bf16* zr = Z + (size_t)(su.rbase + (tv ? t : 0)) * 1024 + 512 * su.g + 64 * wid;
#pragma unroll
        for (int pi = 0; pi < 2; ++pi)
#pragma unroll
            for (int q = 0; q < 4; ++q) {
                const v2u zz = *(const v2u*)(zr + 32 * pi + 8 * q + 4 * hi);
                const float z0 = bflo(zz.x), z1 = bfhi(zz.x), z2 = bflo(zz.y), z3 = bfhi(zz.y);
                float y;
                y = (yp[((pi * 2 + j) * 16 + 4 * q + 0) * 64] + ea * acc[pi][j][4 * q + 0]) * siluf(z0); acc[pi][j][4 * q + 0] = y; ssq[j] += y * y;
                y = (yp[((pi * 2 + j) * 16 + 4 * q + 1) * 64] + ea * acc[pi][j][4 * q + 1]) * siluf(z1); acc[pi][j][4 * q + 1] = y; ssq[j] += y * y;
                y = (yp[((pi * 2 + j) * 16 + 4 * q + 2) * 64] + ea * acc[pi][j][4 * q + 2]) * siluf(z2); acc[pi][j][4 * q + 2] = y; ssq[j] += y * y;
                y = (yp[((pi * 2 + j) * 16 + 4 * q + 3) * 64] + ea * acc[pi][j][4 * q + 3]) * siluf(z3); acc[pi][j][4 * q + 3] = y; ssq[j] += y * y;
            }
        ssq[j] += __shfl_xor(ssq[j], 32);
    }
    LAS float* red = (LAS float*)lds;
    if (hi == 0) { red[wid * 64 + r32] = ssq[0]; red[wid * 64 + 32 + r32] = ssq[1]; }
    __syncthreads();
    const float* gn = A.in[I_GSSM] + 512 * su.g + 64 * wid;
    bf16* A2 = (bf16*)(ws + WS_A2);
#pragma unroll
    for (int j = 0; j < 2; ++j) {
        const int t = 32 * j + r32;
        float tot = 0.f;
#pragma unroll
        for (int w = 0; w < 8; ++w) tot += red[w * 64 + t];
        const float rstd = 1.0f / sqrtf(tot * (1.0f / 512.f) + EPS);
        if (t < su.T) {
            bf16* orow = A2 + (size_t)(su.rbase + t) * 2048 + 1024 + 512 * su.g + 64 * wid;
#pragma unroll
            for (int pi = 0; pi < 2; ++pi)
#pragma unroll
                for (int q = 0; q < 4; ++q) {
                    const int p = 32 * pi + 8 * q + 4 * hi;
                    const f32x4 gg = *(const f32x4*)(gn + p);
                    v2u w; w.x = pk2(acc[pi][j][4 * q + 0] * rstd * gg[0], acc[pi][j][4 * q + 1] * rstd * gg[1]); w.y = pk2(acc[pi][j][4 * q + 2] * rstd * gg[2], acc[pi][j][4 * q + 3] * rstd * gg[3]);
                    *(v2u*)(orow + p) = w;
                }
        }
    }
    __syncthreads();
}

namespace att {
constexpr int KVBLK = 64;
constexpr int SHM_V = 64 * 128 * 2, SHM_K = 64 * 128 * 2;
constexpr int L_V = 0, L_K = 2 * SHM_V, L_WS = L_K + 2 * SHM_K, L_EX = L_WS + NWAVES * 64 * 4, L_END = L_EX + 4 * 16384;
static_assert(L_END <= LDSCTL_OFF, "attn lds");
constexpr float THR = 6.f;
#define KSWZ(row, colB) ((row) * 256 + ((colB) ^ (((row) & 7) << 4)))
#define SBAR() __builtin_amdgcn_sched_barrier(0)
__device__ __forceinline__ unsigned cvtpk(float lo, float hi) { unsigned r; asm volatile("v_cvt_pk_bf16_f32 %0, %1, %2" : "=v"(r) : "v"(lo), "v"(hi)); return r; }
template <typename TIn> struct Stage;
template <> struct Stage<bf16>  { using T = bf16x8;
  __device__ static __forceinline__ T ld8(const bf16* p) { return *reinterpret_cast<const bf16x8*>(p); }
  __device__ static __forceinline__ bf16x8 tobf(T x) { return x; } };
template <> struct Stage<float> { using T = f32x8;
  __device__ static __forceinline__ T ld8(const float* p) { return *reinterpret_cast<const f32x8*>(p); }
  __device__ static __forceinline__ bf16x8 tobf(T x) {
    v4u w = {cvtpk(x[0], x[1]), cvtpk(x[2], x[3]), cvtpk(x[4], x[5]), cvtpk(x[6], x[7])}; return __builtin_bit_cast(bf16x8, w); } };

__device__ __forceinline__ void partialSM(f32x16& p0, f32x16& p1, float& m_reg, float& mn, float& alpha, float base, float c32) {
  float pm0 = p0[0]; for (int r = 1; r < 16; ++r) pm0 = fmaxf(pm0, p0[r]);
  float pm1 = p1[0]; for (int r = 1; r < 16; ++r) pm1 = fmaxf(pm1, p1[r]);
  float pmax = fmaxf(pm0, pm1 + c32) + base;
  { auto rr = __builtin_amdgcn_permlane32_swap(__float_as_uint(pmax), __float_as_uint(pmax), false, false);
    pmax = fmaxf(__uint_as_float(rr[0]), __uint_as_float(rr[1])); }
  if (__builtin_expect(__all(pmax - m_reg <= THR), 1)) { mn = m_reg; alpha = 1.f; }
  else { mn = fmaxf(m_reg, pmax); alpha = __builtin_amdgcn_exp2f(m_reg - mn); m_reg = mn; }
  const float off0 = base - mn, off1 = off0 + c32;
  for (int r = 0; r < 16; ++r) p0[r] = __builtin_amdgcn_exp2f(p0[r] + off0);
  for (int r = 0; r < 16; ++r) p1[r] = p1[r] + off1;
}
__device__ __forceinline__ void finishSM(f32x16& p0, f32x16& p1, float alpha, float& l_reg, bf16x8& pa0, bf16x8& pa1, bf16x8& pa2, bf16x8& pa3) {
  for (int r = 0; r < 16; ++r) p1[r] = __builtin_amdgcn_exp2f(p1[r]);
  float ps = 0; for (int r = 0; r < 16; ++r) ps += p0[r]; for (int r = 0; r < 16; ++r) ps += p1[r];
  { auto rr = __builtin_amdgcn_permlane32_swap(__float_as_uint(ps), __float_as_uint(ps), false, false);
    ps = __uint_as_float(rr[0]) + __uint_as_float(rr[1]); }
  l_reg = l_reg * alpha + ps;
#define PK4(P, BASE, OUT) do { unsigned a0 = cvtpk(P[BASE + 0], P[BASE + 1]), a1 = cvtpk(P[BASE + 2], P[BASE + 3]);   \
    unsigned b0 = cvtpk(P[BASE + 4], P[BASE + 5]), b1 = cvtpk(P[BASE + 6], P[BASE + 7]);                              \
    auto r0 = __builtin_amdgcn_permlane32_swap(a0, b0, false, false); auto r1 = __builtin_amdgcn_permlane32_swap(a1, b1, false, false); \
    v4u w = {r0[0], r1[0], r0[1], r1[1]}; OUT = __builtin_bit_cast(bf16x8, w); } while (0)
  PK4(p0, 0, pa0); PK4(p0, 8, pa1); PK4(p1, 0, pa2); PK4(p1, 8, pa3);
#undef PK4
}
__device__ __forceinline__ void qkt(f32x16& p0, f32x16& p1, const char* Ks, const bf16x8* qr, const f32x16& kc, int r32, int hi, int mapoff) {
  p0 = kc; p1 = kc;
#pragma unroll
  for (int d0 = 0; d0 < 4; ++d0) { const int cb = (mapoff + d0 * 16 + hi * 8) * 2;
    const bf16x8 b0 = *reinterpret_cast<const bf16x8*>(Ks + KSWZ(r32, cb));
    const bf16x8 b1 = *reinterpret_cast<const bf16x8*>(Ks + KSWZ(32 + r32, cb));
    p0 = __builtin_amdgcn_mfma_f32_32x32x16_bf16(b0, qr[d0], p0, 0, 0, 0);
    p1 = __builtin_amdgcn_mfma_f32_32x32x16_bf16(b1, qr[d0], p1, 0, 0, 0); }
}
__device__ __forceinline__ int v_st(int k, int c) { const int kk = (k & ~0xC) | ((k & 4) << 1) | ((k & 8) >> 1); return ((kk >> 3) * 4 + (c >> 5)) * 512 + ((kk & 7) * 32 + (c & 31)) * 2; }
__device__ __forceinline__ int v_rd_base(int lane) { return ((lane & 3) << 3) | (((lane >> 2) & 3) << 6) | (((lane >> 4) & 1) << 5) | (((lane >> 5) & 1) << 8); }
constexpr int v_rd_off(int d0, int ks, int half) { return d0 * 512 + ks * 4096 + half * 2048; }
template <int OFF> __device__ __forceinline__ s16x4 tr_read(int vb) {
  s16x4 r; asm volatile("ds_read_b64_tr_b16 %0, %1 offset:%2" : "=&v"(r) : "v"(vb), "i"(OFF) : "memory"); return r;
}
template <int D0> __device__ __forceinline__ void pv_one(f32x16& od, int vb, bf16x8 pa0, bf16x8 pa1, bf16x8 pa2, bf16x8 pa3) {
  const s16x4 l0 = tr_read<v_rd_off(D0, 0, 0)>(vb), h0 = tr_read<v_rd_off(D0, 0, 1)>(vb), l1 = tr_read<v_rd_off(D0, 1, 0)>(vb), h1 = tr_read<v_rd_off(D0, 1, 1)>(vb);
  const s16x4 l2 = tr_read<v_rd_off(D0, 2, 0)>(vb), h2 = tr_read<v_rd_off(D0, 2, 1)>(vb), l3 = tr_read<v_rd_off(D0, 3, 0)>(vb), h3 = tr_read<v_rd_off(D0, 3, 1)>(vb);
  asm volatile("s_waitcnt lgkmcnt(0)" ::: "memory"); SBAR();
#define PK(L, H) (bf16x8){L[0], L[1], L[2], L[3], H[0], H[1], H[2], H[3]}
  od = __builtin_amdgcn_mfma_f32_32x32x16_bf16(pa0, PK(l0, h0), od, 0, 0, 0);
  od = __builtin_amdgcn_mfma_f32_32x32x16_bf16(pa1, PK(l1, h1), od, 0, 0, 0);
  od = __builtin_amdgcn_mfma_f32_32x32x16_bf16(pa2, PK(l2, h2), od, 0, 0, 0);
  od = __builtin_amdgcn_mfma_f32_32x32x16_bf16(pa3, PK(l3, h3), od, 0, 0, 0);
#undef PK
}
__device__ __forceinline__ void pv_d0(f32x16* o, int vb, bf16x8 pa0, bf16x8 pa1, bf16x8 pa2, bf16x8 pa3) {
  pv_one<0>(o[0], vb, pa0, pa1, pa2, pa3); pv_one<1>(o[1], vb, pa0, pa1, pa2, pa3); pv_one<2>(o[2], vb, pa0, pa1, pa2, pa3); pv_one<3>(o[3], vb, pa0, pa1, pa2, pa3);
}

struct SrcPrompt {
  const bf16* Kh; const bf16* Vh;
  __device__ __forceinline__ const bf16* kp(int t) const { return Kh + (size_t)t * 64 * 1024; }
  __device__ __forceinline__ const bf16* vp(int t) const { return Vh + (size_t)t * 64 * 1024; }
  __device__ __forceinline__ int nvalid(int) const { return 64; }
};
struct SrcSample {
  const float* Kc; const float* Vc; const float* Kn; const float* Vn;
  __device__ __forceinline__ const float* kp(int t) const { return t < 16 ? Kc + (size_t)t * 64 * 1024 : Kn; }
  __device__ __forceinline__ const float* vp(int t) const { return t < 16 ? Vc + (size_t)t * 64 * 1024 : Vn; }
  __device__ __forceinline__ int nvalid(int t) const { return t < 16 ? 64 : 16; }
};

template <typename TKV, int SD, class Src>
__device__ __forceinline__ void attn_core(f32x16 (&o)[4], const bf16* qrow, float qposf, float c, int cq, int NT, int nvd, const Src& src, char* lds, int mapoff) {
  using St = Stage<TKV>;
  int tid_ = threadIdx.x; asm volatile("" : "+v"(tid_));
  const int tid = tid_, wid = tid >> 6, lane = tid & 63, r32 = lane & 31, hi = lane >> 5;
  char* V_lds = lds + L_V; char* K_lds = lds + L_K;
  float* wsf = (float*)(lds + L_WS) + wid * 64; float* li_l = wsf; float* al_l = wsf + 32;
  float m_reg = -1e30f, l_reg = 0; bf16x8 qr[4];
#pragma unroll
  for (int d = 0; d < 4; ++d) o[d] = f32x16{};
#pragma unroll
  for (int d0 = 0; d0 < 4; ++d0) qr[d0] = *reinterpret_cast<const bf16x8*>(qrow + d0 * 16);
  f32x16 kc;
#pragma unroll
  for (int r = 0; r < 16; ++r) kc[r] = c * (float)((r & 3) + 8 * (r >> 2));
  const float c32 = 32.f * c, c2 = 2.f * c;
  const float qrel = (float)(4 * hi) - qposf;
  const int sr = tid >> 4, sc = (tid & 15) * 8, vst0 = v_st(sr, sc), vst1 = v_st(32 + sr, sc);
  const int vb0 = (int)(uintptr_t)V_lds + v_rd_base(lane);
  struct { typename St::T vs0, vs1, ks0, ks1; } sr_[SD];
#define SLOAD(i, t) do { const int nv_ = src.nvalid(t); const int r0_ = sr < nv_ ? sr : nv_ - 1, r1_ = 32 + sr < nv_ ? 32 + sr : nv_ - 1; \
    const TKV* kp_ = src.kp(t); const TKV* vp_ = src.vp(t); \
    sr_[i].vs0 = St::ld8(vp_ + (size_t)r0_ * 1024 + sc); sr_[i].vs1 = St::ld8(vp_ + (size_t)r1_ * 1024 + sc); \
    sr_[i].ks0 = St::ld8(kp_ + (size_t)r0_ * 1024 + sc); sr_[i].ks1 = St::ld8(kp_ + (size_t)r1_ * 1024 + sc); } while (0)
#define SWRITE(b, i) do { *(bf16x8*)(V_lds + (b) * SHM_V + vst0) = St::tobf(sr_[i].vs0);          \
    *(bf16x8*)(V_lds + (b) * SHM_V + vst1) = St::tobf(sr_[i].vs1); const int kcb = sc * 2;               \
    *(bf16x8*)(K_lds + (b) * SHM_K + KSWZ(sr, kcb)) = St::tobf(sr_[i].ks0);                       \
    *(bf16x8*)(K_lds + (b) * SHM_K + KSWZ(32 + sr, kcb)) = St::tobf(sr_[i].ks1); } while (0)
#define SWAIT() do { if constexpr (SD == 2) asm volatile("s_waitcnt vmcnt(4)" ::: "memory"); else asm volatile("s_waitcnt vmcnt(0)" ::: "memory"); } while (0)
#define RESC(a) do { if (__any((a) < 1.f)) { if (hi == 0) al_l[r32] = (a); asm volatile("s_waitcnt lgkmcnt(0)" ::: "memory"); \
    for (int d = 0; d < 4; ++d) for (int r = 0; r < 16; ++r) o[d][r] *= al_l[crow(r, hi)]; } } while (0)
#define POST(P0, P1, t) do { if ((t) == cq) { const float d0_ = (float)(64 * (t)) + qrel; \
      for (int r = 0; r < 16; ++r) { const float d_ = d0_ + (float)((r & 3) + 8 * (r >> 2)); P0[r] -= c2 * fmaxf(d_, 0.f); P1[r] -= c2 * fmaxf(d_ + 32.f, 0.f); } \
      if (nvd < 64) { for (int r = 0; r < 16; ++r) { const int kk_ = crow(r, hi); if (kk_ >= nvd) P0[r] = -1e30f; if (kk_ + 32 >= nvd) P1[r] = -1e30f; } } } } while (0)
#define BASE(t) ((t) > cq ? -1e30f : c * ((float)(64 * (t)) + qrel))
  f32x16 p0, p1; float mn, al; bf16x8 pa0, pa1, pa2, pa3;
  SLOAD(0, 0); asm volatile("s_waitcnt vmcnt(0)" ::: "memory"); SWRITE(0, 0); __syncthreads();
  for (int t = 0; t < NT; ++t) {
    const int bsel = t & 1;
    if (t + 1 < NT) SLOAD(0, t + 1);
    SBAR(); qkt(p0, p1, K_lds + bsel * SHM_K, qr, kc, r32, hi, mapoff); POST(p0, p1, t);
    partialSM(p0, p1, m_reg, mn, al, BASE(t), c32);
    RESC(al);
    finishSM(p0, p1, al, l_reg, pa0, pa1, pa2, pa3); SBAR();
    pv_d0(o, vb0 + bsel * SHM_V, pa0, pa1, pa2, pa3);
    if (t + 1 < NT) { SWRITE(bsel ^ 1, 0); }
    __syncthreads();
  }
  if (hi == 0) li_l[r32] = l_reg; asm volatile("s_waitcnt lgkmcnt(0)" ::: "memory");
#pragma unroll
  for (int r = 0; r < 16; ++r) { const float rl = __builtin_amdgcn_rcpf(li_l[crow(r, hi)]);
#pragma unroll
    for (int d = 0; d < 4; ++d) o[d][r] *= rl; }
#undef SLOAD
#undef SWRITE
#undef SWAIT
#undef RESC
#undef POST
#undef BASE
}

__device__ __forceinline__ void attn_finish(f32x16 (&o)[4], float lam, const float* gsub, bf16* A2h, int rowbase, int nrows, bool store, char* lds) {
  int tid_ = threadIdx.x; asm volatile("" : "+v"(tid_));
  const int tid = tid_, wid = tid >> 6, lane = tid & 63, r32 = lane & 31, hi = lane >> 5;
  float* ex = (float*)(lds + L_EX) + (wid & 3) * 4096 + lane;
  if (wid >= 4) {
#pragma unroll
    for (int d = 0; d < 4; ++d)
#pragma unroll
      for (int r = 0; r < 16; ++r) ex[(d * 16 + r) * 64] = lam * o[d][r];
  }
  __syncthreads();
  if (wid < 4) {
    float g[4];
#pragma unroll
    for (int d = 0; d < 4; ++d) g[d] = gsub[32 * d + r32] * (1.0f - LAM_INIT);
#pragma unroll
    for (int r = 0; r < 16; ++r) {
      float ss = 0.f;
#pragma unroll
      for (int d = 0; d < 4; ++d) { const float a = o[d][r] - ex[(d * 16 + r) * 64]; o[d][r] = a; ss += a * a; }
      ss += __shfl_xor(ss, 1); ss += __shfl_xor(ss, 2); ss += __shfl_xor(ss, 4); ss += __shfl_xor(ss, 8); ss += __shfl_xor(ss, 16);
      const float rstd = 1.0f / sqrtf(ss * (1.0f / 128.f) + EPS);
      const int row = crow(r, hi);
      if (store && row < nrows) {
#pragma unroll
        for (int d = 0; d < 4; ++d) A2h[(size_t)(rowbase + row) * 2048 + 32 * d + r32] = (bf16)f2bf(o[d][r] * rstd * g[d]);
      }
    }
  }
  __syncthreads();
}
#undef SBAR
}

constexpr int N_PHASES = 10;
constexpr int N_LAUNCHES = MK_N_LAUNCHES;

__global__ void __launch_bounds__(NWAVES * 64, 2) hymba_fwd(Args args) {
    extern __shared__ __attribute__((aligned(16))) unsigned char lds_raw[];
    LAS unsigned char* lds = (LAS unsigned char*)lds_raw;
    volatile LAS unsigned* MISC = (volatile LAS unsigned*)(lds + LDSCTL_OFF);
    const int tid = threadIdx.x, lane = tid & 63, wave = __builtin_amdgcn_readfirstlane(tid >> 6);
    const int G = gridDim.x; const int bx = blockIdx.x;
    const int vcu = (G % 8 == 0) ? (bx % 8) * (G / 8) + bx / 8 : bx;
    unsigned char* ws = args.ws;
    gu32* ctl = (gu32*)(ws + WS_CTL);
    for (int u = tid; u < (LDS_BYTES - LDSCTL_OFF) / 4; u += NWAVES * 64) ((LAS unsigned*)(lds + LDSCTL_OFF))[u] = 0u;
    __syncthreads();
    XcdBarrier bar; bar.bar = (unsigned*)(ctl + CW_BAR); bar.x = 0; bar.st = nullptr;
    if (N_LAUNCHES == 1) bar = xcd_barrier_post((unsigned*)(ctl + CW_BAR), MISC + 8);
    const int lo = args.ph_lo, hi_ph = args.ph_hi;
#ifndef PHASE_MASK
#define PHASE_MASK 0x3ff
#endif
#define IN(k) (((PHASE_MASK >> (k)) & 1) && lo <= (k) && (k) < hi_ph)
#define SEAM(k) do { if (IN(k) && IN((k) + 1)) xcd_barrier(bar); } while (0)

    bf16* WIN = (bf16*)(ws + WS_WIN); bf16* WOUT = (bf16*)(ws + WS_WOUT); bf16* WGU = (bf16*)(ws + WS_WGU); bf16* WDN = (bf16*)(ws + WS_WDN);
    bf16* XN = (bf16*)(ws + WS_XN);

    if (IN(0)) {
        {
            LAS float* scr = (LAS float*)(lds + wave * 16384);
            const int gw = vcu * NWAVES + wave, NGW = G * NWAVES;
            constexpr int I_A = 32 * 176, I_B = 32 * 64, I_C = 32 * 176, I_D = 32 * 176, I_E = 88 * 64;
            for (int it = gw; it < I_A + I_B + I_C + I_D + I_E; it += NGW) {
                int r = it;
                if (r < I_A) { p0_transpose_item(args.in[I_WIN], DIN, DM, 64 * (r / 176), 32 * (r % 176), nullptr, WIN, 32 * (r % 176), scr, lane); continue; } r -= I_A;
                if (r < I_B) { p0_transpose_item(args.in[I_WOUT], DM, DM, 64 * (r / 64), 32 * (r % 64), nullptr, WOUT, 32 * (r % 64), scr, lane); continue; } r -= I_B;
                if (r < I_C) { const int n0 = 32 * (r % 176); p0_transpose_item(args.in[I_WGATE], DFF, DM, 64 * (r / 176), n0, args.in[I_GFFN], WGU, (n0 >> 7) * 256 + (n0 & 127), scr, lane); continue; } r -= I_C;
                if (r < I_D) { const int n0 = 32 * (r % 176); p0_transpose_item(args.in[I_WUP], DFF, DM, 64 * (r / 176), n0, args.in[I_GFFN], WGU, (n0 >> 7) * 256 + 128 + (n0 & 127), scr, lane); continue; } r -= I_D;
                p0_transpose_item(args.in[I_WDOWN], DM, DFF, 64 * (r / 64), 32 * (r % 64), nullptr, WDN, 32 * (r % 64), scr, lane);
            }
        }
        __syncthreads();
        {
            LAS float* wT = (LAS float*)lds;
            for (int k = tid; k < DM; k += NWAVES * 64) {
                const float* src = args.in[I_WIN] + (size_t)k * DIN + NPROJ;
#pragma unroll
                for (int q = 0; q < 4; ++q) { const f32x4 v = *(const f32x4*)(src + 4 * q); wT[(4 * q + 0) * DM + k] = v[0]; wT[(4 * q + 1) * DM + k] = v[1]; wT[(4 * q + 2) * DM + k] = v[2]; wT[(4 * q + 3) * DM + k] = v[3]; }
            }
            __syncthreads();
            const int gw = vcu * NWAVES + wave, NGW = G * NWAVES;
            const float* gmix = args.in[I_GMIX];
            float* DT = (float*)(ws + WS_DT);
            for (int m = gw; m < MT; m += NGW) {
                const float* xrow = m < MP ? args.in[I_XP] + (size_t)m * DM : args.in[I_XS] + (size_t)(m - MP) * DM;
                f32x4 v[8]; float s = 0.f;
#pragma unroll
                for (int j = 0; j < 8; ++j) { v[j] = *(const f32x4*)(xrow + 4 * lane + 256 * j); s += (v[j][0] * v[j][0] + v[j][1] * v[j][1]) + (v[j][2] * v[j][2] + v[j][3] * v[j][3]); }
                const float rstd = 1.0f / sqrtf(wave_sum(s) * (1.0f / DM) + EPS);
#pragma unroll
                for (int j = 0; j < 8; ++j) { const f32x4 gg = *(const f32x4*)(gmix + 4 * lane + 256 * j); v[j] = v[j] * rstd * gg;
                    v2u w; w.x = pk2(v[j][0], v[j][1]); w.y = pk2(v[j][2], v[j][3]); *(v2u*)(XN + (size_t)m * DM + 4 * lane + 256 * j) = w; }
                float mine = 0.f;
#pragma unroll 4
                for (int jj = 0; jj < 16; ++jj) {
                    float a = 0.f;
#pragma unroll
                    for (int j = 0; j < 8; ++j) { const f32x4 w = *(const LAS f32x4*)(wT + jj * DM + 4 * lane + 256 * j); a += (v[j][0] * w[0] + v[j][1] * w[1]) + (v[j][2] * w[2] + v[j][3] * w[3]); }
                    a = wave_sum(a);
                    if (lane == jj) mine = a;
                }
                if (lane < 16) { const float xx = mine + args.in[I_DTB][lane]; DT[(size_t)m * 16 + lane] = fmaxf(xx, 0.f) + log1pf(__expf(-fabsf(xx))); }
            }
        }
        __syncthreads();
    }
    SEAM(0);

    if (IN(1)) {
        pg8::Gemm g{XN, WIN, MT, NPROJ, DM}; pg8::StaticOrder S; S.init(MT, NPROJ, G, bx);
        EpiInProj E{(bf16*)(ws + WS_Q), (bf16*)(ws + WS_K), (bf16*)(ws + WS_V), (bf16*)(ws + WS_Z), (bf16*)(ws + WS_XBC), args.out};
        pg8::gemm_phase<EpiInProj, pg8::StaticOrder, true, true>(lds, g, S, E);
    }
    SEAM(1);

    if (IN(2)) { for (int u = vcu; u < 320; u += G) ssd_local(args, lds, u); }
    SEAM(2);

    if (IN(3)) {
        ssd_scan(args, bx * (NWAVES * 64) + tid, G * NWAVES * 64);
        float lam;
        { const float a = args.in[I_LQ1][lane] * args.in[I_LK1][lane], b = args.in[I_LQ2][lane] * args.in[I_LK2][lane];
          lam = __expf(wave_sum(a)) - __expf(wave_sum(b)) + LAM_INIT; }
        const int r32 = lane & 31, hi = lane >> 5, map = wave >> 2, w4 = wave & 3;
        const bf16* Qb = (const bf16*)(ws + WS_Q); const bf16* Kb = (const bf16*)(ws + WS_K); const bf16* Vb = (const bf16*)(ws + WS_V);
        bf16* A2 = (bf16*)(ws + WS_A2);
        for (int slot = vcu; slot < 256; slot += G) {
            const int h = slot >> 5, s = slot & 31;
            const float cs = exp2f(-(float)(h + 1)) * LOG2E;
            f32x16 o[4];
            for (int pass = 0; pass < 3; ++pass) {
#ifdef NO_SAMPLE
                if (pass == 1) continue;
#endif
#ifdef NO_PROMPT
                if (pass != 1) continue;
#endif
                if (pass == 1) {
                    const int b = s;
                    const int qi = r32 < 16 ? r32 : 15;
                    const bf16* qrow = Qb + (size_t)(MP + 16 * b + qi) * 1024 + h * 128 + map * 64 + hi * 8;
                    att::SrcSample src{args.in[I_CK] + ((size_t)b * 1024 * 8 + h) * 128, args.in[I_CV] + ((size_t)b * 1024 * 8 + h) * 128,
                                       args.out + O_KS + (size_t)(16 * b) * 1024 + h * 128, args.out + O_VS + (size_t)(16 * b) * 1024 + h * 128};
                    att::attn_core<float, 1, att::SrcSample>(o, qrow, (float)(1024 + qi), cs, 16, 18, 16, src, (char*)lds_raw, map * 64);
                    att::attn_finish(o, lam, args.in[I_GSUB], A2 + h * 128, MP + 16 * b, 16, w4 == 0, (char*)lds_raw);
                } else {
                    const int j = pass == 0 ? s : 63 - s;
                    const int row = 128 * j + 32 * w4 + r32;
                    const bf16* qrow = Qb + (size_t)row * 1024 + h * 128 + map * 64 + hi * 8;
                    att::SrcPrompt src{Kb + h * 128, Vb + h * 128};
                    att::attn_core<bf16, 1, att::SrcPrompt>(o, qrow, (float)row, cs, 2 * j + (w4 >> 1), 2 * j + 2, 64, src, (char*)lds_raw, map * 64);
                    att::attn_finish(o, lam, args.in[I_GSUB], A2 + h * 128, 128 * j + 32 * w4, 32, true, (char*)lds_raw);
                }
            }
        }
    }
    SEAM(3);

    if (IN(4)) { for (int u = vcu; u < 320; u += G) ssd_out(args, lds, u); }
    SEAM(4);

    if (IN(5)) {
        pg8::Gemm g{(const bf16*)(ws + WS_A2), WOUT, MT, DM, DM}; pg8::StaticOrder S; S.init(MT, DM, G, bx);
        EpiOutProj E{args.in[I_XP], args.in[I_XS], args.out + O_Y, XN, (float*)(ws + WS_RS1)};
        pg8::gemm_phase<EpiOutProj, pg8::StaticOrder, true, true>(lds, g, S, E);
    }
    SEAM(5);

    if (IN(6)) {
        pg8::Gemm g{XN, WGU, MT, 2 * DFF, DM}; pg8::StaticOrder S; S.init(MT, 2 * DFF, G, bx);
        EpiGateUp E{(bf16*)(ws + WS_G), (bf16*)(ws + WS_U), (const float*)(ws + WS_RS1), args.out};
        pg8::gemm_phase<EpiGateUp, pg8::StaticOrder, true, true>(lds, g, S, E);
    }
    SEAM(6);

    if (IN(7)) {
        const bf16* Gm = (const bf16*)(ws + WS_G); const bf16* Um = (const bf16*)(ws + WS_U); bf16* HID = (bf16*)(ws + WS_HID);
        const float* fw = args.in[I_FCW]; const float* fb = args.in[I_FCB];
        const int ntask = (MT / 16) * (DFF / 8);
        for (int task = bx * (NWAVES * 64) + tid; task < ntask; task += G * NWAVES * 64) {
            const int cgp = task % (DFF / 8), rb = task / (DFF / 8), col = 8 * cgp, row0 = 16 * rb;
            float w0[8], w1[8], w2[8], bb[8], h0[8], h1[8];
#pragma unroll
            for (int e = 0; e < 8; ++e) { w0[e] = fw[col + e]; w1[e] = fw[DFF + col + e]; w2[e] = fw[2 * DFF + col + e]; bb[e] = fb[col + e]; }
            if (row0 >= MP) {
                const float* sp = args.in[I_SFFN] + (size_t)((row0 - MP) >> 4) * 2 * DFF + col;
#pragma unroll
                for (int e = 0; e < 8; ++e) { h0[e] = sp[e]; h1[e] = sp[DFF + e]; }
            } else if (row0 == 0) {
#pragma unroll
                for (int e = 0; e < 8; ++e) { h0[e] = 0.f; h1[e] = 0.f; }
            } else {
                const v4u a = *(const v4u*)(Gm + (size_t)(row0 - 2) * DFF + col), b = *(const v4u*)(Gm + (size_t)(row0 - 1) * DFF + col);
                h0[0] = bflo(a.x); h0[1] = bfhi(a.x); h0[2] = bflo(a.y); h0[3] = bfhi(a.y); h0[4] = bflo(a.z); h0[5] = bfhi(a.z); h0[6] = bflo(a.w); h0[7] = bfhi(a.w);
                h1[0] = bflo(b.x); h1[1] = bfhi(b.x); h1[2] = bflo(b.y); h1[3] = bfhi(b.y); h1[4] = bflo(b.z); h1[5] = bfhi(b.z); h1[6] = bflo(b.w); h1[7] = bfhi(b.w);
            }
#pragma unroll 4
            for (int i = 0; i < 16; ++i) {
                const size_t off = (size_t)(row0 + i) * DFF + col;
                const v4u gr = *(const v4u*)(Gm + off), ur = *(const v4u*)(Um + off);
                float gv[8], uv[8], o[8];
                gv[0] = bflo(gr.x); gv[1] = bfhi(gr.x); gv[2] = bflo(gr.y); gv[3] = bfhi(gr.y); gv[4] = bflo(gr.z); gv[5] = bfhi(gr.z); gv[6] = bflo(gr.w); gv[7] = bfhi(gr.w);
                uv[0] = bflo(ur.x); uv[1] = bfhi(ur.x); uv[2] = bflo(ur.y); uv[3] = bfhi(ur.y); uv[4] = bflo(ur.z); uv[5] = bfhi(ur.z); uv[6] = bflo(ur.w); uv[7] = bfhi(ur.w);
#pragma unroll
                for (int e = 0; e < 8; ++e) { const float y = bb[e] + w0[e] * h0[e] + w1[e] * h1[e] + w2[e] * gv[e]; o[e] = siluf(y) * uv[e]; h0[e] = h1[e]; h1[e] = gv[e]; }
                v4u w; w.x = pk2(o[0], o[1]); w.y = pk2(o[2], o[3]); w.z = pk2(o[4], o[5]); w.w = pk2(o[6], o[7]);
                *(v4u*)(HID + off) = w;
            }
        }
    }
    SEAM(7);

    if (IN(8)) {
        pg8::Gemm g{(const bf16*)(ws + WS_HID), WDN, MT, DM, DFF}; pg8::StaticOrder S; S.init(MT, DM, G, bx);
        EpiDown E{args.out + O_Y, (float*)(ws + WS_RS2)};
        pg8::gemm_phase<EpiDown, pg8::StaticOrder, true, true>(lds, g, S, E);
    }
    SEAM(8);

    if (IN(9)) {
        const int gw = vcu * NWAVES + wave, NGW = G * NWAVES;
        const float* rs = (const float*)(ws + WS_RS2); const float* gf = args.in[I_GFIN];
        for (int m = gw; m < MT; m += NGW) {
            float t = lane < 32 ? rs[(size_t)m * 32 + lane] : 0.f; t = wave_sum(t);
            const float rstd = 1.0f / sqrtf(t * (1.0f / DM) + EPS);
            float* row = args.out + O_Y + (size_t)m * DM;
#pragma unroll
            for (int j = 0; j < 8; ++j) { const f32x4 v = *(const f32x4*)(row + 4 * lane + 256 * j), gg = *(const f32x4*)(gf + 4 * lane + 256 * j); *(f32x4*)(row + 4 * lane + 256 * j) = v * rstd * gg; }
        }
    }
#undef IN
#undef SEAM
}

extern "C" void kernel_launch(void* const* d_in, const int* in_sizes, int n_in, void* d_out, int out_size, void* d_ws, size_t ws_size, hipStream_t stream) {
    static int grid = 0;
    if (grid == 0) {
        if (n_in != 28 || out_size != (int)O_END || ws_size < WS_END) { fprintf(stderr, "kernel_launch: unexpected shapes: n_in %d out %d ws %zu (need %zu)\n", n_in, out_size, ws_size, (size_t)WS_END); grid = -1; return; }
        int dev = 0, cus = 0;
        if (hipGetDevice(&dev) != hipSuccess || hipDeviceGetAttribute(&cus, hipDeviceAttributeMultiprocessorCount, dev) != hipSuccess) { grid = -1; return; }
        if (hipFuncSetAttribute((const void*)hymba_fwd, hipFuncAttributeMaxDynamicSharedMemorySize, LDS_BYTES) != hipSuccess) { fprintf(stderr, "kernel_launch: hipFuncSetAttribute failed\n"); grid = -1; return; }
        (void)hipGetLastError();
        grid = cus;
    }
    if (grid < 0) return;
    (void)hipMemsetAsync((char*)d_ws + WS_CTL, 0, CTL_ZERO_BYTES, stream);
    Args a{};
    for (int i = 0; i < 28; ++i) a.in[i] = (const float*)d_in[i];
    a.out = (float*)d_out; a.ws = (unsigned char*)d_ws;
    if (N_LAUNCHES == 1) {
        a.ph_lo = 0; a.ph_hi = N_PHASES; a.li = 0;
        hipLaunchKernelGGL(hymba_fwd, dim3(grid), dim3(NWAVES * 64), LDS_BYTES, stream, a);
    } else {
        for (int li = 0; li < N_PHASES; ++li) { a.ph_lo = li; a.ph_hi = li + 1; a.li = li; hipLaunchKernelGGL(hymba_fwd, dim3(grid), dim3(NWAVES * 64), LDS_BYTES, stream, a); }
    }
    const hipError_t le = hipPeekAtLastError();
    if (le != hipSuccess) fprintf(stderr, "kernel_launch: launch failed: %s\n", hipGetErrorName(le));
}
```

```cpp
#include <hip/hip_runtime.h>
#include <hip/hip_bf16.h>
#include <cstdio>
#include <cstdint>

#ifndef MK_N_LAUNCHES
#define MK_N_LAUNCHES 1
#endif

namespace pg8 {
#define PG8_LAS __attribute__((address_space(3)))
typedef unsigned short bf16_t;
typedef short bf16x8 __attribute__((ext_vector_type(8)));
typedef float f32x4 __attribute__((ext_vector_type(4)));
typedef unsigned u32x4 __attribute__((ext_vector_type(4)));
constexpr int BM = 256, BK = 64, HALF = 128, HTB = HALF * BK * 2, STAGE_BYTES = 8 * HTB, NXCD = 8, WGM = 8;

__host__ __device__ __forceinline__ int lds_byte(int r, int c) { const int st = (r >> 4) * 2 + (c >> 5), rr = r & 15, cc = c & 31, ob = rr * 64 + cc * 2; return st * 1024 + (ob ^ (((ob >> 9) & 1) << 5)); }
__host__ __device__ __forceinline__ void stage_rc(int b, int& R, int& C) { const int st = b / 1024, sb = b % 1024, swz = sb ^ (((sb >> 9) & 1) << 5); R = (st >> 1) * 16 + swz / 64; C = (st & 1) * 32 + (swz % 64) / 2; }
__host__ __device__ __forceinline__ int perm32(int rho) { const int n = rho >> 4, i = rho & 15; return 8 * (i >> 2) + 4 * n + (i & 3); }

struct Unit { int pm, pn, k0, nk, slab; };
struct Gemm { const bf16_t* A; const bf16_t* Bt; int M, N, K; };

struct StaticOrder {
    int nM, nN, nwg, G, c, nkt;
    __host__ __device__ void init(int M, int N, int K, int G_, int c_) { nM = M / BM; nN = N / BM; nwg = nM * nN; G = G_; c = c_; nkt = K / BK; }
    __host__ __device__ __forceinline__ bool next(int i, Unit& u) const { return at((long)i * G + c, u); }
    __host__ __device__ __forceinline__ bool at(long L, Unit& u) const {
        if (L >= nwg) return false; u.k0 = 0; u.nk = nkt; u.slab = -1;
        int wgid = (int)L; { const int q = nwg / NXCD, r = nwg % NXCD, xcd = wgid % NXCD, off = wgid / NXCD; wgid = (xcd < r ? xcd * (q + 1) : r * (q + 1) + (xcd - r) * q) + off; }
        const int nig = WGM * nN, gid = wgid / nig, fm = gid * WGM, gsz = (nM - fm) < WGM ? (nM - fm) : WGM;
        u.pm = fm + ((wgid % nig) % gsz); u.pn = (wgid % nig) / gsz; return true;
    }
    __device__ __forceinline__ void a_ready(const Unit&) const {}
    __device__ __forceinline__ void done(const Unit&) const {}
};

struct SplitOrder {
    StaticOrder P; int nN, nsl, nks, ntail;
    __host__ __device__ void init(int MPR, int M, int N, int K, int G_, int c_, int nsl_) { P.init(MPR, N, K, G_, c_); nN = N / BM; nsl = nsl_; nks = (K / BK) / nsl_; ntail = ((M - MPR) / BM) * nN; }
    __host__ __device__ __forceinline__ bool next(int i, Unit& u) const {
        const long L = (long)i * P.G + P.c;
        const int sidx = (int)(L - P.nwg);
        if (sidx >= ntail * nsl) return false;
        int pm, pn, k0, nk, slab;
        if (sidx < 0) {
            int wgid = (int)L; { const int q = P.nwg / NXCD, r = P.nwg % NXCD, xcd = wgid % NXCD, off = wgid / NXCD; wgid = (xcd < r ? xcd * (q + 1) : r * (q + 1) + (xcd - r) * q) + off; }
            const int nig = WGM * P.nN, gid = wgid / nig, fm = gid * WGM, gsz = (P.nM - fm) < WGM ? (P.nM - fm) : WGM;
            pm = fm + ((wgid % nig) % gsz); pn = (wgid % nig) / gsz; k0 = 0; nk = P.nkt; slab = -1;
        } else {
            const int tile = sidx / nsl, sl = sidx % nsl; pm = P.nM + tile / nN; pn = tile % nN; k0 = sl * nks; nk = nks; slab = sidx;
        }
        u.pm = pm; u.pn = pn; u.k0 = k0; u.nk = nk; u.slab = slab; return true;
    }
    __device__ __forceinline__ void a_ready(const Unit&) const {}
    __device__ __forceinline__ void done(const Unit&) const {}
};

typedef float f32x2_t __attribute__((ext_vector_type(2))); typedef __bf16 bf16x2_t __attribute__((ext_vector_type(2)));
__device__ __forceinline__ unsigned cvt_pk_bf16(float lo, float hi) { f32x2_t v = {lo, hi}; bf16x2_t b = __builtin_convertvector(v, bf16x2_t); return __builtin_bit_cast(unsigned, b); }

template <class Epi, class Sched, bool ALIGN_EPI = false, bool SP2 = false>
__device__ __forceinline__ void gemm_phase(PG8_LAS unsigned char* lds, const Gemm g, const Sched& S, const Epi& E) {
    const int tid = threadIdx.x, wid = __builtin_amdgcn_readfirstlane(tid >> 6), lane = tid & 63, wr = wid >> 2, wc = wid & 3, fr = lane & 15, fq = lane >> 4;
    const int K = g.K;
    unsigned voffA[2], voffB[2];
#pragma unroll
    for (int i = 0; i < 2; ++i) { int R, C; stage_rc(tid * 16 + i * 8192, R, C); const int Rb = Epi::PERM ? ((R & ~31) + perm32(R & 31)) : R;
        voffA[i] = (unsigned)(R * K + C) * 2u; voffB[i] = (unsigned)(Rb * K + C) * 2u; }
    const size_t kstep = (size_t)(BK * 2);
    const size_t hstep = (size_t)HALF * K * 2;
    const size_t tstep = 2 * hstep;
    const unsigned ldsw = (unsigned)wid * 1024u;
    const int aoff = lds_byte(wr * 64 + fr, fq * 8), boff = lds_byte(wc * 32 + fr, fq * 8);
#define PG8_SA(b, h) (((b) * 2 + (h)) * HTB)
#define PG8_SB(b, h) ((4 + (b) * 2 + (h)) * HTB)
#define PG8_STAGE(bufoff, gbase, voff) do { _Pragma("unroll") for (int _i = 0; _i < 2; ++_i) \
        __builtin_amdgcn_global_load_lds((const unsigned*)((const char*)(gbase) + (voff)[_i]), (PG8_LAS unsigned*)(lds + (bufoff) + ldsw + _i * 8192), 16, 0, 0); } while (0)
#define PG8_LDA(dst, b, h) do { _Pragma("unroll") for (int m = 0; m < 4; ++m) _Pragma("unroll") for (int k = 0; k < 2; ++k) dst[m][k] = *(const PG8_LAS bf16x8*)(lds + PG8_SA(b, h) + aoff + m * 2048 + k * 1024); } while (0)
#define PG8_LDB(dst, b, h) do { _Pragma("unroll") for (int n = 0; n < 2; ++n) _Pragma("unroll") for (int k = 0; k < 2; ++k) dst[n][k] = *(const PG8_LAS bf16x8*)(lds + PG8_SB(b, h) + boff + n * 2048 + k * 1024); } while (0)
#define PG8_MMA(ai, bj, At, Bt) do { __builtin_amdgcn_s_setprio(1); _Pragma("unroll") for (int m = 0; m < 4; ++m) _Pragma("unroll") for (int n = 0; n < 2; ++n) _Pragma("unroll") for (int k = 0; k < 2; ++k) \
        acc[ai][bj][m][n] = __builtin_amdgcn_mfma_f32_16x16x32_bf16(Bt[n][k], At[m][k], acc[ai][bj][m][n], 0, 0, 0); __builtin_amdgcn_s_setprio(0); } while (0)
#define PG8_WAIT_V(n) asm volatile("s_waitcnt vmcnt(" #n ")" ::: "memory")
#define PG8_WAIT_L(n) asm volatile("s_waitcnt lgkmcnt(" #n ")" ::: "memory")
#define PG8_BAR __builtin_amdgcn_s_barrier()
#define PG8_SCHED __builtin_amdgcn_sched_barrier(0)
    Unit cur, nxt; int ui = 0;
    if (!S.next(0, cur)) return;
    f32x4 acc[2][2][4][2];
#pragma unroll
    for (int a = 0; a < 2; ++a)
#pragma unroll
        for (int b = 0; b < 2; ++b)
#pragma unroll
            for (int m = 0; m < 4; ++m)
#pragma unroll
                for (int n = 0; n < 2; ++n) acc[a][b][m][n] = (f32x4){0.f, 0.f, 0.f, 0.f};
    bf16x8 At[4][2], B0[2][2], B1[2][2];
    const char* cA = (const char*)g.A + (size_t)cur.pm * tstep + (size_t)cur.k0 * kstep; const char* cB = (const char*)g.Bt + (size_t)cur.pn * tstep + (size_t)cur.k0 * kstep;
    S.a_ready(cur);
    if constexpr (SP2) {
        PG8_STAGE(PG8_SB(0, 0), cB, voffB); PG8_STAGE(PG8_SB(0, 1), cB + hstep, voffB); PG8_STAGE(PG8_SA(0, 0), cA, voffA); PG8_STAGE(PG8_SA(0, 1), cA + hstep, voffA);
        if (wr == 1) PG8_BAR;
        PG8_WAIT_V(2); PG8_BAR;
        PG8_STAGE(PG8_SB(1, 0), cB + kstep, voffB); PG8_STAGE(PG8_SA(1, 0), cA + kstep, voffA); PG8_STAGE(PG8_SB(1, 1), cB + hstep + kstep, voffB);
        PG8_WAIT_V(6); PG8_BAR;
    } else {
        PG8_STAGE(PG8_SB(0, 0), cB, voffB); PG8_STAGE(PG8_SA(0, 0), cA, voffA); PG8_STAGE(PG8_SB(0, 1), cB + hstep, voffB); PG8_STAGE(PG8_SA(0, 1), cA + hstep, voffA);
        if (wr == 1) PG8_BAR;
        PG8_WAIT_V(4); PG8_BAR;
        PG8_STAGE(PG8_SB(1, 0), cB + kstep, voffB); PG8_STAGE(PG8_SA(1, 0), cA + kstep, voffA); PG8_STAGE(PG8_SB(1, 1), cB + hstep + kstep, voffB);
        PG8_WAIT_V(6); PG8_BAR;
    }
    for (;;) {
        const bool has_next = S.next(ui + 1, nxt);
        const char* nA = has_next ? (const char*)g.A + (size_t)nxt.pm * tstep + (size_t)nxt.k0 * kstep : cA; const char* nB = has_next ? (const char*)g.Bt + (size_t)nxt.pn * tstep + (size_t)nxt.k0 * kstep : cB;
        const int nt = cur.nk;
        for (int t = 0; t < nt; t += 2) {
            const bool last = (t == nt - 2);
            const char* a1 = cA + (size_t)(t + 1) * kstep;
            const char* a2 = last ? nA : cA + (size_t)(t + 2) * kstep; const char* b2 = last ? nB : cB + (size_t)(t + 2) * kstep;
            const char* a3 = a2 + kstep; const char* b3 = b2 + kstep;
            if (last && has_next) S.a_ready(nxt);
            if constexpr (SP2) {
            PG8_LDB(B0, 0, 0); PG8_LDB(B1, 0, 1); PG8_SCHED; PG8_LDA(At, 0, 0); PG8_STAGE(PG8_SA(1, 1), a1 + hstep, voffA);
            PG8_WAIT_V(8); PG8_WAIT_L(0); PG8_BAR; PG8_MMA(0, 0, At, B0); PG8_MMA(0, 1, At, B1); PG8_BAR; PG8_SCHED;
            PG8_LDA(At, 0, 1); PG8_STAGE(PG8_SB(0, 0), b2, voffB); PG8_STAGE(PG8_SB(0, 1), b2 + hstep, voffB); PG8_STAGE(PG8_SA(0, 0), a2, voffA);
            PG8_WAIT_V(8); PG8_WAIT_L(0); PG8_BAR; PG8_MMA(1, 0, At, B0); PG8_MMA(1, 1, At, B1); PG8_BAR; PG8_SCHED;
            PG8_LDB(B0, 1, 0); PG8_LDB(B1, 1, 1); PG8_SCHED; PG8_LDA(At, 1, 0); PG8_STAGE(PG8_SA(0, 1), a2 + hstep, voffA);
            PG8_WAIT_V(8); PG8_WAIT_L(0); PG8_BAR; PG8_MMA(0, 0, At, B0); PG8_MMA(0, 1, At, B1); PG8_BAR; PG8_SCHED;
            PG8_LDA(At, 1, 1); PG8_STAGE(PG8_SB(1, 0), b3, voffB); PG8_STAGE(PG8_SB(1, 1), b3 + hstep, voffB); PG8_STAGE(PG8_SA(1, 0), a3, voffA);
            PG8_WAIT_V(8); PG8_WAIT_L(0); PG8_BAR; PG8_MMA(1, 0, At, B0); PG8_MMA(1, 1, At, B1); PG8_BAR; PG8_SCHED;
            } else {
            PG8_LDB(B0, 0, 0); PG8_SCHED; PG8_LDA(At, 0, 0); PG8_STAGE(PG8_SA(1, 1), a1 + hstep, voffA);
            PG8_WAIT_L(8); PG8_BAR; PG8_WAIT_L(0); PG8_MMA(0, 0, At, B0); PG8_BAR; PG8_SCHED;
            PG8_LDB(B1, 0, 1); PG8_STAGE(PG8_SB(0, 0), b2, voffB);
            PG8_BAR; PG8_WAIT_L(0); PG8_MMA(0, 1, At, B1); PG8_BAR;
            PG8_LDA(At, 0, 1); PG8_STAGE(PG8_SA(0, 0), a2, voffA);
            PG8_BAR; PG8_WAIT_L(0); PG8_MMA(1, 0, At, B0); PG8_BAR; PG8_SCHED;
            PG8_STAGE(PG8_SB(0, 1), b2 + hstep, voffB);
            PG8_WAIT_V(6); PG8_BAR; PG8_MMA(1, 1, At, B1); PG8_BAR;
            PG8_LDB(B0, 1, 0); PG8_SCHED; PG8_LDA(At, 1, 0); PG8_STAGE(PG8_SA(0, 1), a2 + hstep, voffA);
            PG8_WAIT_L(8); PG8_BAR; PG8_WAIT_L(0); PG8_MMA(0, 0, At, B0); PG8_BAR; PG8_SCHED;
            PG8_LDB(B1, 1, 1); PG8_STAGE(PG8_SB(1, 0), b3, voffB);
            PG8_BAR; PG8_WAIT_L(0); PG8_MMA(0, 1, At, B1); PG8_BAR;
            PG8_LDA(At, 1, 1); PG8_STAGE(PG8_SA(1, 0), a3, voffA);
            PG8_BAR; PG8_WAIT_L(0); PG8_MMA(1, 0, At, B0); PG8_BAR; PG8_SCHED;
            PG8_STAGE(PG8_SB(1, 1), b3 + hstep, voffB);
            PG8_WAIT_V(6); PG8_BAR; PG8_MMA(1, 1, At, B1); PG8_BAR;
            }
        }
        if constexpr (ALIGN_EPI) { if (wr == 0) PG8_BAR; }
        if constexpr (!Epi::AFTER_DRAIN) { E(acc, cur, wr, wc, fr, fq); S.done(cur); }
        if (!has_next) break;
#pragma unroll
        for (int a = 0; a < 2; ++a)
#pragma unroll
            for (int b = 0; b < 2; ++b)
#pragma unroll
                for (int m = 0; m < 4; ++m)
#pragma unroll
                    for (int n = 0; n < 2; ++n) acc[a][b][m][n] = (f32x4){0.f, 0.f, 0.f, 0.f};
        cur = nxt; cA = nA; cB = nB; ++ui;
        if constexpr (ALIGN_EPI) { if (wr == 1) PG8_BAR; }
    }
    PG8_WAIT_V(0);
    if constexpr (!ALIGN_EPI) { if (wr == 0) PG8_BAR; }
    PG8_BAR;
#undef PG8_SA
#undef PG8_SB
#undef PG8_STAGE
#undef PG8_LDA
#undef PG8_LDB
#undef PG8_MMA
#undef PG8_WAIT_V
#undef PG8_WAIT_L
#undef PG8_BAR
#undef PG8_SCHED
}
}

constexpr int NWAVES = 8;
constexpr int MP = 8192, MS = 512, MT = MP + MS;
constexpr int DM = 2048, NPROJ = 5632, DIN = 5648, DFF = 5632, NH = 8, NSH = 16;
constexpr int NCHUNK = 128 + 32;
constexpr float EPS = 1e-6f;
constexpr float LOG2E = 1.4426950408889634f;
constexpr float QSCALE = 0.125f * LOG2E;
constexpr float LAM_INIT = 0.2f;

constexpr size_t O_Y = 0, O_KP = 17825792, O_VP = 26214400, O_CP = 34603008, O_SP = 34607616, O_FP = 34738688,
                 O_KS = 34749952, O_VS = 35274240, O_CS = 35798528, O_SS = 35945984, O_FS = 40140288, O_END = 40500736;

constexpr size_t MiB = 1u << 20;
constexpr size_t WS_CTL = 0, CTL_ZERO_BYTES = 64 * 1024;
constexpr size_t WS_WIN = 2 * MiB, WS_WOUT = 24 * MiB, WS_WGU = 32 * MiB, WS_WDN = 76 * MiB, WS_XN = 98 * MiB;
constexpr size_t WS_Q = 132 * MiB, WS_K = 150 * MiB, WS_V = 168 * MiB, WS_Z = 186 * MiB, WS_XBC = 204 * MiB, WS_DT = 230 * MiB;
constexpr size_t WS_ACUM = 235 * MiB, WS_CD = 236 * MiB, WS_CB = 237 * MiB, WS_A2 = 243 * MiB, WS_SCH = 277 * MiB, WS_HPREV = 357 * MiB, WS_YP = 397 * MiB;
constexpr size_t WS_RS1 = 437 * MiB, WS_RS2 = 439 * MiB, WS_FRG = 441 * MiB, WS_FRU = 443 * MiB, WS_LRG = 445 * MiB, WS_RSTD1 = 447 * MiB, WS_END = 448 * MiB;
constexpr size_t WS_HID = 132 * MiB, WS_G = 226 * MiB, WS_U = 320 * MiB;
constexpr size_t WS_SLAB5 = WS_Q, WS_SLAB9 = WS_G;
static_assert(WS_U + (size_t)MT * DFF * 2 <= WS_RS1, "ffn overlay");
constexpr int CW_BAR = 4096, CW_QK = 8192, CW_QUEUE = 8320, CW_LDONE = 8384, CW_SDONE = 8448;

constexpr int LDS_BYTES = 147456, LDSCTL_OFF = 146432;

#define GAS __attribute__((address_space(1)))
#define LAS __attribute__((address_space(3)))
typedef unsigned short bf16;
typedef unsigned v4u __attribute__((ext_vector_type(4)));
typedef unsigned v2u __attribute__((ext_vector_type(2)));
typedef float f32x2 __attribute__((ext_vector_type(2)));
typedef float f32x4 __attribute__((ext_vector_type(4)));
typedef float f32x8 __attribute__((ext_vector_type(8)));
typedef float f32x16 __attribute__((ext_vector_type(16)));
typedef short bf16x8 __attribute__((ext_vector_type(8)));
typedef short s16x4 __attribute__((ext_vector_type(4)));
typedef GAS unsigned gu32;

__device__ __forceinline__ unsigned f2bf(float f) { unsigned u = __builtin_bit_cast(unsigned, f); return (u + 0x7fffu + ((u >> 16) & 1u)) >> 16; }
__device__ __forceinline__ unsigned pk2(float lo, float hi) { return pg8::cvt_pk_bf16(lo, hi); }
__device__ __forceinline__ float bf2f(unsigned short b) { return __builtin_bit_cast(float, (unsigned)b << 16); }
__device__ __forceinline__ float bflo(unsigned w) { return __builtin_bit_cast(float, w << 16); }
__device__ __forceinline__ float bfhi(unsigned w) { return __builtin_bit_cast(float, w & 0xffff0000u); }
__device__ __forceinline__ float wave_sum(float v) {
#pragma unroll
    for (int o = 1; o < 64; o <<= 1) v += __shfl_xor(v, o);
    return v;
}
__device__ __forceinline__ float siluf(float x) { return x * __builtin_amdgcn_rcpf(1.f + __builtin_amdgcn_exp2f(-LOG2E * x)); }

#define XB_TMO      128
#define XB_XCNT(j)  (256  + 64 * (j))
#define XB_XSUB(j)  (1280 + 64 * (j))
#define XB_XGEN(j)  (2304 + 64 * (j))
#define XB_TOP      3328
#define XB_TOPGEN   3392
#define XCD_BAR_WORDS 3456
#define XB_SPIN_CAP (1u << 18)
__device__ __forceinline__ unsigned xb_ld(unsigned* p)              { return __hip_atomic_load(p, __ATOMIC_RELAXED, __HIP_MEMORY_SCOPE_AGENT); }
__device__ __forceinline__ unsigned xb_add(unsigned* p, unsigned v) { return __hip_atomic_fetch_add(p, v, __ATOMIC_RELAXED, __HIP_MEMORY_SCOPE_AGENT); }
__device__ __forceinline__ unsigned xb_xcc_id() { return (unsigned)__builtin_amdgcn_s_getreg((3 << 11) | 20) & 0xFu; }
#define XB_SPIN(cond, bar) do { unsigned _sp = 0; while (cond) { __builtin_amdgcn_s_sleep(1); \
    if ((++_sp & 255u) == 0u) { if (xb_ld(&(bar)[XB_TMO])) break; if (_sp > XB_SPIN_CAP) { atomicAdd(&(bar)[XB_TMO], 1u); break; } } } } while (0)
struct XcdBarrier { unsigned* bar; unsigned x; volatile LAS unsigned* st; };
__device__ __forceinline__ XcdBarrier xcd_barrier_post(unsigned* bar, volatile LAS unsigned* st) {
    XcdBarrier b; b.bar = bar; b.x = xb_xcc_id(); b.st = st;
    if (threadIdx.x == 0) (void)xb_add(&bar[XB_XCNT(b.x)], 1u);
    return b;
}
__device__ __forceinline__ void xcd_barrier_complete(unsigned* bar, unsigned x, unsigned& nloc, unsigned& nx) {
    const unsigned G = gridDim.x * gridDim.y * gridDim.z;
    unsigned sum, cnt, mine, sp = 0u;
    for (;;) {
        sum = 0u; cnt = 0u; mine = 0u;
#pragma unroll
        for (unsigned j = 0; j < 16; ++j) { const unsigned c = xb_ld(&bar[XB_XCNT(j)]); sum += c; cnt += (c > 0u) ? 1u : 0u; mine = (j == x) ? c : mine; }
        if (sum == G) break;
        __builtin_amdgcn_s_sleep(1);
        if ((++sp & 255u) == 0u) { if (xb_ld(&bar[XB_TMO])) break; if (sp > XB_SPIN_CAP) { atomicAdd(&bar[XB_TMO], 1u); break; } }
    }
    nloc = mine > 0u ? mine : 1u; nx = cnt > 0u ? cnt : 1u;
}
__device__ __forceinline__ void xcd_barrier(const XcdBarrier& b) {
    asm volatile("s_waitcnt vmcnt(0)" ::: "memory");
    __syncthreads();
    if (threadIdx.x == 0) {
        unsigned* bar = b.bar;
        __builtin_amdgcn_s_waitcnt(0);
        unsigned nloc = b.st[0], nx = b.st[1];
        if (nloc == 0u) { xcd_barrier_complete(bar, b.x, nloc, nx); b.st[0] = nloc; b.st[1] = nx; }
        const unsigned old = xb_add(&bar[XB_XSUB(b.x)], 1u);
        const unsigned gen = old / nloc;
        if (old + 1u == (gen + 1u) * nloc) {
            __builtin_amdgcn_fence(__ATOMIC_RELEASE, "agent");
            asm volatile("s_waitcnt vmcnt(0)" ::: "memory");
            const unsigned og = xb_add(&bar[XB_TOP], 1u);
            const unsigned tg = og / nx;
            if (og + 1u == (tg + 1u) * nx) xb_add(&bar[XB_TOPGEN], 1u);
            else XB_SPIN(xb_ld(&bar[XB_TOPGEN]) == tg, bar);
            __builtin_amdgcn_fence(__ATOMIC_ACQUIRE, "agent");
            xb_add(&bar[XB_XGEN(b.x)], 1u);
            asm volatile("s_waitcnt vmcnt(0)" ::: "memory");
        } else {
            XB_SPIN(xb_ld(&bar[XB_XGEN(b.x)]) == gen, bar);
            __builtin_amdgcn_fence(__ATOMIC_ACQUIRE, "agent");
            asm volatile("s_waitcnt vmcnt(0)" ::: "memory");
        }
    }
    __syncthreads();
}

struct Args {
    const float* in[28];
    float* out; unsigned char* ws;
    int ph_lo, ph_hi, li, pad;
};
enum { I_XP = 0, I_XS, I_CK, I_CV, I_SCONV, I_SSM, I_SFFN, I_GMIX, I_WIN, I_LQ1, I_LK1, I_LQ2, I_LK2, I_GSUB, I_CONVW, I_CONVB, I_DTB, I_ALOG, I_DSKIP,
       I_GSSM, I_WOUT, I_GFFN, I_WGATE, I_WUP, I_FCW, I_FCB, I_WDOWN, I_GFIN };

struct P0Item { const float* W; const float* g; bf16* WT; int ldw, K, k0, n0, rowbase; };
__device__ __forceinline__ void p0_load(const P0Item& it, f32x4 (&v)[16], int lane) {
    const int rsub = lane >> 4, c4 = 4 * (lane & 15);
#pragma unroll
    for (int i = 0; i < 16; ++i) v[i] = *(const f32x4*)(it.W + (size_t)(it.k0 + 4 * i + rsub) * it.ldw + it.n0 + c4);
}
__device__ __forceinline__ void p0_to_lds(const P0Item& it, const f32x4 (&v)[16], LAS float* scr, int lane) {
    const int rsub = lane >> 4, c4 = 4 * (lane & 15);
#pragma unroll
    for (int i = 0; i < 16; ++i) { const int r = 4 * i + rsub; f32x4 x = v[i]; if (it.g) x = x * it.g[it.k0 + r];
        LAS float* d = scr + r * 65 + c4; d[0] = x[0]; d[1] = x[1]; d[2] = x[2]; d[3] = x[3]; }
    asm volatile("s_waitcnt lgkmcnt(0)" ::: "memory");
}
__device__ __forceinline__ void p0_store(const P0Item& it, LAS float* scr, int lane) {
    const int c = lane & 7;
#pragma unroll
    for (int j = 0; j < 8; ++j) { const int n = (lane >> 3) + 8 * j; const LAS float* sp = scr + (8 * c) * 65 + n;
        v4u o; o.x = pk2(sp[0 * 65], sp[1 * 65]); o.y = pk2(sp[2 * 65], sp[3 * 65]); o.z = pk2(sp[4 * 65], sp[5 * 65]); o.w = pk2(sp[6 * 65], sp[7 * 65]);
        *(GAS v4u*)(it.WT + (size_t)(it.rowbase + n) * it.K + it.k0 + 8 * c) = o; }
    asm volatile("s_waitcnt lgkmcnt(0)" ::: "memory");
}
__device__ __forceinline__ P0Item p0_item(const Args& A, unsigned char* ws, int r) {
    constexpr int I_A = 32 * 88, I_B = 32 * 32, I_C = 32 * 88, I_D = 32 * 88;
    P0Item it;
    if (r < I_A) { it = P0Item{A.in[I_WIN], nullptr, (bf16*)(ws + WS_WIN), DIN, DM, 64 * (r / 88), 64 * (r % 88), 64 * (r % 88)}; return it; } r -= I_A;
    if (r < I_B) { it = P0Item{A.in[I_WOUT], nullptr, (bf16*)(ws + WS_WOUT), DM, DM, 64 * (r / 32), 64 * (r % 32), 64 * (r % 32)}; return it; } r -= I_B;
    if (r < I_C) { const int n0 = 64 * (r % 88); it = P0Item{A.in[I_WGATE], A.in[I_GFFN], (bf16*)(ws + WS_WGU), DFF, DM, 64 * (r / 88), n0, (n0 >> 7) * 256 + (n0 & 127)}; return it; } r -= I_C;
    if (r < I_D) { const int n0 = 64 * (r % 88); it = P0Item{A.in[I_WUP], A.in[I_GFFN], (bf16*)(ws + WS_WGU), DFF, DM, 64 * (r / 88), n0, (n0 >> 7) * 256 + 128 + (n0 & 127)}; return it; } r -= I_D;
    it = P0Item{A.in[I_WDOWN], nullptr, (bf16*)(ws + WS_WDN), DM, DFF, 64 * (r / 32), 64 * (r % 32), 64 * (r % 32)}; return it;
}

struct EpiInProj {
    static constexpr bool PERM = true, AFTER_DRAIN = false;
    bf16 *Q, *K, *V, *Z, *XBC; float* out; unsigned* qk2;
    __device__ __forceinline__ void operator()(const pg8::f32x4 (&acc)[2][2][4][2], const pg8::Unit& u, int wr, int wc, int fr, int fq) const {
        const int region = u.pn >> 2;
        float nmax[2] = {0.f, 0.f};
        const int row0 = u.pm * 256 + wr * 64 + fr;
        const int cl = wc * 32 + 8 * fq;
#pragma unroll
        for (int ai = 0; ai < 2; ++ai)
#pragma unroll
            for (int m = 0; m < 4; ++m) {
                const int row = row0 + ai * 128 + m * 16;
#pragma unroll
                for (int bj = 0; bj < 2; ++bj) {
                    f32x4 v0 = acc[ai][bj][m][0], v1 = acc[ai][bj][m][1];
                    if (region < 4) {
                        const int c = (u.pn & 3) * 256 + bj * 128 + cl;
                        if (region == 0) { v0 = v0 * QSCALE; v1 = v1 * QSCALE; }
                        if (region < 2) { float ss = (v0[0] * v0[0] + v0[1] * v0[1]) + (v0[2] * v0[2] + v0[3] * v0[3]) + (v1[0] * v1[0] + v1[1] * v1[1]) + (v1[2] * v1[2] + v1[3] * v1[3]);
                            ss += __shfl_xor(ss, 16); ss += __shfl_xor(ss, 32); nmax[bj] = fmaxf(nmax[bj], ss); }
                        v4u w; w.x = pk2(v0[0], v0[1]); w.y = pk2(v0[2], v0[3]); w.z = pk2(v1[0], v1[1]); w.w = pk2(v1[2], v1[3]);
                        bf16* dst = region == 0 ? Q : region == 1 ? K : region == 2 ? V : Z;
                        *(v4u*)(dst + (size_t)row * 1024 + c) = w;
                        if (region == 1 || region == 2) {
                            float* o = out + (row < MP ? (region == 1 ? O_KP : O_VP) + (size_t)row * 1024 : (region == 1 ? O_KS : O_VS) + (size_t)(row - MP) * 1024) + c;
                            *(f32x4*)o = v0; *(f32x4*)(o + 4) = v1;
                        }
                    } else {
                        const int c = (u.pn - 16) * 256 + bj * 128 + cl;
                        v4u w; w.x = pk2(v0[0], v0[1]); w.y = pk2(v0[2], v0[3]); w.z = pk2(v1[0], v1[1]); w.w = pk2(v1[2], v1[3]);
                        *(v4u*)(XBC + (size_t)row * 1536 + c) = w;
                        if (row >= MP - 3) {
                            float* o = nullptr;
                            if (row < MP) o = out + O_CP + (size_t)(row - (MP - 3)) * 1536 + c;
                            else { const int rr = row - MP, i = rr & 15; if (i >= 13) o = out + O_CS + (size_t)((rr >> 4) * 3 + (i - 13)) * 1536 + c; }
                            if (o) { *(f32x4*)o = v0; *(f32x4*)(o + 4) = v1; }
                        }
                    }
                }
            }
        if (region < 2 && u.pm < MP / 256) {
#pragma unroll
            for (int bj = 0; bj < 2; ++bj) { float v = nmax[bj]; v = fmaxf(v, __shfl_xor(v, 1)); v = fmaxf(v, __shfl_xor(v, 2)); v = fmaxf(v, __shfl_xor(v, 4)); v = fmaxf(v, __shfl_xor(v, 8));
                if (fr == 0 && fq == 0) atomicMax(qk2 + region * 32 + (u.pn & 3) * 8 + bj * 4 + wc, __float_as_uint(v)); }
        }
    }
};

__device__ __forceinline__ void store_slab(float* slab, const pg8::f32x4 (&acc)[2][2][4][2], int wr, int wc, int fr, int fq) {
#pragma unroll
    for (int ai = 0; ai < 2; ++ai)
#pragma unroll
        for (int m = 0; m < 4; ++m)
#pragma unroll
            for (int bj = 0; bj < 2; ++bj) { float* o = slab + (size_t)(ai * 128 + wr * 64 + m * 16 + fr) * 256 + bj * 128 + wc * 32 + 8 * fq; *(f32x4*)o = acc[ai][bj][m][0]; *(f32x4*)(o + 4) = acc[ai][bj][m][1]; }
}

struct EpiOutProj {
    static constexpr bool PERM = true, AFTER_DRAIN = false;
    const float* xp; const float* xs; float* out; bf16* x1b; float* rs; float* slabs;
    __device__ __forceinline__ void operator()(const pg8::f32x4 (&acc)[2][2][4][2], const pg8::Unit& u, int wr, int wc, int fr, int fq) const {
        if (u.slab >= 0) { store_slab(slabs + (size_t)u.slab * 65536, acc, wr, wc, fr, fq); return; }
        const int row0 = u.pm * 256 + wr * 64 + fr;
        const int c0 = u.pn * 256 + wc * 32 + 8 * fq;
#pragma unroll
        for (int ai = 0; ai < 2; ++ai)
#pragma unroll
        for (int mh = 0; mh < 2; ++mh) {
            f32x4 xr[2][2][2];
#pragma unroll
            for (int m = 0; m < 2; ++m) { const int row = row0 + ai * 128 + (2 * mh + m) * 16; const float* xrow = row < MP ? xp + (size_t)row * DM : xs + (size_t)(row - MP) * DM;
#pragma unroll
                for (int bj = 0; bj < 2; ++bj) { xr[m][bj][0] = *(const f32x4*)(xrow + c0 + bj * 128); xr[m][bj][1] = *(const f32x4*)(xrow + c0 + bj * 128 + 4); } }
            asm volatile("" ::: "memory");
#pragma unroll
            for (int m = 0; m < 2; ++m) {
                const int mm = 2 * mh + m, row = row0 + ai * 128 + mm * 16;
                float ss = 0.f;
#pragma unroll
                for (int bj = 0; bj < 2; ++bj) {
                    const int c = c0 + bj * 128;
                    const f32x4 v0 = acc[ai][bj][mm][0] + xr[m][bj][0], v1 = acc[ai][bj][mm][1] + xr[m][bj][1];
                    v4u w; w.x = pk2(v0[0], v0[1]); w.y = pk2(v0[2], v0[3]); w.z = pk2(v1[0], v1[1]); w.w = pk2(v1[2], v1[3]);
                    *(v4u*)(x1b + (size_t)row * DM + c) = w;
                    ss += (v0[0] * v0[0] + v0[1] * v0[1]) + (v0[2] * v0[2] + v0[3] * v0[3]) + (v1[0] * v1[0] + v1[1] * v1[1]) + (v1[2] * v1[2] + v1[3] * v1[3]);
                }
                ss += __shfl_xor(ss, 16); ss += __shfl_xor(ss, 32);
                if (fq == 0) rs[(size_t)row * 32 + u.pn * 4 + wc] = ss;
            }
        }
    }
};


constexpr int HALO_OFF = 131072;
struct EpiGateUp {
    static constexpr bool PERM = true, AFTER_DRAIN = false;
    bf16* HID; const float* rs; float* out; const float* fcw; const float* fcb; const float* sffn; float* frg; float* fru; float* lrg; LAS unsigned char* lds;
    __device__ __forceinline__ void operator()(const pg8::f32x4 (&acc)[2][2][4][2], const pg8::Unit& u, int wr, int wc, int fr, int fq) const {
        const int row0 = u.pm * 256 + wr * 64 + fr;
        const int cl = wc * 32 + 8 * fq, c = u.pn * 128 + cl;
        const bool sample = u.pm >= MP / 256;
        f32x4 w0[2], w1[2], w2[2], bb[2];
#pragma unroll
        for (int n = 0; n < 2; ++n) { w0[n] = *(const f32x4*)(fcw + c + 4 * n); w1[n] = *(const f32x4*)(fcw + DFF + c + 4 * n); w2[n] = *(const f32x4*)(fcw + 2 * DFF + c + 4 * n); bb[n] = *(const f32x4*)(fcb + c + 4 * n); }
        float rstd8[2][4];
#pragma unroll
        for (int ai = 0; ai < 2; ++ai)
#pragma unroll
            for (int m = 0; m < 4; ++m) rstd8[ai][m] = rs[row0 + ai * 128 + m * 16];
        LAS float* halo = (LAS float*)(lds + HALO_OFF);
        if (!sample) {
#pragma unroll
            for (int ai = 0; ai < 2; ++ai) {
                const float r3 = rstd8[ai][3];
                if (fr >= 14) { LAS float* hp = halo + ((2 * ai + wr) * 2 + (fr - 14)) * 128 + cl; *(LAS f32x4*)hp = acc[ai][0][3][0] * r3; *(LAS f32x4*)(hp + 4) = acc[ai][0][3][1] * r3; }
            }
        }
        asm volatile("s_waitcnt lgkmcnt(0)" ::: "memory"); __builtin_amdgcn_s_barrier(); asm volatile("" ::: "memory");
#pragma unroll
        for (int ai = 0; ai < 2; ++ai) {
            f32x4 gprev[2] = {(f32x4){0.f, 0.f, 0.f, 0.f}, (f32x4){0.f, 0.f, 0.f, 0.f}};
#pragma unroll
            for (int m = 0; m < 4; ++m) {
                const int row = row0 + ai * 128 + m * 16;
                const float rstd = rstd8[ai][m];
                f32x4 gc[2] = {acc[ai][0][m][0] * rstd, acc[ai][0][m][1] * rstd};
                f32x4 pv[2];
                bool defer = false;
                if (sample) {
                    const int b = (row - fr - MP) >> 4;
                    const float* sp = sffn + ((size_t)b * 2 + (fr & 1)) * DFF + c;
                    pv[0] = *(const f32x4*)sp; pv[1] = *(const f32x4*)(sp + 4);
                } else if (m > 0) { pv[0] = gprev[0]; pv[1] = gprev[1]; }
                else {
                    const int gidx = 2 * ai + wr;
                    if (gidx > 0) { const LAS float* hp = halo + ((gidx - 1) * 2 + (fr & 1)) * 128 + cl; pv[0] = *(const LAS f32x4*)hp; pv[1] = *(const LAS f32x4*)(hp + 4); }
                    else { pv[0] = (f32x4){0.f, 0.f, 0.f, 0.f}; pv[1] = pv[0]; defer = u.pm > 0; }
                }
                const f32x4 u0 = acc[ai][1][m][0] * rstd, u1 = acc[ai][1][m][1] * rstd;
                f32x4 h[2];
#pragma unroll
                for (int n = 0; n < 2; ++n)
#pragma unroll
                    for (int e = 0; e < 4; ++e) {
                        const float cur = gc[n][e], pvv = pv[n][e];
                        const int ci = __float_as_int(cur), pi_ = __float_as_int(pvv);
                        const float g1 = __int_as_float(__builtin_amdgcn_update_dpp(__builtin_amdgcn_update_dpp(0, pi_, 0x121, 0xf, 0xf, false), ci, 0x111, 0xf, 0xf, false));
                        const float g2 = __int_as_float(__builtin_amdgcn_update_dpp(__builtin_amdgcn_update_dpp(0, pi_, 0x122, 0xf, 0xf, false), ci, 0x112, 0xf, 0xf, false));
                        const float y = bb[n][e] + w0[n][e] * g2 + w1[n][e] * g1 + w2[n][e] * cur;
                        h[n][e] = siluf(y) * (n == 0 ? u0[e] : u1[e]);
                    }
                if (defer && fr < 2) {
                    float* o = frg + ((size_t)u.pm * 2 + fr) * DFF + c; *(f32x4*)o = gc[0]; *(f32x4*)(o + 4) = gc[1];
                    o = fru + ((size_t)u.pm * 2 + fr) * DFF + c; *(f32x4*)o = u0; *(f32x4*)(o + 4) = u1;
                } else {
                    v4u w; w.x = pk2(h[0][0], h[0][1]); w.y = pk2(h[0][2], h[0][3]); w.z = pk2(h[1][0], h[1][1]); w.w = pk2(h[1][2], h[1][3]);
                    *(v4u*)(HID + (size_t)row * DFF + c) = w;
                }
                if (!sample && ai == 1 && m == 3 && wr == 1 && fr >= 14) { float* o = lrg + ((size_t)u.pm * 2 + (fr - 14)) * DFF + c; *(f32x4*)o = gc[0]; *(f32x4*)(o + 4) = gc[1]; }
                if (row >= MP - 2) {
                    float* o = nullptr;
                    if (row < MP) o = out + O_FP + (size_t)(row - (MP - 2)) * DFF + c;
                    else { const int rr = row - MP, i = rr & 15; if (i >= 14) o = out + O_FS + (size_t)((rr >> 4) * 2 + (i - 14)) * DFF + c; }
                    if (o) { *(f32x4*)o = gc[0]; *(f32x4*)(o + 4) = gc[1]; }
                }
                gprev[0] = gc[0]; gprev[1] = gc[1];
            }
        }
    }
};

struct EpiDown {
    static constexpr bool PERM = true, AFTER_DRAIN = false;
    float* out; float* rs; float* slabs; bf16* x2b;
    __device__ __forceinline__ void operator()(const pg8::f32x4 (&acc)[2][2][4][2], const pg8::Unit& u, int wr, int wc, int fr, int fq) const {
        if (u.slab >= 0) { store_slab(slabs + (size_t)u.slab * 65536, acc, wr, wc, fr, fq); return; }
        const int row0 = u.pm * 256 + wr * 64 + fr;
        const int c0 = u.pn * 256 + wc * 32 + 8 * fq;
#pragma unroll
        for (int ai = 0; ai < 2; ++ai)
#pragma unroll
        for (int mh = 0; mh < 2; ++mh) {
            f32x4 xr[2][2][2];
#pragma unroll
            for (int m = 0; m < 2; ++m) { const bf16* xrow = x2b + (size_t)(row0 + ai * 128 + (2 * mh + m) * 16) * DM;
#pragma unroll
                for (int bj = 0; bj < 2; ++bj) { const v4u w = *(const v4u*)(xrow + c0 + bj * 128);
                    xr[m][bj][0] = (f32x4){bflo(w.x), bfhi(w.x), bflo(w.y), bfhi(w.y)}; xr[m][bj][1] = (f32x4){bflo(w.z), bfhi(w.z), bflo(w.w), bfhi(w.w)}; } }
            asm volatile("" ::: "memory");
#pragma unroll
            for (int m = 0; m < 2; ++m) {
                const int mm = 2 * mh + m, row = row0 + ai * 128 + mm * 16;
                float ss = 0.f;
#pragma unroll
                for (int bj = 0; bj < 2; ++bj) {
                    const f32x4 v0 = acc[ai][bj][mm][0] + xr[m][bj][0], v1 = acc[ai][bj][mm][1] + xr[m][bj][1];
                    v4u w; w.x = pk2(v0[0], v0[1]); w.y = pk2(v0[2], v0[3]); w.z = pk2(v1[0], v1[1]); w.w = pk2(v1[2], v1[3]);
                    *(v4u*)(x2b + (size_t)row * DM + c0 + bj * 128) = w;
                    ss += (v0[0] * v0[0] + v0[1] * v0[1]) + (v0[2] * v0[2] + v0[3] * v0[3]) + (v1[0] * v1[0] + v1[1] * v1[1]) + (v1[2] * v1[2] + v1[3] * v1[3]);
                }
                ss += __shfl_xor(ss, 16); ss += __shfl_xor(ss, 32);
                if (fq == 0) rs[(size_t)row * 32 + u.pn * 4 + wc] = ss;
            }
        }
    }
};

__device__ __forceinline__ int crow(int r, int hi) { return (r & 3) + 8 * (r >> 2) + 4 * hi; }
#define MFMA32(a, b, c) __builtin_amdgcn_mfma_f32_32x32x16_bf16((a), (b), (c), 0, 0, 0)

constexpr int SL_XT = 0, SL_XT_ROW = 144, SL_XT_HEAD = 64 * 144;
constexpr int SL_BN = 73728, SL_N_ROW = 272;
constexpr int SL_CN = SL_BN + 64 * 272;
constexpr int SL_BT = SL_CN + 64 * 272, SL_BT_ROW = 144;
constexpr int SL_DT = SL_BT + 128 * 144;
constexpr int SL_AC = SL_DT + 2048;
constexpr int SL_W = SL_AC + 2048;
constexpr int SL_END = SL_W + 2048;
static_assert(SL_END <= LDSCTL_OFF, "ssd lds");

struct SsdUnit { int cid, g, T, rbase, batch; };
__device__ __forceinline__ SsdUnit ssd_unit(int u) {
    SsdUnit s;
    if (u < 256) { s.cid = u >> 1; s.g = u & 1; s.T = 64; s.rbase = 64 * s.cid; s.batch = -1; }
    else { const int v = u - 256; s.batch = v >> 1; s.g = v & 1; s.cid = 128 + s.batch; s.T = 16; s.rbase = MP + 16 * s.batch; }
    return s;
}

__device__ __forceinline__ void ssd_local(const Args& A, LAS unsigned char* lds, int u) {
    const SsdUnit su = ssd_unit(u);
    int tid_ = threadIdx.x; asm volatile("" : "+v"(tid_));
    const int tid = tid_, lane = tid & 63, wid = __builtin_amdgcn_readfirstlane(tid >> 6), r32 = lane & 31, hi = lane >> 5;
    unsigned char* ws = A.ws;
    const bf16* XBC = (const bf16*)(ws + WS_XBC);
    const float* DT = (const float*)(ws + WS_DT);
    if (tid < 384) {
        const int tq = tid & 3, cgi = tid >> 2, t0 = 16 * tq;
        int col; if (cgi < 64) col = 512 * su.g + 8 * cgi; else if (cgi < 80) col = 1024 + 128 * su.g + 8 * (cgi - 64); else col = 1280 + 128 * su.g + 8 * (cgi - 80);
        unsigned ow[8][8];
        if (t0 < su.T) {
            const float* cw = A.in[I_CONVW]; const float* cbias = A.in[I_CONVB];
            f32x4 wv[4][2], bb[2];
#pragma unroll
            for (int n = 0; n < 2; ++n) { bb[n] = *(const f32x4*)(cbias + col + 4 * n);
#pragma unroll
                for (int k = 0; k < 4; ++k) wv[k][n] = *(const f32x4*)(cw + k * 1536 + col + 4 * n); }
            float hist[3][8];
#pragma unroll
            for (int k = 0; k < 3; ++k) {
                const int t = t0 - 3 + k;
                if (t >= 0 || (su.batch < 0 && su.cid > 0)) {
                    const v4u raw = *(const v4u*)(XBC + (size_t)(su.rbase + t) * 1536 + col);
                    hist[k][0] = bflo(raw.x); hist[k][1] = bfhi(raw.x); hist[k][2] = bflo(raw.y); hist[k][3] = bfhi(raw.y); hist[k][4] = bflo(raw.z); hist[k][5] = bfhi(raw.z); hist[k][6] = bflo(raw.w); hist[k][7] = bfhi(raw.w);
                } else if (su.batch >= 0) {
                    const float* sp = A.in[I_SCONV] + ((size_t)su.batch * 3 + (3 + t)) * 1536 + col;
                    const f32x4 a = *(const f32x4*)sp, b = *(const f32x4*)(sp + 4);
                    hist[k][0] = a[0]; hist[k][1] = a[1]; hist[k][2] = a[2]; hist[k][3] = a[3]; hist[k][4] = b[0]; hist[k][5] = b[1]; hist[k][6] = b[2]; hist[k][7] = b[3];
                } else {
#pragma unroll
                    for (int e = 0; e < 8; ++e) hist[k][e] = 0.f;
                }
            }
            v4u rawv[16];
#pragma unroll
            for (int tt = 0; tt < 16; ++tt) rawv[tt] = *(const v4u*)(XBC + (size_t)(su.rbase + t0 + tt) * 1536 + col);
            float prev[8];
#pragma unroll
            for (int tt = 0; tt < 16; ++tt) {
                const v4u raw = rawv[tt];
                float v[8], o[8]; v[0] = bflo(raw.x); v[1] = bfhi(raw.x); v[2] = bflo(raw.y); v[3] = bfhi(raw.y); v[4] = bflo(raw.z); v[5] = bfhi(raw.z); v[6] = bflo(raw.w); v[7] = bfhi(raw.w);
#pragma unroll
                for (int e = 0; e < 8; ++e) { const float y = bb[e >> 2][e & 3] + wv[0][e >> 2][e & 3] * hist[0][e] + wv[1][e >> 2][e & 3] * hist[1][e] + wv[2][e >> 2][e & 3] * hist[2][e] + wv[3][e >> 2][e & 3] * v[e];
                    o[e] = siluf(y); hist[0][e] = hist[1][e]; hist[1][e] = hist[2][e]; hist[2][e] = v[e]; }
                if (cgi >= 64) {
                    v4u w; w.x = pk2(o[0], o[1]); w.y = pk2(o[2], o[3]); w.z = pk2(o[4], o[5]); w.w = pk2(o[6], o[7]);
                    const int n0 = 8 * ((cgi - 64) & 15), t = t0 + tt;
                    if (cgi < 80) *(LAS v4u*)(lds + SL_BN + t * SL_N_ROW + n0 * 2) = w;
                    else { *(LAS v4u*)(lds + SL_CN + t * SL_N_ROW + n0 * 2) = w; *(v4u*)((bf16*)(ws + WS_CB) + ((size_t)su.cid * 64 + t) * 256 + su.g * 128 + n0) = w; }
                }
                if (tt & 1) {
#pragma unroll
                    for (int e = 0; e < 8; ++e) ow[e][tt >> 1] = pk2(prev[e], o[e]);
                } else {
#pragma unroll
                    for (int e = 0; e < 8; ++e) prev[e] = o[e];
                }
            }
        } else {
#pragma unroll
            for (int e = 0; e < 8; ++e)
#pragma unroll
                for (int k = 0; k < 8; ++k) ow[e][k] = 0u;
            { unsigned z1 = 0u; asm volatile("" : "+v"(z1)); ow[0][0] = z1; }
            if (cgi >= 64) {
                const int n0 = 8 * ((cgi - 64) & 15); unsigned z0 = 0u; asm volatile("" : "+v"(z0)); const v4u z = {z0, z0, z0, z0};
#pragma unroll
                for (int tt = 0; tt < 16; ++tt) { const int t = t0 + tt;
                    if (cgi < 80) *(LAS v4u*)(lds + SL_BN + t * SL_N_ROW + n0 * 2) = z;
                    else { *(LAS v4u*)(lds + SL_CN + t * SL_N_ROW + n0 * 2) = z; *(v4u*)((bf16*)(ws + WS_CB) + ((size_t)su.cid * 64 + t) * 256 + su.g * 128 + n0) = z; } }
            }
        }
        if (cgi < 80) {
            LAS unsigned char* tb_ = cgi < 64 ? lds + SL_XT + (cgi >> 3) * SL_XT_HEAD + (8 * (cgi & 7)) * SL_XT_ROW + t0 * 2 : lds + SL_BT + (8 * (cgi - 64)) * SL_BT_ROW + t0 * 2;
#pragma unroll
            for (int e = 0; e < 8; ++e) { const v4u a = {ow[e][0], ow[e][1], ow[e][2], ow[e][3]}, b = {ow[e][4], ow[e][5], ow[e][6], ow[e][7]};
                *(LAS v4u*)(tb_ + e * SL_XT_ROW) = a; *(LAS v4u*)(tb_ + e * SL_XT_ROW + 16) = b; }
        }
    }
    {
        const int h = 8 * su.g + wid;
        const float dt = lane < su.T ? DT[(size_t)(su.rbase + lane) * 16 + h] : 0.f;
        const float a = -__expf(A.in[I_ALOG][h]);
        float x = dt * a;
#pragma unroll
        for (int off = 1; off < 64; off <<= 1) { const float v = __shfl_up(x, off); if (lane >= off) x += v; }
        const float tot = __shfl(x, 63);
        LAS float* dl = (LAS float*)(lds + SL_DT) + wid * 64; LAS float* al = (LAS float*)(lds + SL_AC) + wid * 64; LAS float* wl = (LAS float*)(lds + SL_W) + wid * 64;
        dl[lane] = dt; al[lane] = x; wl[lane] = __expf(tot - x) * dt;
        ((float*)(ws + WS_ACUM))[((size_t)su.cid * 16 + h) * 64 + lane] = x;
        if (lane == 63) ((float*)(ws + WS_CD))[su.cid * 16 + h] = __expf(tot);
    }
    __syncthreads();
    {
        const int h = 8 * su.g + wid;
        const float dskip = A.in[I_DSKIP][h];
        const LAS unsigned char* bn = lds + SL_BN; const LAS unsigned char* cn = lds + SL_CN; const LAS unsigned char* bt = lds + SL_BT;
        const LAS unsigned char* xt = lds + SL_XT + wid * SL_XT_HEAD;
        const LAS float* dl = (const LAS float*)(lds + SL_DT) + wid * 64; const LAS float* al = (const LAS float*)(lds + SL_AC) + wid * 64; const LAS float* wl = (const LAS float*)(lds + SL_W) + wid * 64;
        f32x16 cb00 = {}, cb01 = {}, cb11 = {};
#pragma unroll
        for (int ks = 0; ks < 8; ++ks) {
            const int kb = (16 * ks + 8 * hi) * 2;
            const bf16x8 b0 = *(const LAS bf16x8*)(bn + r32 * SL_N_ROW + kb), b1 = *(const LAS bf16x8*)(bn + (32 + r32) * SL_N_ROW + kb);
            const bf16x8 c0 = *(const LAS bf16x8*)(cn + r32 * SL_N_ROW + kb), c1 = *(const LAS bf16x8*)(cn + (32 + r32) * SL_N_ROW + kb);
            cb00 = MFMA32(b0, c0, cb00); cb01 = MFMA32(b0, c1, cb01); cb11 = MFMA32(b1, c1, cb11);
        }
        const float at0 = al[r32], at1 = al[32 + r32];
        bf16x8 X00[2], X01[2], X11[2];
        {
            float m00[16], m01[16], m11[16];
#pragma unroll
            for (int r = 0; r < 16; ++r) {
                const int s0 = crow(r, hi), s1 = 32 + s0;
                const float as0 = al[s0], as1 = al[s1], ds0 = dl[s0], ds1 = dl[s1];
                float v = (s0 <= r32) ? cb00[r] * __expf(at0 - as0) * ds0 : 0.f; if (s0 == r32) v += dskip; m00[r] = v;
                m01[r] = cb01[r] * __expf(at1 - as0) * ds0;
                v = (s0 <= r32) ? cb11[r] * __expf(at1 - as1) * ds1 : 0.f; if (s0 == r32) v += dskip; m11[r] = v;
            }
#pragma unroll
            for (int sp = 0; sp < 2; ++sp) {
                v4u w;
                w.x = pk2(m00[8 * sp + 0], m00[8 * sp + 1]); w.y = pk2(m00[8 * sp + 2], m00[8 * sp + 3]); w.z = pk2(m00[8 * sp + 4], m00[8 * sp + 5]); w.w = pk2(m00[8 * sp + 6], m00[8 * sp + 7]); X00[sp] = __builtin_bit_cast(bf16x8, w);
                w.x = pk2(m01[8 * sp + 0], m01[8 * sp + 1]); w.y = pk2(m01[8 * sp + 2], m01[8 * sp + 3]); w.z = pk2(m01[8 * sp + 4], m01[8 * sp + 5]); w.w = pk2(m01[8 * sp + 6], m01[8 * sp + 7]); X01[sp] = __builtin_bit_cast(bf16x8, w);
                w.x = pk2(m11[8 * sp + 0], m11[8 * sp + 1]); w.y = pk2(m11[8 * sp + 2], m11[8 * sp + 3]); w.z = pk2(m11[8 * sp + 4], m11[8 * sp + 5]); w.w = pk2(m11[8 * sp + 6], m11[8 * sp + 7]); X11[sp] = __builtin_bit_cast(bf16x8, w);
            }
        }
        unsigned* yp = (unsigned*)(ws + WS_YP) + ((size_t)su.cid * 16 + h) * 2048 + lane;
#pragma unroll
        for (int pi = 0; pi < 2; ++pi) {
            f32x16 y0 = {}, y1 = {};
#pragma unroll
            for (int i = 0; i < 2; ++i)
#pragma unroll
                for (int sp = 0; sp < 2; ++sp) {
                    const LAS unsigned char* ap = xt + (32 * pi + r32) * SL_XT_ROW + (32 * i + 16 * sp + 4 * hi) * 2;
                    const v2u lo = *(const LAS v2u*)ap, hh = *(const LAS v2u*)(ap + 16);
                    const v4u aw = {lo.x, lo.y, hh.x, hh.y}; const bf16x8 af = __builtin_bit_cast(bf16x8, aw);
                    if (i == 0) { y0 = MFMA32(af, X00[sp], y0); y1 = MFMA32(af, X01[sp], y1); }
                    else y1 = MFMA32(af, X11[sp], y1);
                }
#pragma unroll
            for (int r = 0; r < 16; r += 2) { yp[((pi * 2 + 0) * 8 + (r >> 1)) * 64] = pk2(y0[r], y0[r + 1]); yp[((pi * 2 + 1) * 8 + (r >> 1)) * 64] = pk2(y1[r], y1[r + 1]); }
        }
        bf16* sch = (bf16*)(ws + WS_SCH) + ((size_t)su.cid * 16 + h) * 8192;
#pragma unroll
        for (int pi = 0; pi < 2; ++pi) {
            f32x16 s0 = {}, s1 = {}, s2 = {}, s3 = {};
#pragma unroll
            for (int ks = 0; ks < 4; ++ks) {
                const int sb = 16 * ks + 8 * hi;
                const v4u raw = *(const LAS v4u*)(xt + (32 * pi + r32) * SL_XT_ROW + sb * 2);
                const f32x4 wa = *(const LAS f32x4*)(wl + sb), wb = *(const LAS f32x4*)(wl + sb + 4);
                v4u aw; aw.x = pk2(bflo(raw.x) * wa[0], bfhi(raw.x) * wa[1]); aw.y = pk2(bflo(raw.y) * wa[2], bfhi(raw.y) * wa[3]);
                aw.z = pk2(bflo(raw.z) * wb[0], bfhi(raw.z) * wb[1]); aw.w = pk2(bflo(raw.w) * wb[2], bfhi(raw.w) * wb[3]);
                const bf16x8 xf = __builtin_bit_cast(bf16x8, aw);
                const bf16x8 q0 = *(const LAS bf16x8*)(bt + (0 + r32) * SL_BT_ROW + sb * 2), q1 = *(const LAS bf16x8*)(bt + (32 + r32) * SL_BT_ROW + sb * 2);
                const bf16x8 q2 = *(const LAS bf16x8*)(bt + (64 + r32) * SL_BT_ROW + sb * 2), q3 = *(const LAS bf16x8*)(bt + (96 + r32) * SL_BT_ROW + sb * 2);
                s0 = MFMA32(q0, xf, s0); s1 = MFMA32(q1, xf, s1); s2 = MFMA32(q2, xf, s2); s3 = MFMA32(q3, xf, s3);
            }
            bf16* orow = sch + (size_t)(32 * pi + r32) * 128 + 4 * hi;
#pragma unroll
            for (int q = 0; q < 4; ++q) {
                v2u w;
                w.x = pk2(s0[4 * q], s0[4 * q + 1]); w.y = pk2(s0[4 * q + 2], s0[4 * q + 3]); *(v2u*)(orow + 0 + 8 * q) = w;
                w.x = pk2(s1[4 * q], s1[4 * q + 1]); w.y = pk2(s1[4 * q + 2], s1[4 * q + 3]); *(v2u*)(orow + 32 + 8 * q) = w;
                w.x = pk2(s2[4 * q], s2[4 * q + 1]); w.y = pk2(s2[4 * q + 2], s2[4 * q + 3]); *(v2u*)(orow + 64 + 8 * q) = w;
                w.x = pk2(s3[4 * q], s3[4 * q + 1]); w.y = pk2(s3[4 * q + 2], s3[4 * q + 3]); *(v2u*)(orow + 96 + 8 * q) = w;
            }
        }
    }
    __syncthreads();
}

__device__ __forceinline__ void ssd_scan(const Args& A, int item, int tid) {
    unsigned char* ws = A.ws;
    const int e4 = item * 2048 + 4 * tid, h = __builtin_amdgcn_readfirstlane(e4 >> 13);
    const v2u* SCH = (const v2u*)(ws + WS_SCH) + (e4 >> 2); const float* CD = (const float*)(ws + WS_CD) + h; v2u* HP = (v2u*)(ws + WS_HPREV) + (e4 >> 2);
    float st0 = 0.f, st1 = 0.f, st2 = 0.f, st3 = 0.f;
    for (int c0 = 0; c0 < 128; c0 += 32) {
        v2u sv[32]; float d[32];
#pragma unroll
        for (int k = 0; k < 32; ++k) { sv[k] = SCH[(size_t)(c0 + k) * 32768]; d[k] = CD[(c0 + k) * 16]; }
#pragma unroll
        for (int k = 0; k < 32; ++k) { v2u o; o.x = pk2(st0, st1); o.y = pk2(st2, st3); HP[(size_t)(c0 + k) * 32768] = o;
            st0 = d[k] * st0 + bflo(sv[k].x); st1 = d[k] * st1 + bfhi(sv[k].x); st2 = d[k] * st2 + bflo(sv[k].y); st3 = d[k] * st3 + bfhi(sv[k].y); }
    }
    { f32x4 o = {st0, st1, st2, st3}; *(f32x4*)(A.out + O_SP + e4) = o; }
    for (int b0 = 0; b0 < 32; b0 += 16) {
        v2u sv[16]; float d[16]; f32x4 h0[16];
#pragma unroll
        for (int k = 0; k < 16; ++k) { sv[k] = SCH[(size_t)(128 + b0 + k) * 32768]; d[k] = CD[(128 + b0 + k) * 16]; h0[k] = *(const f32x4*)(A.in[I_SSM] + (size_t)(b0 + k) * 131072 + e4); }
#pragma unroll
        for (int k = 0; k < 16; ++k) { v2u o; o.x = pk2(h0[k][0], h0[k][1]); o.y = pk2(h0[k][2], h0[k][3]); HP[(size_t)(128 + b0 + k) * 32768] = o;
            f32x4 r = {d[k] * h0[k][0] + bflo(sv[k].x), d[k] * h0[k][1] + bfhi(sv[k].x), d[k] * h0[k][2] + bflo(sv[k].y), d[k] * h0[k][3] + bfhi(sv[k].y)};
            *(f32x4*)(A.out + O_SS + (size_t)(b0 + k) * 131072 + e4) = r; }
    }
}

__device__ __forceinline__ void ssd_out(const Args& A, LAS unsigned char* lds, int u) {
    const SsdUnit su = ssd_unit(u);
    int tid_ = threadIdx.x; asm volatile("" : "+v"(tid_));
    const int tid = tid_, lane = tid & 63, wid = __builtin_amdgcn_readfirstlane(tid >> 6), r32 = lane & 31, hi = lane >> 5;
    unsigned char* ws = A.ws;
    const int h = 8 * su.g + wid;
    const bf16* HP = (const bf16*)(ws + WS_HPREV) + ((size_t)su.cid * 16 + h) * 8192;
    const bf16* CB = (const bf16*)(ws + WS_CB) + (size_t)su.cid * 64 * 256 + su.g * 128;
    const float* acum = (const float*)(ws + WS_ACUM) + ((size_t)su.cid * 16 + h) * 64;
    const unsigned* yp = (const unsigned*)(ws + WS_YP) + ((size_t)su.cid * 16 + h) * 2048 + lane;
    const bf16* Z = (const bf16*)(ws + WS_Z);
    float ac_[2]; v2u zz_[2][2][4]; unsigned ya_[2][2][4], yb_[2][2][4]; f32x4 gg_[2][4];
    { const float* gn0 = A.in[I_GSSM] + 512 * su.g + 64 * wid + 4 * hi;
#pragma unroll
      for (int pi = 0; pi < 2; ++pi)
#pragma unroll
        for (int q = 0; q < 4; ++q) gg_[pi][q] = *(const f32x4*)(gn0 + 32 * pi + 8 * q); }
#pragma unroll
    for (int j = 0; j < 2; ++j) {
        const int t = 32 * j + r32;
        ac_[j] = acum[t];
        const bf16* zr = Z + (size_t)(su.rbase + (t < su.T ? t : 0)) * 1024 + 512 * su.g + 64 * wid;
#pragma unroll
        for (int pi = 0; pi < 2; ++pi)
#pragma unroll
            for (int q = 0; q < 4; ++q) { zz_[j][pi][q] = *(const v2u*)(zr + 32 * pi + 8 * q + 4 * hi);
                ya_[j][pi][q] = yp[((pi * 2 + j) * 8 + 2 * q + 0) * 64]; yb_[j][pi][q] = yp[((pi * 2 + j) * 8 + 2 * q + 1) * 64]; }
    }
    f32x16 acc[2][2] = {};
#pragma unroll
    for (int kh = 0; kh < 2; ++kh) {
        bf16x8 fa0[4], fa1[4], fb0[4], fb1[4];
#pragma unroll
        for (int k = 0; k < 4; ++k) { const int kb = 16 * (4 * kh + k) + 8 * hi;
            fa0[k] = *(const bf16x8*)(HP + (size_t)r32 * 128 + kb); fa1[k] = *(const bf16x8*)(HP + (size_t)(32 + r32) * 128 + kb);
            fb0[k] = *(const bf16x8*)(CB + (size_t)r32 * 256 + kb); fb1[k] = *(const bf16x8*)(CB + (size_t)(32 + r32) * 256 + kb); }
#pragma unroll
        for (int k = 0; k < 4; ++k) { acc[0][0] = MFMA32(fa0[k], fb0[k], acc[0][0]); acc[0][1] = MFMA32(fa0[k], fb1[k], acc[0][1]); acc[1][0] = MFMA32(fa1[k], fb0[k], acc[1][0]); acc[1][1] = MFMA32(fa1[k], fb1[k], acc[1][1]); }
    }
    float ssq[2] = {0.f, 0.f};
#pragma unroll
    for (int j = 0; j < 2; ++j) {
        const float ea = __expf(ac_[j]);
#pragma unroll
        for (int pi = 0; pi < 2; ++pi)
#pragma unroll
            for (int q = 0; q < 4; ++q) {
                const v2u zz = zz_[j][pi][q];
                const float z0 = bflo(zz.x), z1 = bfhi(zz.x), z2 = bflo(zz.y), z3 = bfhi(zz.y);
                const unsigned ya = ya_[j][pi][q], yb = yb_[j][pi][q];
                float y;
                y = (bflo(ya) + ea * acc[pi][j][4 * q + 0]) * siluf(z0); acc[pi][j][4 * q + 0] = y; ssq[j] += y * y;
                y = (bfhi(ya) + ea * acc[pi][j][4 * q + 1]) * siluf(z1); acc[pi][j][4 * q + 1] = y; ssq[j] += y * y;
                y = (bflo(yb) + ea * acc[pi][j][4 * q + 2]) * siluf(z2); acc[pi][j][4 * q + 2] = y; ssq[j] += y * y;
                y = (bfhi(yb) + ea * acc[pi][j][4 * q + 3]) * siluf(z3); acc[pi][j][4 * q + 3] = y; ssq[j] += y * y;
            }
        ssq[j] += __shfl_xor(ssq[j], 32);
    }
    LAS float* red = (LAS float*)lds;
    if (hi == 0) { red[wid * 64 + r32] = ssq[0]; red[wid * 64 + 32 + r32] = ssq[1]; }
    __syncthreads();
    bf16* A2 = (bf16*)(ws + WS_A2);
#pragma unroll
    for (int j = 0; j < 2; ++j) {
        const int t = 32 * j + r32;
        float tot = 0.f;
#pragma unroll
        for (int w = 0; w < 8; ++w) tot += red[w * 64 + t];
        const float rstd = 1.0f / sqrtf(tot * (1.0f / 512.f) + EPS);
        if (t < su.T) {
            bf16* orow = A2 + (size_t)(su.rbase + t) * 2048 + 1024 + 512 * su.g + 64 * wid;
#pragma unroll
            for (int pi = 0; pi < 2; ++pi)
#pragma unroll
                for (int q = 0; q < 4; ++q) {
                    const int p = 32 * pi + 8 * q + 4 * hi;
                    const f32x4 gg = gg_[pi][q];
                    v2u w; w.x = pk2(acc[pi][j][4 * q + 0] * rstd * gg[0], acc[pi][j][4 * q + 1] * rstd * gg[1]); w.y = pk2(acc[pi][j][4 * q + 2] * rstd * gg[2], acc[pi][j][4 * q + 3] * rstd * gg[3]);
                    *(v2u*)(orow + p) = w;
                }
        }
    }
    __syncthreads();
}

namespace att {
constexpr int KVBLK = 64;
constexpr int SHM_V = 64 * 128 * 2, SHM_K = 64 * 128 * 2;
constexpr int NSLOT = 3;
constexpr int L_V = 0, L_K = NSLOT * SHM_V, L_WS = L_K + NSLOT * SHM_K, L_EX = 0  , L_END = L_WS + NWAVES * 128 * 4;
static_assert(4 * 16384 <= L_WS, "exchange slots fit under the rings");
static_assert(L_END <= LDSCTL_OFF, "attn lds");
constexpr float THR = 6.f;
#define KSWZ(row, colB) ((row) * 256 + ((colB) ^ (((row) & 15) << 4)))
#define SBAR() __builtin_amdgcn_sched_barrier(0)
__device__ __forceinline__ unsigned cvtpk(float lo, float hi) { return pg8::cvt_pk_bf16(lo, hi); }
template <typename TIn> struct Stage;
template <> struct Stage<bf16>  { using T = bf16x8;
  __device__ static __forceinline__ T ld8(const bf16* p) { return *reinterpret_cast<const bf16x8*>(p); }
  __device__ static __forceinline__ bf16x8 tobf(T x) { return x; } };
template <> struct Stage<float> { using T = f32x8;
  __device__ static __forceinline__ T ld8(const float* p) { return *reinterpret_cast<const f32x8*>(p); }
  __device__ static __forceinline__ bf16x8 tobf(T x) {
    v4u w = {cvtpk(x[0], x[1]), cvtpk(x[2], x[3]), cvtpk(x[4], x[5]), cvtpk(x[6], x[7])}; return __builtin_bit_cast(bf16x8, w); } };

__device__ __forceinline__ void partialSM(f32x16& p0, f32x16& p1, float& m_reg, float& mn, float& alpha, float base, float c32) {
  float pm0 = p0[0]; for (int r = 1; r < 16; ++r) pm0 = fmaxf(pm0, p0[r]);
  float pm1 = p1[0]; for (int r = 1; r < 16; ++r) pm1 = fmaxf(pm1, p1[r]);
  float pmax = fmaxf(pm0, pm1 + c32) + base;
  { auto rr = __builtin_amdgcn_permlane32_swap(__float_as_uint(pmax), __float_as_uint(pmax), false, false);
    pmax = fmaxf(__uint_as_float(rr[0]), __uint_as_float(rr[1])); }
  if (__builtin_expect(__all(pmax - m_reg <= THR), 1)) { mn = m_reg; alpha = 1.f; }
  else { mn = fmaxf(m_reg, pmax); alpha = __builtin_amdgcn_exp2f(m_reg - mn); m_reg = mn; }
  const float off0 = base - mn, off1 = off0 + c32;
  for (int r = 0; r < 16; ++r) p0[r] = __builtin_amdgcn_exp2f(p0[r] + off0);
  for (int r = 0; r < 16; ++r) p1[r] = p1[r] + off1;
}
__device__ __forceinline__ void finishSM(f32x16& p0, f32x16& p1, float alpha, float& l_reg, bf16x8& pa0, bf16x8& pa1, bf16x8& pa2, bf16x8& pa3) {
  for (int r = 0; r < 16; ++r) p1[r] = __builtin_amdgcn_exp2f(p1[r]);
  float ps = 0; for (int r = 0; r < 16; ++r) ps += p0[r]; for (int r = 0; r < 16; ++r) ps += p1[r];
  { auto rr = __builtin_amdgcn_permlane32_swap(__float_as_uint(ps), __float_as_uint(ps), false, false);
    ps = __uint_as_float(rr[0]) + __uint_as_float(rr[1]); }
  l_reg = l_reg * alpha + ps;
#define PK4(P, BASE, OUT) do { unsigned a0 = cvtpk(P[BASE + 0], P[BASE + 1]), a1 = cvtpk(P[BASE + 2], P[BASE + 3]);   \
    unsigned b0 = cvtpk(P[BASE + 4], P[BASE + 5]), b1 = cvtpk(P[BASE + 6], P[BASE + 7]);                              \
    auto r0 = __builtin_amdgcn_permlane32_swap(a0, b0, false, false); auto r1 = __builtin_amdgcn_permlane32_swap(a1, b1, false, false); \
    v4u w = {r0[0], r1[0], r0[1], r1[1]}; OUT = __builtin_bit_cast(bf16x8, w); } while (0)
  PK4(p0, 0, pa0); PK4(p0, 8, pa1); PK4(p1, 0, pa2); PK4(p1, 8, pa3);
#undef PK4
}
__device__ __forceinline__ void qkt(f32x16& p0, f32x16& p1, const char* Ks, const bf16x8* qr, const float* kc, int r32, int hi, int mapoff) {
  { const f32x4 k0 = *(const f32x4*)kc, k1 = *(const f32x4*)(kc + 4), k2 = *(const f32x4*)(kc + 8), k3 = *(const f32x4*)(kc + 12);
    p0 = (f32x16){k0[0], k0[1], k0[2], k0[3], k1[0], k1[1], k1[2], k1[3], k2[0], k2[1], k2[2], k2[3], k3[0], k3[1], k3[2], k3[3]}; p1 = p0; }
#pragma unroll
  for (int d0 = 0; d0 < 4; ++d0) { const int cb = (mapoff + d0 * 16 + hi * 8) * 2;
    const bf16x8 b0 = *reinterpret_cast<const bf16x8*>(Ks + KSWZ(r32, cb));
    const bf16x8 b1 = *reinterpret_cast<const bf16x8*>(Ks + KSWZ(32 + r32, cb));
    p0 = __builtin_amdgcn_mfma_f32_32x32x16_bf16(b0, qr[d0], p0, 0, 0, 0);
    p1 = __builtin_amdgcn_mfma_f32_32x32x16_bf16(b1, qr[d0], p1, 0, 0, 0); }
}
__device__ __forceinline__ int v_st(int k, int c) { const int kk = (k & ~0xC) | ((k & 4) << 1) | ((k & 8) >> 1); return ((kk >> 3) * 4 + (c >> 5)) * 512 + ((kk & 7) * 32 + (c & 31)) * 2; }
__device__ __forceinline__ int v_rd_base(int lane) { return ((lane & 3) << 3) | (((lane >> 2) & 3) << 6) | (((lane >> 4) & 1) << 5) | (((lane >> 5) & 1) << 8); }
constexpr int v_rd_off(int d0, int ks, int half) { return d0 * 512 + ks * 4096 + half * 2048; }
template <int OFF> __device__ __forceinline__ s16x4 tr_read(int vb) {
  s16x4 r; asm volatile("ds_read_b64_tr_b16 %0, %1 offset:%2" : "=&v"(r) : "v"(vb), "i"(OFF) : "memory"); return r;
}
template <int D0> __device__ __forceinline__ void pv_one(f32x16& od, int vb, bf16x8 pa0, bf16x8 pa1, bf16x8 pa2, bf16x8 pa3) {
  const s16x4 l0 = tr_read<v_rd_off(D0, 0, 0)>(vb), h0 = tr_read<v_rd_off(D0, 0, 1)>(vb), l1 = tr_read<v_rd_off(D0, 1, 0)>(vb), h1 = tr_read<v_rd_off(D0, 1, 1)>(vb);
  const s16x4 l2 = tr_read<v_rd_off(D0, 2, 0)>(vb), h2 = tr_read<v_rd_off(D0, 2, 1)>(vb), l3 = tr_read<v_rd_off(D0, 3, 0)>(vb), h3 = tr_read<v_rd_off(D0, 3, 1)>(vb);
  asm volatile("s_waitcnt lgkmcnt(0)" ::: "memory"); SBAR();
#define PK(L, H) (bf16x8){L[0], L[1], L[2], L[3], H[0], H[1], H[2], H[3]}
  od = __builtin_amdgcn_mfma_f32_32x32x16_bf16(pa0, PK(l0, h0), od, 0, 0, 0);
  od = __builtin_amdgcn_mfma_f32_32x32x16_bf16(pa1, PK(l1, h1), od, 0, 0, 0);
  od = __builtin_amdgcn_mfma_f32_32x32x16_bf16(pa2, PK(l2, h2), od, 0, 0, 0);
  od = __builtin_amdgcn_mfma_f32_32x32x16_bf16(pa3, PK(l3, h3), od, 0, 0, 0);
#undef PK
}
__device__ __forceinline__ void pv_d0(f32x16* o, int vb, bf16x8 pa0, bf16x8 pa1, bf16x8 pa2, bf16x8 pa3) {
  pv_one<0>(o[0], vb, pa0, pa1, pa2, pa3); pv_one<1>(o[1], vb, pa0, pa1, pa2, pa3); pv_one<2>(o[2], vb, pa0, pa1, pa2, pa3); pv_one<3>(o[3], vb, pa0, pa1, pa2, pa3);
}

struct SrcPrompt {
  const bf16* Kh; const bf16* Vh;
  __device__ __forceinline__ const bf16* kp(int t) const { return Kh + (size_t)t * 64 * 1024; }
  __device__ __forceinline__ const bf16* vp(int t) const { return Vh + (size_t)t * 64 * 1024; }
  __device__ __forceinline__ int nvalid(int) const { return 64; }
};
struct SrcSample {
  const float* Kc; const float* Vc; const float* Kn; const float* Vn;
  __device__ __forceinline__ const float* kp(int t) const { return t < 16 ? Kc + (size_t)t * 64 * 1024 : Kn; }
  __device__ __forceinline__ const float* vp(int t) const { return t < 16 ? Vc + (size_t)t * 64 * 1024 : Vn; }
  __device__ __forceinline__ int nvalid(int t) const { return t < 16 ? 64 : 16; }
};

template <typename TKV, int SD, int nvd, class Src>
__device__ __forceinline__ void attn_core(f32x16 (&o)[4], const bf16* qrow, float qposf, float c, int cq, int t0, int NT, const Src& src, char* lds, LAS unsigned char* lds3, int mapoff) {
  using St = Stage<TKV>;
  int tid_ = threadIdx.x; asm volatile("" : "+v"(tid_));
  const int tid = tid_, wid = tid >> 6, lane = tid & 63, r32 = lane & 31, hi = lane >> 5;
  char* V_lds = lds + L_V; char* K_lds = lds + L_K;
  float* wsf = (float*)(lds + L_WS) + wid * 128; float* li_l = wsf; float* al_l = wsf + 32; float* kc = wsf + 64;
  float m_reg = -1e30f, l_reg = 0; bf16x8 qr[4];
#pragma unroll
  for (int d = 0; d < 4; ++d) o[d] = f32x16{};
#pragma unroll
  for (int d0 = 0; d0 < 4; ++d0) qr[d0] = *reinterpret_cast<const bf16x8*>(qrow + d0 * 16);
  if (lane < 16) kc[lane] = c * (float)((lane & 3) + 8 * (lane >> 2));
  asm volatile("s_waitcnt lgkmcnt(0)" ::: "memory");
  const float c32 = 32.f * c, c2 = 2.f * c;
  const float qrel = (float)(4 * hi) - qposf;
  const int sr = tid >> 4, sc = (tid & 15) * 8, vst0 = v_st(sr, sc), kst0 = KSWZ(sr, sc * 2);
  const int vb0 = (int)(uintptr_t)V_lds + v_rd_base(lane);
  struct { typename St::T vs0, vs1, ks0, ks1; } sr_[SD];
#define SLOAD(i, t) do { const int nv_ = src.nvalid(t); const int r0_ = sr < nv_ ? sr : nv_ - 1, r1_ = 32 + sr < nv_ ? 32 + sr : nv_ - 1; \
    const TKV* kp_ = src.kp(t); const TKV* vp_ = src.vp(t); \
    sr_[i].vs0 = St::ld8(vp_ + (size_t)r0_ * 1024 + sc); sr_[i].vs1 = St::ld8(vp_ + (size_t)r1_ * 1024 + sc); \
    sr_[i].ks0 = St::ld8(kp_ + (size_t)r0_ * 1024 + sc); sr_[i].ks1 = St::ld8(kp_ + (size_t)r1_ * 1024 + sc); } while (0)
#define SWRITE(b, i) do { *(bf16x8*)(V_lds + (b) * SHM_V + vst0) = St::tobf(sr_[i].vs0);          \
    *(bf16x8*)(V_lds + (b) * SHM_V + vst0 + 8192) = St::tobf(sr_[i].vs1);               \
    *(bf16x8*)(K_lds + (b) * SHM_K + kst0) = St::tobf(sr_[i].ks0);                       \
    *(bf16x8*)(K_lds + (b) * SHM_K + kst0 + 8192) = St::tobf(sr_[i].ks1); } while (0)
#define SWRITE3(off, i) do { *(bf16x8*)(V_lds + (off) + vst0) = St::tobf(sr_[i].vs0);          \
    *(bf16x8*)(V_lds + (off) + vst0 + 8192) = St::tobf(sr_[i].vs1);               \
    *(bf16x8*)(K_lds + (off) + kst0) = St::tobf(sr_[i].ks0);                       \
    *(bf16x8*)(K_lds + (off) + kst0 + 8192) = St::tobf(sr_[i].ks1); } while (0)
#define SWAIT() do { if constexpr (SD == 2) asm volatile("s_waitcnt vmcnt(4)" ::: "memory"); else asm volatile("s_waitcnt vmcnt(0)" ::: "memory"); } while (0)
#define RESC(a) do { if (__any((a) < 1.f)) { int tl_ = threadIdx.x; asm volatile("" : "+v"(tl_)); const int hi_ = (tl_ >> 5) & 1; if (hi_ == 0) al_l[tl_ & 31] = (a); asm volatile("s_waitcnt lgkmcnt(0)" ::: "memory"); \
    for (int d = 0; d < 4; ++d) for (int r = 0; r < 16; ++r) o[d][r] *= al_l[crow(r, hi_)]; } } while (0)
#define POST(P0, P1, t) do { if ((t) == cq) { const float d0_ = (float)(64 * (t)) + qrel; \
      for (int r = 0; r < 16; ++r) { const float d_ = d0_ + (float)((r & 3) + 8 * (r >> 2)); P0[r] -= c2 * fmaxf(d_, 0.f); P1[r] -= c2 * fmaxf(d_ + 32.f, 0.f); } \
      if (nvd < 64) { for (int r = 0; r < 16; ++r) { const int kk_ = crow(r, hi); if (kk_ >= nvd) P0[r] = -1e30f; if (kk_ + 32 >= nvd) P1[r] = -1e30f; } } } } while (0)
#define BASE(t) ((t) > cq ? -1e30f : c * ((float)(64 * (t)) + qrel))
  if constexpr (SD == 2) {
  f32x16 p0, p1; float mn, al; bf16x8 pa0, pa1, pa2, pa3;
  SLOAD(0, t0); SLOAD(1, t0 + 1); SWRITE(0, 0); __syncthreads();
#define STEP1(t, bsel, nset, cset, havenext, haveload) do { \
    if (haveload) SLOAD(cset, (t) + 2); \
    SBAR(); qkt(p0, p1, K_lds + (bsel) * SHM_K, qr, kc, r32, hi, mapoff); POST(p0, p1, t); \
    partialSM(p0, p1, m_reg, mn, al, BASE(t), c32); RESC(al); \
    finishSM(p0, p1, al, l_reg, pa0, pa1, pa2, pa3); SBAR(); \
    pv_d0(o, vb0 + (bsel) * SHM_V, pa0, pa1, pa2, pa3); \
    if (havenext) { SWRITE((bsel) ^ 1, nset); } \
    __syncthreads(); } while (0)
  for (int t = t0; t < NT; t += 2) {
    STEP1(t, 0, 1, 0, true, t + 2 < NT);
    STEP1(t + 1, 1, 0, 1, t + 2 < NT, t + 3 < NT);
  }
#undef STEP1
  } else {
  f32x16 pA0, pA1, pB0, pB1; float mnA, mnB, alA, alB; bf16x8 pa0, pa1, pa2, pa3;
  const int n_ = NT - t0;
  unsigned ksrc[2], vsrc[2];
#pragma unroll
  for (int p = 0; p < 2; ++p) {
    const int L = (p * 512 + tid) * 16;
    { const int row = L >> 8, csw = (L >> 4) & 15; ksrc[p] = (unsigned)(row * 1024 + ((csw ^ (row & 15)) * 8)) * 2u; }
    { const int st = L >> 9, within = (L & 511) >> 1, kk = (st >> 2) * 8 + (within >> 5), c = (st & 3) * 32 + (within & 31), k = (kk & ~0xC) | ((kk & 4) << 1) | ((kk & 8) >> 1); vsrc[p] = (unsigned)(k * 1024 + c) * 2u; }
  }
  const unsigned dmaw = (unsigned)__builtin_amdgcn_readfirstlane(wid) * 1024u;
#define DMA3(off, t) do { const char* kp_ = (const char*)src.kp(t); const char* vp_ = (const char*)src.vp(t); _Pragma("unroll") for (int p_ = 0; p_ < 2; ++p_) { \
      __builtin_amdgcn_global_load_lds((const unsigned*)(kp_ + ksrc[p_]), (LAS unsigned*)(lds3 + L_K + (off) + p_ * 8192 + dmaw), 16, 0, 0); \
      __builtin_amdgcn_global_load_lds((const unsigned*)(vp_ + vsrc[p_]), (LAS unsigned*)(lds3 + L_V + (off) + p_ * 8192 + dmaw), 16, 0, 0); } } while (0)
  DMA3(0, t0); DMA3(16384, t0 + 1); __syncthreads();
  qkt(pA0, pA1, K_lds, qr, kc, r32, hi, mapoff); POST(pA0, pA1, t0); partialSM(pA0, pA1, m_reg, mnA, alA, BASE(t0), c32);
  int s_prev = 0, s_cur = 16384, s_next = 32768;
#define ROT3() do { s_prev = s_cur; s_cur = s_next; s_next = s_next == 32768 ? 0 : s_next + 16384; asm volatile("" : "+s"(s_prev), "+s"(s_cur), "+s"(s_next)); } while (0)
#define STEP3(C0, C1, mnC, alC, P0, P1, alP, i_) do { const int t_ = t0 + (i_); \
    if ((i_) + 1 < n_) { DMA3(s_next, t_ + 1); } \
    SBAR(); qkt(C0, C1, K_lds + s_cur, qr, kc, r32, hi, mapoff); POST(C0, C1, t_); \
    finishSM(P0, P1, alP, l_reg, pa0, pa1, pa2, pa3); SBAR(); \
    pv_d0(o, vb0 + s_prev, pa0, pa1, pa2, pa3); partialSM(C0, C1, m_reg, mnC, alC, BASE(t_), c32); \
    RESC(alC); __syncthreads(); ROT3(); } while (0)
  int i3 = 1;
  for (; i3 + 1 <= n_ - 2; i3 += 2) {
    STEP3(pB0, pB1, mnB, alB, pA0, pA1, alA, i3);
    STEP3(pA0, pA1, mnA, alA, pB0, pB1, alB, i3 + 1);
  }
  STEP3(pB0, pB1, mnB, alB, pA0, pA1, alA, i3);
  finishSM(pB0, pB1, alB, l_reg, pa0, pa1, pa2, pa3); SBAR();
  pv_d0(o, vb0 + s_prev, pa0, pa1, pa2, pa3);
#undef STEP3
#undef ROT3
  }
  { int tl_ = threadIdx.x; asm volatile("" : "+v"(tl_)); const int hi_ = (tl_ >> 5) & 1;
  if (hi_ == 0) li_l[tl_ & 31] = l_reg; asm volatile("s_waitcnt lgkmcnt(0)" ::: "memory");
#pragma unroll
  for (int r = 0; r < 16; ++r) { const float rl = __builtin_amdgcn_rcpf(li_l[crow(r, hi_)]);
#pragma unroll
    for (int d = 0; d < 4; ++d) o[d][r] *= rl; } }
#undef SLOAD
#undef SWRITE
#undef SWRITE3
#undef SWAIT
#undef RESC
#undef POST
#undef BASE
}

__device__ __forceinline__ void attn_finish(f32x16 (&o)[4], float lam, const float* gsub, bf16* A2h, int rowbase, int nrows, bool store, char* lds) {
  int tid_ = threadIdx.x; asm volatile("" : "+v"(tid_));
  const int tid = tid_, wid = tid >> 6, lane = tid & 63, r32 = lane & 31, hi = lane >> 5;
  float* ex = (float*)(lds + L_EX) + (wid & 3) * 4096 + lane;
  __syncthreads();
  if (wid >= 4) {
#pragma unroll
    for (int d = 0; d < 4; ++d)
#pragma unroll
      for (int r = 0; r < 16; ++r) ex[(d * 16 + r) * 64] = lam * o[d][r];
  }
  __syncthreads();
  if (wid < 4) {
    float g[4];
#pragma unroll
    for (int d = 0; d < 4; ++d) g[d] = gsub[32 * d + r32] * (1.0f - LAM_INIT);
#pragma unroll
    for (int r = 0; r < 16; ++r) {
      float ss = 0.f;
#pragma unroll
      for (int d = 0; d < 4; ++d) { const float a = o[d][r] - ex[(d * 16 + r) * 64]; o[d][r] = a; ss += a * a; }
      ss += __shfl_xor(ss, 1); ss += __shfl_xor(ss, 2); ss += __shfl_xor(ss, 4); ss += __shfl_xor(ss, 8); ss += __shfl_xor(ss, 16);
      const float rstd = 1.0f / sqrtf(ss * (1.0f / 128.f) + EPS);
#pragma unroll
      for (int d = 0; d < 4; ++d) o[d][r] *= rstd * g[d];
    }
    unsigned short* stg = (unsigned short*)(lds + L_EX) + (wid & 3) * 8192;
#pragma unroll
    for (int r = 0; r < 16; ++r) {
      const int row = crow(r, hi);
#pragma unroll
      for (int d = 0; d < 4; ++d) stg[row * 136 + 32 * d + r32] = (unsigned short)f2bf(o[d][r]);
    }
    asm volatile("s_waitcnt lgkmcnt(0)" ::: "memory");
    if (store) {
#pragma unroll
      for (int i = 0; i < 8; ++i) {
        const int id = lane + 64 * i, row = id >> 4, c16 = id & 15;
        if (row < nrows) *(v4u*)(A2h + (size_t)(rowbase + row) * 2048 + c16 * 8) = *(const v4u*)(stg + row * 136 + c16 * 8);
      }
    }
  }
  __syncthreads();
}
#undef SBAR
}

constexpr int N_PHASES = 8;
constexpr int NSL5 = 8, NSL9 = 11;
constexpr int N_LAUNCHES = MK_N_LAUNCHES;

__global__ void __launch_bounds__(NWAVES * 64, 2) hymba_fwd(Args args) {
    extern __shared__ __attribute__((aligned(16))) unsigned char lds_raw[];
    LAS unsigned char* lds = (LAS unsigned char*)lds_raw;
    volatile LAS unsigned* MISC = (volatile LAS unsigned*)(lds + LDSCTL_OFF);
    const int tid = threadIdx.x, lane = tid & 63, wave = __builtin_amdgcn_readfirstlane(tid >> 6);
    const int G = gridDim.x; const int bx = blockIdx.x;
    const int vcu = (G % 8 == 0) ? (bx % 8) * (G / 8) + bx / 8 : bx;
    unsigned char* ws = args.ws;
    gu32* ctl = (gu32*)(ws + WS_CTL);
    for (int u = tid; u < (LDS_BYTES - LDSCTL_OFF) / 4; u += NWAVES * 64) ((LAS unsigned*)(lds + LDSCTL_OFF))[u] = 0u;
    __syncthreads();
    XcdBarrier bar; bar.bar = (unsigned*)(ctl + CW_BAR); bar.x = 0; bar.st = nullptr;
    if (N_LAUNCHES == 1) bar = xcd_barrier_post((unsigned*)(ctl + CW_BAR), MISC + 8);
    const int lo = args.ph_lo, hi_ph = args.ph_hi;
#ifndef PHASE_MASK
#define PHASE_MASK 0xff
#endif
#define IN(k) (((PHASE_MASK >> (k)) & 1) && lo <= (k) && (k) < hi_ph)
#ifdef PROBE_PHASE
    unsigned long long pr_a = 0, pr_b = 0;
#define PSTART(k) do { if ((k) == PROBE_PHASE) pr_a = __builtin_amdgcn_s_memrealtime(); } while (0)
#define PEND(k) do { if ((k) == PROBE_PHASE) pr_b = __builtin_amdgcn_s_memrealtime(); } while (0)
#else
#define PSTART(k) do {} while (0)
#define PEND(k) do {} while (0)
#endif
#define SEAM(k) do { if (IN(k) && IN((k) + 1)) xcd_barrier(bar); PEND(k); PSTART((k) + 1); } while (0)

    bf16* WIN = (bf16*)(ws + WS_WIN); bf16* WOUT = (bf16*)(ws + WS_WOUT); bf16* WGU = (bf16*)(ws + WS_WGU); bf16* WDN = (bf16*)(ws + WS_WDN);
    bf16* XN = (bf16*)(ws + WS_XN);

    PSTART(0);
    if (IN(0)) {
        {
            LAS float* scr = (LAS float*)(lds + wave * 16896);
            const int gw = vcu * NWAVES + wave, NGW = G * NWAVES;
            constexpr int NITEM = 32 * 88;
            f32x4 v[16];
            int itn = gw;
            P0Item cur{};
            if (itn < NITEM) { cur = p0_item(args, ws, itn); p0_load(cur, v, lane); }
            while (itn < NITEM) {
                p0_to_lds(cur, v, scr, lane);
                const P0Item done = cur;
                itn += NGW;
                if (itn < NITEM) { cur = p0_item(args, ws, itn); p0_load(cur, v, lane); }
                p0_store(done, scr, lane);
            }
        }
        __syncthreads();
        {
            LAS float* wT = (LAS float*)lds;
            for (int k = tid; k < DM; k += NWAVES * 64) {
                const float* src = args.in[I_WIN] + (size_t)k * DIN + NPROJ;
#pragma unroll
                for (int q = 0; q < 4; ++q) { const f32x4 v = *(const f32x4*)(src + 4 * q); wT[(4 * q + 0) * DM + k] = v[0]; wT[(4 * q + 1) * DM + k] = v[1]; wT[(4 * q + 2) * DM + k] = v[2]; wT[(4 * q + 3) * DM + k] = v[3]; }
            }
            __syncthreads();
            const int gw = vcu * NWAVES + wave, NGW = G * NWAVES;
            const float* gmix = args.in[I_GMIX];
            float* DT = (float*)(ws + WS_DT);
            f32x4 gm[8];
#pragma unroll
            for (int j = 0; j < 8; ++j) gm[j] = *(const f32x4*)(gmix + 4 * lane + 256 * j);
            f32x4 nx[8];
            { const int m = gw; if (m < MT) { const float* xrow = m < MP ? args.in[I_XP] + (size_t)m * DM : args.in[I_XS] + (size_t)(m - MP) * DM;
#pragma unroll
                for (int j = 0; j < 8; ++j) nx[j] = *(const f32x4*)(xrow + 4 * lane + 256 * j); } }
            for (int m = gw; m < MT; m += NGW) {
                f32x4 v[8]; float s = 0.f;
#pragma unroll
                for (int j = 0; j < 8; ++j) { v[j] = nx[j]; s += (v[j][0] * v[j][0] + v[j][1] * v[j][1]) + (v[j][2] * v[j][2] + v[j][3] * v[j][3]); }
                { const int m2 = m + NGW; if (m2 < MT) { const float* xrow = m2 < MP ? args.in[I_XP] + (size_t)m2 * DM : args.in[I_XS] + (size_t)(m2 - MP) * DM;
#pragma unroll
                    for (int j = 0; j < 8; ++j) nx[j] = *(const f32x4*)(xrow + 4 * lane + 256 * j); } }
                const float rstd = 1.0f / sqrtf(wave_sum(s) * (1.0f / DM) + EPS);
#pragma unroll
                for (int j = 0; j < 8; ++j) { v[j] = v[j] * rstd * gm[j];
                    v2u w; w.x = pk2(v[j][0], v[j][1]); w.y = pk2(v[j][2], v[j][3]); *(v2u*)(XN + (size_t)m * DM + 4 * lane + 256 * j) = w; }
                float a[16];
#pragma unroll
                for (int jj = 0; jj < 16; ++jj) {
                    float t = 0.f;
#pragma unroll
                    for (int j = 0; j < 8; ++j) { const f32x4 w = *(const LAS f32x4*)(wT + jj * DM + 4 * lane + 256 * j); t += (v[j][0] * w[0] + v[j][1] * w[1]) + (v[j][2] * w[2] + v[j][3] * w[3]); }
                    a[jj] = t;
                    if ((jj & 1) == 1) __builtin_amdgcn_sched_barrier(0);
                }
                float b8[8], c4[4], d2[2], e1;
                { const bool up = lane & 32;
#pragma unroll
                  for (int q = 0; q < 8; ++q) { const float snd = up ? a[q] : a[q + 8], kp = up ? a[q + 8] : a[q]; b8[q] = kp + __shfl_xor(snd, 32); } }
                { const bool up = lane & 16;
#pragma unroll
                  for (int q = 0; q < 4; ++q) { const float snd = up ? b8[q] : b8[q + 4], kp = up ? b8[q + 4] : b8[q]; c4[q] = kp + __shfl_xor(snd, 16); } }
                { const bool up = lane & 8;
#pragma unroll
                  for (int q = 0; q < 2; ++q) { const float snd = up ? c4[q] : c4[q + 2], kp = up ? c4[q + 2] : c4[q]; d2[q] = kp + __shfl_xor(snd, 8); } }
                { const bool up = lane & 4; const float snd = up ? d2[0] : d2[1], kp = up ? d2[1] : d2[0]; e1 = kp + __shfl_xor(snd, 4); }
                e1 += __shfl_xor(e1, 2); e1 += __shfl_xor(e1, 1);
                if ((lane & 3) == 0) { const int jj = ((lane >> 5) & 1) * 8 + ((lane >> 4) & 1) * 4 + ((lane >> 3) & 1) * 2 + ((lane >> 2) & 1);
                    const float xx = e1 + args.in[I_DTB][jj]; DT[(size_t)m * 16 + jj] = fmaxf(xx, 0.f) + log1pf(__expf(-fabsf(xx))); }
            }
        }
        __syncthreads();
    }
    SEAM(0);

    if (IN(1)) {
        pg8::Gemm g{XN, WIN, MT, NPROJ, DM}; pg8::StaticOrder S; S.init(MT, NPROJ, DM, G, bx);
        EpiInProj E{(bf16*)(ws + WS_Q), (bf16*)(ws + WS_K), (bf16*)(ws + WS_V), (bf16*)(ws + WS_Z), (bf16*)(ws + WS_XBC), args.out, (unsigned*)(ctl + CW_QK)};
        pg8::gemm_phase<EpiInProj, pg8::StaticOrder, false, true>(lds, g, S, E);
    }
    SEAM(1);

    if (IN(2)) {
        const bf16* Qb = (const bf16*)(ws + WS_Q); const bf16* Kb = (const bf16*)(ws + WS_K); const bf16* Vb = (const bf16*)(ws + WS_V);
        bf16* A2 = (bf16*)(ws + WS_A2);
        volatile LAS int* qslot = (volatile LAS int*)(lds + LDSCTL_OFF + 64);
        volatile LAS float* blkc = (volatile LAS float*)(lds + LDSCTL_OFF + 128);
        if (wave == 0) {
            const int l6 = tid & 63;
            const float a = args.in[I_LQ1][l6] * args.in[I_LK1][l6], b = args.in[I_LQ2][l6] * args.in[I_LK2][l6];
            const float lamv = __expf(wave_sum(a)) - __expf(wave_sum(b)) + LAM_INIT;
            if (l6 == 0) blkc[0] = lamv;
            if (l6 < 8) {
                float qkb = 0.f;
#pragma unroll
                for (int m = 0; m < 2; ++m) { const unsigned* w = (const unsigned*)(ctl + CW_QK) + 2 * (2 * l6 + m);
                    const float q2 = __uint_as_float(__hip_atomic_load(w, __ATOMIC_RELAXED, __HIP_MEMORY_SCOPE_AGENT)) + __uint_as_float(__hip_atomic_load(w + 1, __ATOMIC_RELAXED, __HIP_MEMORY_SCOPE_AGENT));
                    const float k2 = __uint_as_float(__hip_atomic_load(w + 32, __ATOMIC_RELAXED, __HIP_MEMORY_SCOPE_AGENT)) + __uint_as_float(__hip_atomic_load(w + 33, __ATOMIC_RELAXED, __HIP_MEMORY_SCOPE_AGENT));
                    qkb = fmaxf(qkb, sqrtf(q2 * k2)); }
                blkc[8 + l6] = (2.f * 1.02f * qkb + att::THR + 180.f) / (exp2f(-(float)(l6 + 1)) * LOG2E);
            }
        }
        __syncthreads();
        constexpr int NA1 = 256, NA2 = 128, NA3 = 128;
        constexpr int Q_A0 = 256, Q_LOC = Q_A0 + 320, Q_ATT1 = Q_LOC + NA1, Q_SCAN = Q_ATT1 + 64, Q_ATT2 = Q_SCAN + NA2, Q_OUT = Q_ATT2 + 320, Q_CONV = Q_OUT + (512 - NA1 - NA2), Q_END = Q_CONV + 592;
#define ITEM_DONE(word) do { asm volatile("s_waitcnt vmcnt(0)" ::: "memory"); __syncthreads(); \
            if (tid == 0) { __builtin_amdgcn_fence(__ATOMIC_RELEASE, "agent"); asm volatile("s_waitcnt vmcnt(0)" ::: "memory"); (void)atomicAdd((unsigned*)(ctl + (word)), 1u); } } while (0)
#define ITEM_WAIT(word, need) do { if (tid == 0) { unsigned sp_ = 0; while (__hip_atomic_load((unsigned*)(ctl + (word)), __ATOMIC_RELAXED, __HIP_MEMORY_SCOPE_AGENT) < (unsigned)(need)) { __builtin_amdgcn_s_sleep(8); if (++sp_ > (1u << 22)) break; } \
            __builtin_amdgcn_fence(__ATOMIC_ACQUIRE, "agent"); asm volatile("s_waitcnt vmcnt(0)" ::: "memory"); } __syncthreads(); } while (0)
        for (;;) {
            __syncthreads();
            if (tid == 0) *qslot = (int)atomicAdd((unsigned*)(ctl + CW_QUEUE), 1u);
            __syncthreads();
            const int p = *qslot;
            if (p >= Q_END) break;
            if (p >= Q_CONV) {
                int tw_ = threadIdx.x; asm volatile("" : "+v"(tw_));
                const int wv2 = __builtin_amdgcn_readfirstlane(tw_ >> 6), ln2 = tw_ & 63;
                LAS float* scr = (LAS float*)(lds + wv2 * 16896);
                const int it0 = 32 * 88 + (p - Q_CONV) * 16 + wv2 * 2;
                f32x4 v[16];
                const P0Item a = p0_item(args, ws, it0); p0_load(a, v, ln2); p0_to_lds(a, v, scr, ln2);
                const P0Item b = p0_item(args, ws, it0 + 1); p0_load(b, v, ln2);
                p0_store(a, scr, ln2); p0_to_lds(b, v, scr, ln2); p0_store(b, scr, ln2);
                continue;
            }
            if (p >= Q_A0 && p < Q_LOC) { ssd_local(args, lds, p - Q_A0); ITEM_DONE(CW_LDONE); continue; }
            if (p >= Q_ATT1 && p < Q_SCAN) { ITEM_WAIT(CW_LDONE, 320); { int te_ = tid; asm volatile("" : "+v"(te_)); ssd_scan(args, p - Q_ATT1, te_); } ITEM_DONE(CW_SDONE); continue; }
            if (p >= Q_ATT2 && p < Q_OUT) { ITEM_WAIT(CW_SDONE, 64); ssd_out(args, lds, p - Q_ATT2); continue; }
            const int ap = p < Q_A0 ? p : (p < Q_ATT1 ? p - Q_LOC + 256 : (p < Q_ATT2 ? p - Q_SCAN + 256 + NA1 : p - Q_OUT + 256 + NA1 + NA2));
            const int grp = ap / 3, rr = ap - 3 * grp;
            int tl_ = threadIdx.x; asm volatile("" : "+v"(tl_));
            const int r32 = tl_ & 31, hi = (tl_ >> 5) & 1, wv_ = __builtin_amdgcn_readfirstlane(tl_ >> 6), map = wv_ >> 2, w4 = wv_ & 3;
            const float lam = blkc[0];
            f32x16 o[4];
            if (rr == 1) {
                const int b = grp & 31, h = grp >> 5;
                const float cs = exp2f(-(float)(h + 1)) * LOG2E;
                const int qi = r32 < 16 ? r32 : 15;
                const bf16* qrow = Qb + (size_t)(MP + 16 * b + qi) * 1024 + h * 128 + map * 64 + hi * 8;
                att::SrcSample src{args.in[I_CK] + ((size_t)b * 1024 * 8 + h) * 128, args.in[I_CV] + ((size_t)b * 1024 * 8 + h) * 128,
                                   args.out + O_KS + (size_t)(16 * b) * 1024 + h * 128, args.out + O_VS + (size_t)(16 * b) * 1024 + h * 128};
                att::attn_core<float, 2, 16, att::SrcSample>(o, qrow, (float)(1024 + qi), cs, 16, 0, 18, src, (char*)lds_raw, lds, map * 64);
                att::attn_finish(o, lam, args.in[I_GSUB], A2 + h * 128, MP + 16 * b, 16, w4 == 0, (char*)lds_raw);
            } else {
                const int q = 2 * grp + (rr == 2 ? 1 : 0), j = 63 - (q >> 3), h = 7 - (q & 7);
                const float cs = exp2f(-(float)(h + 1)) * LOG2E;
                const float wv = blkc[8 + h];
                int t0 = (int)ceilf(((float)(128 * j - 63) - wv) * (1.0f / 64.f)); t0 = t0 < 0 ? 0 : (t0 & ~1);
                const int row = 128 * j + 32 * w4 + r32;
                const bf16* qrow = Qb + (size_t)row * 1024 + h * 128 + map * 64 + hi * 8;
                att::SrcPrompt src{Kb + h * 128, Vb + h * 128};
                att::attn_core<bf16, 1, 64, att::SrcPrompt>(o, qrow, (float)row, cs, 2 * j + (w4 >> 1), t0, 2 * j + 2, src, (char*)lds_raw, lds, map * 64);
                att::attn_finish(o, lam, args.in[I_GSUB], A2 + h * 128, 128 * j + 32 * w4, 32, true, (char*)lds_raw);
            }
        }
#undef ITEM_DONE
#undef ITEM_WAIT
    }
    SEAM(2);

    if (IN(3)) {
        pg8::Gemm g{(const bf16*)(ws + WS_A2), WOUT, MT, DM, DM}; pg8::SplitOrder S; S.init(MP, MT, DM, DM, G, bx, NSL5);
        EpiOutProj E{args.in[I_XP], args.in[I_XS], args.out + O_Y, XN, (float*)(ws + WS_RS1), (float*)(ws + WS_SLAB5)};
        pg8::gemm_phase<EpiOutProj, pg8::SplitOrder, true, true>(lds, g, S, E);
    }
    SEAM(3);

    if (IN(4)) {
        int tq_ = threadIdx.x; asm volatile("" : "+v"(tq_)); const int lane = tq_ & 63;
        const int gw = vcu * NWAVES + wave, NGW = G * NWAVES;
        const float* slabs = (const float*)(ws + WS_SLAB5); const float* rs = (const float*)(ws + WS_RS1); float* rstd1 = (float*)(ws + WS_RSTD1);
        for (int rr = (gw & 3) == 0 ? (gw >> 2) : MS; rr < MS; rr += NGW / 4) {
            const int row = MP + rr, pms = rr >> 8, rl = rr & 255;
            const float* xr = args.in[I_XS] + (size_t)rr * DM; float ss = 0.f;
            f32x4 vv[8];
#pragma unroll
            for (int jh = 0; jh < 8; jh += 4) {
                f32x4 ld[4][NSL5 + 1];
#pragma unroll
                for (int jj = 0; jj < 4; ++jj) { const int j = jh + jj; ld[jj][NSL5] = *(const f32x4*)(xr + 4 * lane + 256 * j);
                    const float* sp = slabs + ((size_t)(pms * 8 + j) * NSL5) * 65536 + (size_t)rl * 256 + 4 * lane;
#pragma unroll
                    for (int q = 0; q < NSL5; ++q) ld[jj][q] = *(const f32x4*)(sp + (size_t)q * 65536); }
                asm volatile("" ::: "memory");
#pragma unroll
                for (int jj = 0; jj < 4; ++jj) { f32x4 a = ld[jj][NSL5];
#pragma unroll
                    for (int q = 0; q < NSL5; ++q) a = a + ld[jj][q];
                    vv[jh + jj] = a; }
            }
#pragma unroll
            for (int j = 0; j < 8; ++j) {
                const f32x4 v = vv[j];
                *(f32x4*)(args.out + O_Y + (size_t)row * DM + 4 * lane + 256 * j) = v;
                v2u w; w.x = pk2(v[0], v[1]); w.y = pk2(v[2], v[3]); *(v2u*)(XN + (size_t)row * DM + 4 * lane + 256 * j) = w;
                ss += (v[0] * v[0] + v[1] * v[1]) + (v[2] * v[2] + v[3] * v[3]);
            }
            ss = wave_sum(ss);
            if (lane == 0) rstd1[row] = 1.0f / sqrtf(ss * (1.0f / DM) + EPS);
        }
        for (int row = bx * (NWAVES * 64) + tid; row < MP; row += G * NWAVES * 64) {
            const float* p = rs + (size_t)row * 32; float t = 0.f;
#pragma unroll
            for (int q = 0; q < 8; ++q) { const f32x4 a = *(const f32x4*)(p + 4 * q); t += (a[0] + a[1]) + (a[2] + a[3]); }
            rstd1[row] = 1.0f / sqrtf(t * (1.0f / DM) + EPS);
        }
    }
    SEAM(4);

    if (IN(5)) {
        pg8::Gemm g{XN, WGU, MT, 2 * DFF, DM}; pg8::StaticOrder S; S.init(MT, 2 * DFF, DM, G, bx);
        EpiGateUp E{(bf16*)(ws + WS_HID), (const float*)(ws + WS_RSTD1), args.out, args.in[I_FCW], args.in[I_FCB], args.in[I_SFFN], (float*)(ws + WS_FRG), (float*)(ws + WS_FRU), (float*)(ws + WS_LRG), lds};
        pg8::gemm_phase<EpiGateUp, pg8::StaticOrder, true, true>(lds, g, S, E);
    }
    SEAM(5);

    if (IN(6)) {
        pg8::Gemm g{(const bf16*)(ws + WS_HID), WDN, MT, DM, DFF}; pg8::SplitOrder S; S.init(MP, MT, DM, DFF, G, bx, NSL9);
        {
            pg8::Unit u0;
            if (S.next(0, u0) && u0.slab < 0 && u0.pm > 0) {
                const float* frg = (const float*)(ws + WS_FRG) + (size_t)u0.pm * 2 * DFF; const float* fru = (const float*)(ws + WS_FRU) + (size_t)u0.pm * 2 * DFF;
                const float* lrg = (const float*)(ws + WS_LRG) + (size_t)(u0.pm - 1) * 2 * DFF; bf16* HID = (bf16*)(ws + WS_HID);
                const float* fw = args.in[I_FCW]; const float* fb = args.in[I_FCB];
                for (int task = tid; task < 2 * (DFF / 8); task += NWAVES * 64) {
                    const int r = task / (DFF / 8), col = 8 * (task % (DFF / 8));
                    const float* p2 = r == 0 ? lrg + col : lrg + DFF + col; const float* p1 = r == 0 ? lrg + DFF + col : frg + col; const float* p0 = frg + (size_t)r * DFF + col; const float* pu = fru + (size_t)r * DFF + col;
                    float o[8];
#pragma unroll
                    for (int e = 0; e < 8; ++e) { const float y = fb[col + e] + fw[col + e] * p2[e] + fw[DFF + col + e] * p1[e] + fw[2 * DFF + col + e] * p0[e]; o[e] = siluf(y) * pu[e]; }
                    v4u w; w.x = pk2(o[0], o[1]); w.y = pk2(o[2], o[3]); w.z = pk2(o[4], o[5]); w.w = pk2(o[6], o[7]);
                    *(v4u*)(HID + (size_t)(256 * u0.pm + r) * DFF + col) = w;
                }
                asm volatile("s_waitcnt vmcnt(0)" ::: "memory");
            }
            __syncthreads();
        }
        EpiDown E{args.out + O_Y, (float*)(ws + WS_RS2), (float*)(ws + WS_SLAB9), XN  };
        pg8::gemm_phase<EpiDown, pg8::SplitOrder, true, true>(lds, g, S, E);
    }
    SEAM(6);

    if (IN(7)) {
        int tq_ = threadIdx.x; asm volatile("" : "+v"(tq_)); const int lane = tq_ & 63;
        const int gw = vcu * NWAVES + wave, NGW = G * NWAVES;
        const float* rs = (const float*)(ws + WS_RS2); const float* gf = args.in[I_GFIN]; const float* slabs = (const float*)(ws + WS_SLAB9);
        f32x4 gfv[8];
#pragma unroll
        for (int j = 0; j < 8; ++j) gfv[j] = *(const f32x4*)(gf + 4 * lane + 256 * j);
        const int nprompt = (MP - gw + NGW - 1) / NGW, nsample = (gw & 3) == 0 ? (MS - (gw >> 2) + NGW / 4 - 1) / (NGW / 4) : 0;
        for (int st = 0; st < nprompt + nsample; ++st) {
            const int m = st < nprompt ? gw + st * NGW : MP + (gw >> 2) + (st - nprompt) * (NGW / 4);
            float* row = args.out + O_Y + (size_t)m * DM;
            f32x4 v[8]; float t;
            if (m < MP) {
                t = lane < 32 ? rs[(size_t)m * 32 + lane] : 0.f;
#pragma unroll
                for (int j = 0; j < 8; ++j) { const v2u w = *(const v2u*)(XN + (size_t)m * DM + 4 * lane + 256 * j); v[j] = (f32x4){bflo(w.x), bfhi(w.x), bflo(w.y), bfhi(w.y)}; }
            } else {
                const int rr = m - MP, pms = rr >> 8, rl = rr & 255; t = 0.f;
#pragma unroll
                for (int jh = 0; jh < 8; jh += 2) {
                    f32x4 ld[2][NSL9 + 1];
#pragma unroll
                    for (int jj = 0; jj < 2; ++jj) { const int j = jh + jj; ld[jj][NSL9] = *(const f32x4*)(row + 4 * lane + 256 * j);
                        const float* sp = slabs + ((size_t)(pms * 8 + j) * NSL9) * 65536 + (size_t)rl * 256 + 4 * lane;
#pragma unroll
                        for (int q = 0; q < NSL9; ++q) ld[jj][q] = *(const f32x4*)(sp + (size_t)q * 65536); }
                    asm volatile("" ::: "memory");
#pragma unroll
                    for (int jj = 0; jj < 2; ++jj) { f32x4 a = ld[jj][NSL9];
#pragma unroll
                        for (int q = 0; q < NSL9; ++q) a = a + ld[jj][q];
                        v[jh + jj] = a; t += (a[0] * a[0] + a[1] * a[1]) + (a[2] * a[2] + a[3] * a[3]); }
                }
            }
            t = wave_sum(t);
            const float rstd = 1.0f / sqrtf(t * (1.0f / DM) + EPS);
#pragma unroll
            for (int j = 0; j < 8; ++j) *(f32x4*)(row + 4 * lane + 256 * j) = v[j] * rstd * gfv[j];
        }
    }
    PEND(N_PHASES - 1);
#ifdef PROBE_PHASE
    if (blockIdx.x == 0 && tid == 0) { const unsigned long long d = (pr_b - pr_a) * PROBE_SCALE, t0 = __builtin_amdgcn_s_memrealtime(); while (__builtin_amdgcn_s_memrealtime() - t0 < d) __builtin_amdgcn_s_sleep(16); }
#endif
#undef IN
#undef SEAM
}

extern "C" void kernel_launch(void* const* d_in, const int* in_sizes, int n_in, void* d_out, int out_size, void* d_ws, size_t ws_size, hipStream_t stream) {
    static int grid = 0;
    if (grid == 0) {
        if (n_in != 28 || out_size != (int)O_END || ws_size < WS_END) { fprintf(stderr, "kernel_launch: unexpected shapes: n_in %d out %d ws %zu (need %zu)\n", n_in, out_size, ws_size, (size_t)WS_END); grid = -1; return; }
        int dev = 0, cus = 0;
        if (hipGetDevice(&dev) != hipSuccess || hipDeviceGetAttribute(&cus, hipDeviceAttributeMultiprocessorCount, dev) != hipSuccess) { grid = -1; return; }
        if (hipFuncSetAttribute((const void*)hymba_fwd, hipFuncAttributeMaxDynamicSharedMemorySize, LDS_BYTES) != hipSuccess) { fprintf(stderr, "kernel_launch: hipFuncSetAttribute failed\n"); grid = -1; return; }
        (void)hipGetLastError();
        grid = cus;
    }
    if (grid < 0) return;
    (void)hipMemsetAsync((char*)d_ws + WS_CTL, 0, CTL_ZERO_BYTES, stream);
    Args a{};
    for (int i = 0; i < 28; ++i) a.in[i] = (const float*)d_in[i];
    a.out = (float*)d_out; a.ws = (unsigned char*)d_ws;
    if (N_LAUNCHES == 1) {
        a.ph_lo = 0; a.ph_hi = N_PHASES; a.li = 0;
        hipLaunchKernelGGL(hymba_fwd, dim3(grid), dim3(NWAVES * 64), LDS_BYTES, stream, a);
    } else {
        for (int li = 0; li < N_PHASES; ++li) { a.ph_lo = li; a.ph_hi = li + 1; a.li = li; hipLaunchKernelGGL(hymba_fwd, dim3(grid), dim3(NWAVES * 64), LDS_BYTES, stream, a); }
    }
    const hipError_t le = hipPeekAtLastError();
    if (le != hipSuccess) fprintf(stderr, "kernel_launch: launch failed: %s\n", hipGetErrorName(le));
}
```

```cpp
#include <hip/hip_runtime.h>
#include <hip/hip_bf16.h>
#include <cstdio>
#include <cstdint>

#ifndef MK_N_LAUNCHES
#define MK_N_LAUNCHES 1
#endif

namespace pg8 {
#define PG8_LAS __attribute__((address_space(3)))
typedef unsigned short bf16_t;
typedef short bf16x8 __attribute__((ext_vector_type(8)));
typedef float f32x4 __attribute__((ext_vector_type(4)));
typedef unsigned u32x4 __attribute__((ext_vector_type(4)));
constexpr int BM = 256, BK = 64, HALF = 128, HTB = HALF * BK * 2, STAGE_BYTES = 8 * HTB, NXCD = 8, WGM = 8;

__host__ __device__ __forceinline__ int lds_byte(int r, int c) { const int st = (r >> 4) * 2 + (c >> 5), rr = r & 15, cc = c & 31, ob = rr * 64 + cc * 2; return st * 1024 + (ob ^ (((ob >> 9) & 1) << 5)); }
__host__ __device__ __forceinline__ void stage_rc(int b, int& R, int& C) { const int st = b / 1024, sb = b % 1024, swz = sb ^ (((sb >> 9) & 1) << 5); R = (st >> 1) * 16 + swz / 64; C = (st & 1) * 32 + (swz % 64) / 2; }
__host__ __device__ __forceinline__ int perm32(int rho) { const int n = rho >> 4, i = rho & 15; return 8 * (i >> 2) + 4 * n + (i & 3); }

struct Unit { int pm, pn, k0, nk, slab; };
struct Gemm { const bf16_t* A; const bf16_t* Bt; int M, N, K; };

struct StaticOrder {
    int nM, nN, nwg, G, c, nkt;
    __host__ __device__ void init(int M, int N, int K, int G_, int c_) { nM = M / BM; nN = N / BM; nwg = nM * nN; G = G_; c = c_; nkt = K / BK; }
    __host__ __device__ __forceinline__ bool next(int i, Unit& u) const { return at((long)i * G + c, u); }
    __host__ __device__ __forceinline__ bool at(long L, Unit& u) const {
        if (L >= nwg) return false; u.k0 = 0; u.nk = nkt; u.slab = -1;
        int wgid = (int)L; { const int q = nwg / NXCD, r = nwg % NXCD, xcd = wgid % NXCD, off = wgid / NXCD; wgid = (xcd < r ? xcd * (q + 1) : r * (q + 1) + (xcd - r) * q) + off; }
        const int nig = WGM * nN, gid = wgid / nig, fm = gid * WGM, gsz = (nM - fm) < WGM ? (nM - fm) : WGM;
        u.pm = fm + ((wgid % nig) % gsz); u.pn = (wgid % nig) / gsz; return true;
    }
    __device__ __forceinline__ void a_ready(const Unit&) const {}
    __device__ __forceinline__ void done(const Unit&) const {}
};

struct SplitOrder {
    StaticOrder P; int nN, nsl, nks, ntail;
    __host__ __device__ void init(int MPR, int M, int N, int K, int G_, int c_, int nsl_) { P.init(MPR, N, K, G_, c_); nN = N / BM; nsl = nsl_; nks = (K / BK) / nsl_; ntail = ((M - MPR) / BM) * nN; }
    __host__ __device__ __forceinline__ bool next(int i, Unit& u) const {
        const long L = (long)i * P.G + P.c;
        const int sidx = (int)(L - P.nwg);
        if (sidx >= ntail * nsl) return false;
        int pm, pn, k0, nk, slab;
        if (sidx < 0) {
            int wgid = (int)L; { const int q = P.nwg / NXCD, r = P.nwg % NXCD, xcd = wgid % NXCD, off = wgid / NXCD; wgid = (xcd < r ? xcd * (q + 1) : r * (q + 1) + (xcd - r) * q) + off; }
            const int nig = WGM * P.nN, gid = wgid / nig, fm = gid * WGM, gsz = (P.nM - fm) < WGM ? (P.nM - fm) : WGM;
            pm = fm + ((wgid % nig) % gsz); pn = (wgid % nig) / gsz; k0 = 0; nk = P.nkt; slab = -1;
        } else {
            const int tile = sidx / nsl, sl = sidx % nsl; pm = P.nM + tile / nN; pn = tile % nN; k0 = sl * nks; nk = nks; slab = sidx;
        }
        u.pm = pm; u.pn = pn; u.k0 = k0; u.nk = nk; u.slab = slab; return true;
    }
    __device__ __forceinline__ void a_ready(const Unit&) const {}
    __device__ __forceinline__ void done(const Unit&) const {}
};

typedef float f32x2_t __attribute__((ext_vector_type(2))); typedef __bf16 bf16x2_t __attribute__((ext_vector_type(2)));
__device__ __forceinline__ unsigned cvt_pk_bf16(float lo, float hi) { f32x2_t v = {lo, hi}; bf16x2_t b = __builtin_convertvector(v, bf16x2_t); return __builtin_bit_cast(unsigned, b); }

template <class Epi, class Sched, bool ALIGN_EPI = false, bool SP2 = false>
__device__ __forceinline__ void gemm_phase(PG8_LAS unsigned char* lds, const Gemm g, const Sched& S, const Epi& E) {
    const int tid = threadIdx.x, wid = __builtin_amdgcn_readfirstlane(tid >> 6), lane = tid & 63, wr = wid >> 2, wc = wid & 3, fr = lane & 15, fq = lane >> 4;
    const int K = g.K;
    unsigned voffA[2], voffB[2];
#pragma unroll
    for (int i = 0; i < 2; ++i) { int R, C; stage_rc(tid * 16 + i * 8192, R, C); const int Rb = Epi::PERM ? ((R & ~31) + perm32(R & 31)) : R;
        voffA[i] = (unsigned)(R * K + C) * 2u; voffB[i] = (unsigned)(Rb * K + C) * 2u; }
    const size_t kstep = (size_t)(BK * 2);
    const size_t hstep = (size_t)HALF * K * 2;
    const size_t tstep = 2 * hstep;
    const unsigned ldsw = (unsigned)wid * 1024u;
    const int aoff = lds_byte(wr * 64 + fr, fq * 8), boff = lds_byte(wc * 32 + fr, fq * 8);
#define PG8_SA(b, h) (((b) * 2 + (h)) * HTB)
#define PG8_SB(b, h) ((4 + (b) * 2 + (h)) * HTB)
#define PG8_STAGE(bufoff, gbase, voff) do { _Pragma("unroll") for (int _i = 0; _i < 2; ++_i) \
        __builtin_amdgcn_global_load_lds((const unsigned*)((const char*)(gbase) + (voff)[_i]), (PG8_LAS unsigned*)(lds + (bufoff) + ldsw + _i * 8192), 16, 0, 0); } while (0)
#define PG8_LDA(dst, b, h) do { _Pragma("unroll") for (int m = 0; m < 4; ++m) _Pragma("unroll") for (int k = 0; k < 2; ++k) dst[m][k] = *(const PG8_LAS bf16x8*)(lds + PG8_SA(b, h) + aoff + m * 2048 + k * 1024); } while (0)
#define PG8_LDB(dst, b, h) do { _Pragma("unroll") for (int n = 0; n < 2; ++n) _Pragma("unroll") for (int k = 0; k < 2; ++k) dst[n][k] = *(const PG8_LAS bf16x8*)(lds + PG8_SB(b, h) + boff + n * 2048 + k * 1024); } while (0)
#define PG8_MMA(ai, bj, At, Bt) do { __builtin_amdgcn_s_setprio(1); _Pragma("unroll") for (int m = 0; m < 4; ++m) _Pragma("unroll") for (int n = 0; n < 2; ++n) _Pragma("unroll") for (int k = 0; k < 2; ++k) \
        acc[ai][bj][m][n] = __builtin_amdgcn_mfma_f32_16x16x32_bf16(Bt[n][k], At[m][k], acc[ai][bj][m][n], 0, 0, 0); __builtin_amdgcn_s_setprio(0); } while (0)
#define PG8_WAIT_V(n) asm volatile("s_waitcnt vmcnt(" #n ")" ::: "memory")
#define PG8_WAIT_L(n) asm volatile("s_waitcnt lgkmcnt(" #n ")" ::: "memory")
#define PG8_BAR __builtin_amdgcn_s_barrier()
#define PG8_SCHED __builtin_amdgcn_sched_barrier(0)
    Unit cur, nxt; int ui = 0;
    if (!S.next(0, cur)) return;
    f32x4 acc[2][2][4][2];
#pragma unroll
    for (int a = 0; a < 2; ++a)
#pragma unroll
        for (int b = 0; b < 2; ++b)
#pragma unroll
            for (int m = 0; m < 4; ++m)
#pragma unroll
                for (int n = 0; n < 2; ++n) acc[a][b][m][n] = (f32x4){0.f, 0.f, 0.f, 0.f};
    bf16x8 At[4][2], B0[2][2], B1[2][2];
    const char* cA = (const char*)g.A + (size_t)cur.pm * tstep + (size_t)cur.k0 * kstep; const char* cB = (const char*)g.Bt + (size_t)cur.pn * tstep + (size_t)cur.k0 * kstep;
    S.a_ready(cur);
    if constexpr (SP2) {
        PG8_STAGE(PG8_SB(0, 0), cB, voffB); PG8_STAGE(PG8_SB(0, 1), cB + hstep, voffB); PG8_STAGE(PG8_SA(0, 0), cA, voffA); PG8_STAGE(PG8_SA(0, 1), cA + hstep, voffA);
        if (wr == 1) PG8_BAR;
        PG8_WAIT_V(2); PG8_BAR;
        PG8_STAGE(PG8_SB(1, 0), cB + kstep, voffB); PG8_STAGE(PG8_SA(1, 0), cA + kstep, voffA); PG8_STAGE(PG8_SB(1, 1), cB + hstep + kstep, voffB);
        PG8_WAIT_V(6); PG8_BAR;
    } else {
        PG8_STAGE(PG8_SB(0, 0), cB, voffB); PG8_STAGE(PG8_SA(0, 0), cA, voffA); PG8_STAGE(PG8_SB(0, 1), cB + hstep, voffB); PG8_STAGE(PG8_SA(0, 1), cA + hstep, voffA);
        if (wr == 1) PG8_BAR;
        PG8_WAIT_V(4); PG8_BAR;
        PG8_STAGE(PG8_SB(1, 0), cB + kstep, voffB); PG8_STAGE(PG8_SA(1, 0), cA + kstep, voffA); PG8_STAGE(PG8_SB(1, 1), cB + hstep + kstep, voffB);
        PG8_WAIT_V(6); PG8_BAR;
    }
    for (;;) {
        const bool has_next = S.next(ui + 1, nxt);
        const char* nA = has_next ? (const char*)g.A + (size_t)nxt.pm * tstep + (size_t)nxt.k0 * kstep : cA; const char* nB = has_next ? (const char*)g.Bt + (size_t)nxt.pn * tstep + (size_t)nxt.k0 * kstep : cB;
        const int nt = cur.nk;
        for (int t = 0; t < nt; t += 2) {
            const bool last = (t == nt - 2);
            const char* a1 = cA + (size_t)(t + 1) * kstep;
            const char* a2 = last ? nA : cA + (size_t)(t + 2) * kstep; const char* b2 = last ? nB : cB + (size_t)(t + 2) * kstep;
            const char* a3 = a2 + kstep; const char* b3 = b2 + kstep;
            if (last && has_next) S.a_ready(nxt);
            if constexpr (SP2) {
            PG8_LDB(B0, 0, 0); PG8_LDB(B1, 0, 1); PG8_SCHED; PG8_LDA(At, 0, 0); PG8_STAGE(PG8_SA(1, 1), a1 + hstep, voffA);
            PG8_WAIT_V(8); PG8_WAIT_L(0); PG8_BAR; PG8_MMA(0, 0, At, B0); PG8_MMA(0, 1, At, B1); PG8_BAR; PG8_SCHED;
            PG8_LDA(At, 0, 1); PG8_STAGE(PG8_SB(0, 0), b2, voffB); PG8_STAGE(PG8_SB(0, 1), b2 + hstep, voffB); PG8_STAGE(PG8_SA(0, 0), a2, voffA);
            PG8_WAIT_V(8); PG8_WAIT_L(0); PG8_BAR; PG8_MMA(1, 0, At, B0); PG8_MMA(1, 1, At, B1); PG8_BAR; PG8_SCHED;
            PG8_LDB(B0, 1, 0); PG8_LDB(B1, 1, 1); PG8_SCHED; PG8_LDA(At, 1, 0); PG8_STAGE(PG8_SA(0, 1), a2 + hstep, voffA);
            PG8_WAIT_V(8); PG8_WAIT_L(0); PG8_BAR; PG8_MMA(0, 0, At, B0); PG8_MMA(0, 1, At, B1); PG8_BAR; PG8_SCHED;
            PG8_LDA(At, 1, 1); PG8_STAGE(PG8_SB(1, 0), b3, voffB); PG8_STAGE(PG8_SB(1, 1), b3 + hstep, voffB); PG8_STAGE(PG8_SA(1, 0), a3, voffA);
            PG8_WAIT_V(8); PG8_WAIT_L(0); PG8_BAR; PG8_MMA(1, 0, At, B0); PG8_MMA(1, 1, At, B1); PG8_BAR; PG8_SCHED;
            } else {
            PG8_LDB(B0, 0, 0); PG8_SCHED; PG8_LDA(At, 0, 0); PG8_STAGE(PG8_SA(1, 1), a1 + hstep, voffA);
            PG8_WAIT_L(8); PG8_BAR; PG8_WAIT_L(0); PG8_MMA(0, 0, At, B0); PG8_BAR; PG8_SCHED;
            PG8_LDB(B1, 0, 1); PG8_STAGE(PG8_SB(0, 0), b2, voffB);
            PG8_BAR; PG8_WAIT_L(0); PG8_MMA(0, 1, At, B1); PG8_BAR;
            PG8_LDA(At, 0, 1); PG8_STAGE(PG8_SA(0, 0), a2, voffA);
            PG8_BAR; PG8_WAIT_L(0); PG8_MMA(1, 0, At, B0); PG8_BAR; PG8_SCHED;
            PG8_STAGE(PG8_SB(0, 1), b2 + hstep, voffB);
            PG8_WAIT_V(6); PG8_BAR; PG8_MMA(1, 1, At, B1); PG8_BAR;
            PG8_LDB(B0, 1, 0); PG8_SCHED; PG8_LDA(At, 1, 0); PG8_STAGE(PG8_SA(0, 1), a2 + hstep, voffA);
            PG8_WAIT_L(8); PG8_BAR; PG8_WAIT_L(0); PG8_MMA(0, 0, At, B0); PG8_BAR; PG8_SCHED;
            PG8_LDB(B1, 1, 1); PG8_STAGE(PG8_SB(1, 0), b3, voffB);
            PG8_BAR; PG8_WAIT_L(0); PG8_MMA(0, 1, At, B1); PG8_BAR;
            PG8_LDA(At, 1, 1); PG8_STAGE(PG8_SA(1, 0), a3, voffA);
            PG8_BAR; PG8_WAIT_L(0); PG8_MMA(1, 0, At, B0); PG8_BAR; PG8_SCHED;
            PG8_STAGE(PG8_SB(1, 1), b3 + hstep, voffB);
            PG8_WAIT_V(6); PG8_BAR; PG8_MMA(1, 1, At, B1); PG8_BAR;
            }
        }
        if constexpr (ALIGN_EPI) { if (wr == 0) PG8_BAR; }
        if constexpr (!Epi::AFTER_DRAIN) { E(acc, cur, wr, wc, fr, fq); S.done(cur); }
        if (!has_next) break;
#pragma unroll
        for (int a = 0; a < 2; ++a)
#pragma unroll
            for (int b = 0; b < 2; ++b)
#pragma unroll
                for (int m = 0; m < 4; ++m)
#pragma unroll
                    for (int n = 0; n < 2; ++n) acc[a][b][m][n] = (f32x4){0.f, 0.f, 0.f, 0.f};
        cur = nxt; cA = nA; cB = nB; ++ui;
        if constexpr (ALIGN_EPI) { if (wr == 1) PG8_BAR; }
    }
    PG8_WAIT_V(0);
    if constexpr (!ALIGN_EPI) { if (wr == 0) PG8_BAR; }
    PG8_BAR;
#undef PG8_SA
#undef PG8_SB
#undef PG8_STAGE
#undef PG8_LDA
#undef PG8_LDB
#undef PG8_MMA
#undef PG8_WAIT_V
#undef PG8_WAIT_L
#undef PG8_BAR
#undef PG8_SCHED
}
}

constexpr int NWAVES = 8;
constexpr int MP = 8192, MS = 512, MT = MP + MS;
constexpr int DM = 2048, NPROJ = 5632, DIN = 5648, DFF = 5632, NH = 8, NSH = 16;
constexpr int NCHUNK = 128 + 32;
constexpr float EPS = 1e-6f;
constexpr float LOG2E = 1.4426950408889634f;
constexpr float QSCALE = 0.125f * LOG2E;
constexpr float LAM_INIT = 0.2f;

constexpr size_t O_Y = 0, O_KP = 17825792, O_VP = 26214400, O_CP = 34603008, O_SP = 34607616, O_FP = 34738688,
                 O_KS = 34749952, O_VS = 35274240, O_CS = 35798528, O_SS = 35945984, O_FS = 40140288, O_END = 40500736;

constexpr size_t MiB = 1u << 20;
constexpr size_t WS_CTL = 0, CTL_ZERO_BYTES = 64 * 1024;
constexpr size_t WS_WIN = 2 * MiB, WS_WOUT = 24 * MiB, WS_WGU = 32 * MiB, WS_WDN = 76 * MiB, WS_XN = 98 * MiB;
constexpr size_t WS_Q = 132 * MiB, WS_K = 150 * MiB, WS_V = 168 * MiB, WS_Z = 186 * MiB, WS_XBC = 204 * MiB, WS_DT = 230 * MiB;
constexpr size_t WS_ACUM = 235 * MiB, WS_CD = 236 * MiB, WS_CB = 237 * MiB, WS_A2 = 243 * MiB, WS_SCH = 277 * MiB, WS_HPREV = 357 * MiB, WS_YP = 397 * MiB;
constexpr size_t WS_RS1 = 437 * MiB, WS_RS2 = 439 * MiB, WS_FRG = 441 * MiB, WS_FRU = 443 * MiB, WS_LRG = 445 * MiB, WS_RSTD1 = 447 * MiB, WS_END = 448 * MiB;
constexpr size_t WS_HID = 132 * MiB, WS_G = 226 * MiB, WS_U = 320 * MiB;
constexpr size_t WS_SLAB5 = WS_Q, WS_SLAB9 = WS_G;
static_assert(WS_U + (size_t)MT * DFF * 2 <= WS_RS1, "ffn overlay");
constexpr int CW_BAR = 4096, CW_QK = 8192, CW_QUEUE = 8320, CW_LDONE = 8384, CW_SDONE = 8448;

constexpr int LDS_BYTES = 147456, LDSCTL_OFF = 146432;

#define GAS __attribute__((address_space(1)))
#define LAS __attribute__((address_space(3)))
typedef unsigned short bf16;
typedef unsigned v4u __attribute__((ext_vector_type(4)));
typedef unsigned v2u __attribute__((ext_vector_type(2)));
typedef float f32x2 __attribute__((ext_vector_type(2)));
typedef float f32x4 __attribute__((ext_vector_type(4)));
typedef float f32x8 __attribute__((ext_vector_type(8)));
typedef float f32x16 __attribute__((ext_vector_type(16)));
typedef short bf16x8 __attribute__((ext_vector_type(8)));
typedef short s16x4 __attribute__((ext_vector_type(4)));
typedef GAS unsigned gu32;

__device__ __forceinline__ unsigned f2bf(float f) { unsigned u = __builtin_bit_cast(unsigned, f); return (u + 0x7fffu + ((u >> 16) & 1u)) >> 16; }
__device__ __forceinline__ unsigned pk2(float lo, float hi) { return pg8::cvt_pk_bf16(lo, hi); }
__device__ __forceinline__ float bf2f(unsigned short b) { return __builtin_bit_cast(float, (unsigned)b << 16); }
__device__ __forceinline__ float bflo(unsigned w) { return __builtin_bit_cast(float, w << 16); }
__device__ __forceinline__ float bfhi(unsigned w) { return __builtin_bit_cast(float, w & 0xffff0000u); }
__device__ __forceinline__ float wave_sum(float v) {
#pragma unroll
    for (int o = 1; o < 64; o <<= 1) v += __shfl_xor(v, o);
    return v;
}
__device__ __forceinline__ float siluf(float x) { return x * __builtin_amdgcn_rcpf(1.f + __builtin_amdgcn_exp2f(-LOG2E * x)); }

#define XB_TMO      128
#define XB_XCNT(j)  (256  + 64 * (j))
#define XB_XSUB(j)  (1280 + 64 * (j))
#define XB_XGEN(j)  (2304 + 64 * (j))
#define XB_TOP      3328
#define XB_TOPGEN   3392
#define XCD_BAR_WORDS 3456
#define XB_SPIN_CAP (1u << 18)
__device__ __forceinline__ unsigned xb_ld(unsigned* p)              { return __hip_atomic_load(p, __ATOMIC_RELAXED, __HIP_MEMORY_SCOPE_AGENT); }
__device__ __forceinline__ unsigned xb_add(unsigned* p, unsigned v) { return __hip_atomic_fetch_add(p, v, __ATOMIC_RELAXED, __HIP_MEMORY_SCOPE_AGENT); }
__device__ __forceinline__ unsigned xb_xcc_id() { return (unsigned)__builtin_amdgcn_s_getreg((3 << 11) | 20) & 0xFu; }
#define XB_SPIN(cond, bar) do { unsigned _sp = 0; while (cond) { __builtin_amdgcn_s_sleep(1); \
    if ((++_sp & 255u) == 0u) { if (xb_ld(&(bar)[XB_TMO])) break; if (_sp > XB_SPIN_CAP) { atomicAdd(&(bar)[XB_TMO], 1u); break; } } } } while (0)
struct XcdBarrier { unsigned* bar; unsigned x; volatile LAS unsigned* st; };
__device__ __forceinline__ XcdBarrier xcd_barrier_post(unsigned* bar, volatile LAS unsigned* st) {
    XcdBarrier b; b.bar = bar; b.x = xb_xcc_id(); b.st = st;
    if (threadIdx.x == 0) (void)xb_add(&bar[XB_XCNT(b.x)], 1u);
    return b;
}
__device__ __forceinline__ void xcd_barrier_complete(unsigned* bar, unsigned x, unsigned& nloc, unsigned& nx) {
    const unsigned G = gridDim.x * gridDim.y * gridDim.z;
    unsigned sum, cnt, mine, sp = 0u;
    for (;;) {
        sum = 0u; cnt = 0u; mine = 0u;
#pragma unroll
        for (unsigned j = 0; j < 16; ++j) { const unsigned c = xb_ld(&bar[XB_XCNT(j)]); sum += c; cnt += (c > 0u) ? 1u : 0u; mine = (j == x) ? c : mine; }
        if (sum == G) break;
        __builtin_amdgcn_s_sleep(1);
        if ((++sp & 255u) == 0u) { if (xb_ld(&bar[XB_TMO])) break; if (sp > XB_SPIN_CAP) { atomicAdd(&bar[XB_TMO], 1u); break; } }
    }
    nloc = mine > 0u ? mine : 1u; nx = cnt > 0u ? cnt : 1u;
}
__device__ __forceinline__ void xcd_barrier(const XcdBarrier& b) {
    asm volatile("s_waitcnt vmcnt(0)" ::: "memory");
    __syncthreads();
    if (threadIdx.x == 0) {
        unsigned* bar = b.bar;
        __builtin_amdgcn_s_waitcnt(0);
        unsigned nloc = b.st[0], nx = b.st[1];
        if (nloc == 0u) { xcd_barrier_complete(bar, b.x, nloc, nx); b.st[0] = nloc; b.st[1] = nx; }
        const unsigned old = xb_add(&bar[XB_XSUB(b.x)], 1u);
        const unsigned gen = old / nloc;
        if (old + 1u == (gen + 1u) * nloc) {
            __builtin_amdgcn_fence(__ATOMIC_RELEASE, "agent");
            asm volatile("s_waitcnt vmcnt(0)" ::: "memory");
            const unsigned og = xb_add(&bar[XB_TOP], 1u);
            const unsigned tg = og / nx;
            if (og + 1u == (tg + 1u) * nx) xb_add(&bar[XB_TOPGEN], 1u);
            else XB_SPIN(xb_ld(&bar[XB_TOPGEN]) == tg, bar);
            __builtin_amdgcn_fence(__ATOMIC_ACQUIRE, "agent");
            xb_add(&bar[XB_XGEN(b.x)], 1u);
            asm volatile("s_waitcnt vmcnt(0)" ::: "memory");
        } else {
            XB_SPIN(xb_ld(&bar[XB_XGEN(b.x)]) == gen, bar);
            __builtin_amdgcn_fence(__ATOMIC_ACQUIRE, "agent");
            asm volatile("s_waitcnt vmcnt(0)" ::: "memory");
        }
    }
    __syncthreads();
}

struct Args {
    const float* in[28];
    float* out; unsigned char* ws;
    int ph_lo, ph_hi, li, pad;
};
enum { I_XP = 0, I_XS, I_CK, I_CV, I_SCONV, I_SSM, I_SFFN, I_GMIX, I_WIN, I_LQ1, I_LK1, I_LQ2, I_LK2, I_GSUB, I_CONVW, I_CONVB, I_DTB, I_ALOG, I_DSKIP,
       I_GSSM, I_WOUT, I_GFFN, I_WGATE, I_WUP, I_FCW, I_FCB, I_WDOWN, I_GFIN };

struct P0Item { const float* W; const float* g; bf16* WT; int ldw, K, k0, n0, rowbase; };
__device__ __forceinline__ void p0_load(const P0Item& it, f32x4 (&v)[16], int lane) {
    const int rsub = lane >> 4, c4 = 4 * (lane & 15);
#pragma unroll
    for (int i = 0; i < 16; ++i) v[i] = *(const f32x4*)(it.W + (size_t)(it.k0 + 4 * i + rsub) * it.ldw + it.n0 + c4);
}
__device__ __forceinline__ void p0_to_lds(const P0Item& it, const f32x4 (&v)[16], LAS float* scr, int lane) {
    const int rsub = lane >> 4, c4 = 4 * (lane & 15);
#pragma unroll
    for (int i = 0; i < 16; ++i) { const int r = 4 * i + rsub; f32x4 x = v[i]; if (it.g) x = x * it.g[it.k0 + r];
        LAS float* d = scr + r * 65 + c4; d[0] = x[0]; d[1] = x[1]; d[2] = x[2]; d[3] = x[3]; }
    asm volatile("s_waitcnt lgkmcnt(0)" ::: "memory");
}
__device__ __forceinline__ void p0_store(const P0Item& it, LAS float* scr, int lane) {
    const int c = lane & 7;
#pragma unroll
    for (int j = 0; j < 8; ++j) { const int n = (lane >> 3) + 8 * j; const LAS float* sp = scr + (8 * c) * 65 + n;
        v4u o; o.x = pk2(sp[0 * 65], sp[1 * 65]); o.y = pk2(sp[2 * 65], sp[3 * 65]); o.z = pk2(sp[4 * 65], sp[5 * 65]); o.w = pk2(sp[6 * 65], sp[7 * 65]);
        *(GAS v4u*)(it.WT + (size_t)(it.rowbase + n) * it.K + it.k0 + 8 * c) = o; }
    asm volatile("s_waitcnt lgkmcnt(0)" ::: "memory");
}
__device__ __forceinline__ P0Item p0_item(const Args& A, unsigned char* ws, int r) {
    constexpr int I_A = 32 * 88, I_B = 32 * 32, I_C = 32 * 88, I_D = 32 * 88;
    P0Item it;
    if (r < I_A) { it = P0Item{A.in[I_WIN], nullptr, (bf16*)(ws + WS_WIN), DIN, DM, 64 * (r / 88), 64 * (r % 88), 64 * (r % 88)}; return it; } r -= I_A;
    if (r < I_B) { it = P0Item{A.in[I_WOUT], nullptr, (bf16*)(ws + WS_WOUT), DM, DM, 64 * (r / 32), 64 * (r % 32), 64 * (r % 32)}; return it; } r -= I_B;
    if (r < I_C) { const int n0 = 64 * (r % 88); it = P0Item{A.in[I_WGATE], A.in[I_GFFN], (bf16*)(ws + WS_WGU), DFF, DM, 64 * (r / 88), n0, (n0 >> 7) * 256 + (n0 & 127)}; return it; } r -= I_C;
    if (r < I_D) { const int n0 = 64 * (r % 88); it = P0Item{A.in[I_WUP], A.in[I_GFFN], (bf16*)(ws + WS_WGU), DFF, DM, 64 * (r / 88), n0, (n0 >> 7) * 256 + 128 + (n0 & 127)}; return it; } r -= I_D;
    it = P0Item{A.in[I_WDOWN], nullptr, (bf16*)(ws + WS_WDN), DM, DFF, 64 * (r / 32), 64 * (r % 32), 64 * (r % 32)}; return it;
}

struct EpiInProj {
    static constexpr bool PERM = true, AFTER_DRAIN = false;
    bf16 *Q, *K, *V, *Z, *XBC; float* out; unsigned* qk2;
    __device__ __forceinline__ void operator()(const pg8::f32x4 (&acc)[2][2][4][2], const pg8::Unit& u, int wr, int wc, int fr, int fq) const {
        const int region = u.pn >> 2;
        float nmax[2] = {0.f, 0.f};
        const int row0 = u.pm * 256 + wr * 64 + fr;
        const int cl = wc * 32 + 8 * fq;
#pragma unroll
        for (int ai = 0; ai < 2; ++ai)
#pragma unroll
            for (int m = 0; m < 4; ++m) {
                const int row = row0 + ai * 128 + m * 16;
#pragma unroll
                for (int bj = 0; bj < 2; ++bj) {
                    f32x4 v0 = acc[ai][bj][m][0], v1 = acc[ai][bj][m][1];
                    if (region < 4) {
                        const int c = (u.pn & 3) * 256 + bj * 128 + cl;
                        if (region == 0) { v0 = v0 * QSCALE; v1 = v1 * QSCALE; }
                        if (region < 2) { float ss = (v0[0] * v0[0] + v0[1] * v0[1]) + (v0[2] * v0[2] + v0[3] * v0[3]) + (v1[0] * v1[0] + v1[1] * v1[1]) + (v1[2] * v1[2] + v1[3] * v1[3]);
                            ss += __shfl_xor(ss, 16); ss += __shfl_xor(ss, 32); nmax[bj] = fmaxf(nmax[bj], ss); }
                        v4u w; w.x = pk2(v0[0], v0[1]); w.y = pk2(v0[2], v0[3]); w.z = pk2(v1[0], v1[1]); w.w = pk2(v1[2], v1[3]);
                        bf16* dst = region == 0 ? Q : region == 1 ? K : region == 2 ? V : Z;
                        *(v4u*)(dst + (size_t)row * 1024 + c) = w;
                        if (region == 1 || region == 2) {
                            float* o = out + (row < MP ? (region == 1 ? O_KP : O_VP) + (size_t)row * 1024 : (region == 1 ? O_KS : O_VS) + (size_t)(row - MP) * 1024) + c;
                            *(f32x4*)o = v0; *(f32x4*)(o + 4) = v1;
                        }
                    } else {
                        const int c = (u.pn - 16) * 256 + bj * 128 + cl;
                        v4u w; w.x = pk2(v0[0], v0[1]); w.y = pk2(v0[2], v0[3]); w.z = pk2(v1[0], v1[1]); w.w = pk2(v1[2], v1[3]);
                        *(v4u*)(XBC + (size_t)row * 1536 + c) = w;
                        if (row >= MP - 3) {
                            float* o = nullptr;
                            if (row < MP) o = out + O_CP + (size_t)(row - (MP - 3)) * 1536 + c;
                            else { const int rr = row - MP, i = rr & 15; if (i >= 13) o = out + O_CS + (size_t)((rr >> 4) * 3 + (i - 13)) * 1536 + c; }
                            if (o) { *(f32x4*)o = v0; *(f32x4*)(o + 4) = v1; }
                        }
                    }
                }
            }
        if (region < 2 && u.pm < MP / 256) {
#pragma unroll
            for (int bj = 0; bj < 2; ++bj) { float v = nmax[bj]; v = fmaxf(v, __shfl_xor(v, 1)); v = fmaxf(v, __shfl_xor(v, 2)); v = fmaxf(v, __shfl_xor(v, 4)); v = fmaxf(v, __shfl_xor(v, 8));
                if (fr == 0 && fq == 0) atomicMax(qk2 + region * 32 + (u.pn & 3) * 8 + bj * 4 + wc, __float_as_uint(v)); }
        }
    }
};

__device__ __forceinline__ void store_slab(float* slab, const pg8::f32x4 (&acc)[2][2][4][2], int wr, int wc, int fr, int fq) {
#pragma unroll
    for (int ai = 0; ai < 2; ++ai)
#pragma unroll
        for (int m = 0; m < 4; ++m)
#pragma unroll
            for (int bj = 0; bj < 2; ++bj) { float* o = slab + (size_t)(ai * 128 + wr * 64 + m * 16 + fr) * 256 + bj * 128 + wc * 32 + 8 * fq; *(f32x4*)o = acc[ai][bj][m][0]; *(f32x4*)(o + 4) = acc[ai][bj][m][1]; }
}

struct EpiOutProj {
    static constexpr bool PERM = true, AFTER_DRAIN = false;
    const float* xp; const float* xs; float* out; bf16* x1b; float* rs; float* slabs;
    __device__ __forceinline__ void operator()(const pg8::f32x4 (&acc)[2][2][4][2], const pg8::Unit& u, int wr, int wc, int fr, int fq) const {
        if (u.slab >= 0) { store_slab(slabs + (size_t)u.slab * 65536, acc, wr, wc, fr, fq); return; }
        const int row0 = u.pm * 256 + wr * 64 + fr;
        const int c0 = u.pn * 256 + wc * 32 + 8 * fq;
#pragma unroll
        for (int ai = 0; ai < 2; ++ai)
#pragma unroll
        for (int mh = 0; mh < 2; ++mh) {
            f32x4 xr[2][2][2];
#pragma unroll
            for (int m = 0; m < 2; ++m) { const int row = row0 + ai * 128 + (2 * mh + m) * 16; const float* xrow = row < MP ? xp + (size_t)row * DM : xs + (size_t)(row - MP) * DM;
#pragma unroll
                for (int bj = 0; bj < 2; ++bj) { xr[m][bj][0] = *(const f32x4*)(xrow + c0 + bj * 128); xr[m][bj][1] = *(const f32x4*)(xrow + c0 + bj * 128 + 4); } }
            asm volatile("" ::: "memory");
#pragma unroll
            for (int m = 0; m < 2; ++m) {
                const int mm = 2 * mh + m, row = row0 + ai * 128 + mm * 16;
                float ss = 0.f;
#pragma unroll
                for (int bj = 0; bj < 2; ++bj) {
                    const int c = c0 + bj * 128;
                    const f32x4 v0 = acc[ai][bj][mm][0] + xr[m][bj][0], v1 = acc[ai][bj][mm][1] + xr[m][bj][1];
                    v4u w; w.x = pk2(v0[0], v0[1]); w.y = pk2(v0[2], v0[3]); w.z = pk2(v1[0], v1[1]); w.w = pk2(v1[2], v1[3]);
                    *(v4u*)(x1b + (size_t)row * DM + c) = w;
                    ss += (v0[0] * v0[0] + v0[1] * v0[1]) + (v0[2] * v0[2] + v0[3] * v0[3]) + (v1[0] * v1[0] + v1[1] * v1[1]) + (v1[2] * v1[2] + v1[3] * v1[3]);
                }
                ss += __shfl_xor(ss, 16); ss += __shfl_xor(ss, 32);
                if (fq == 0) rs[(size_t)row * 32 + u.pn * 4 + wc] = ss;
            }
        }
    }
};


constexpr int HALO_OFF = 131072;
struct EpiGateUp {
    static constexpr bool PERM = true, AFTER_DRAIN = false;
    bf16* HID; const float* rs; float* out; const float* fcw; const float* fcb; const float* sffn; float* frg; float* fru; float* lrg; LAS unsigned char* lds;
    __device__ __forceinline__ void operator()(const pg8::f32x4 (&acc)[2][2][4][2], const pg8::Unit& u, int wr, int wc, int fr, int fq) const {
        const int row0 = u.pm * 256 + wr * 64 + fr;
        const int cl = wc * 32 + 8 * fq, c = u.pn * 128 + cl;
        const bool sample = u.pm >= MP / 256;
        f32x4 w0[2], w1[2], w2[2], bb[2];
#pragma unroll
        for (int n = 0; n < 2; ++n) { w0[n] = *(const f32x4*)(fcw + c + 4 * n); w1[n] = *(const f32x4*)(fcw + DFF + c + 4 * n); w2[n] = *(const f32x4*)(fcw + 2 * DFF + c + 4 * n); bb[n] = *(const f32x4*)(fcb + c + 4 * n); }
        float rstd8[2][4];
#pragma unroll
        for (int ai = 0; ai < 2; ++ai)
#pragma unroll
            for (int m = 0; m < 4; ++m) rstd8[ai][m] = rs[row0 + ai * 128 + m * 16];
        LAS float* halo = (LAS float*)(lds + HALO_OFF);
        if (!sample) {
#pragma unroll
            for (int ai = 0; ai < 2; ++ai) {
                const float r3 = rstd8[ai][3];
                if (fr >= 14) { LAS float* hp = halo + ((2 * ai + wr) * 2 + (fr - 14)) * 128 + cl; *(LAS f32x4*)hp = acc[ai][0][3][0] * r3; *(LAS f32x4*)(hp + 4) = acc[ai][0][3][1] * r3; }
            }
        }
        asm volatile("s_waitcnt lgkmcnt(0)" ::: "memory"); __builtin_amdgcn_s_barrier(); asm volatile("" ::: "memory");
#pragma unroll
        for (int ai = 0; ai < 2; ++ai) {
            f32x4 gprev[2] = {(f32x4){0.f, 0.f, 0.f, 0.f}, (f32x4){0.f, 0.f, 0.f, 0.f}};
#pragma unroll
            for (int m = 0; m < 4; ++m) {
                const int row = row0 + ai * 128 + m * 16;
                const float rstd = rstd8[ai][m];
                f32x4 gc[2] = {acc[ai][0][m][0] * rstd, acc[ai][0][m][1] * rstd};
                f32x4 pv[2];
                bool defer = false;
                if (sample) {
                    const int b = (row - fr - MP) >> 4;
                    const float* sp = sffn + ((size_t)b * 2 + (fr & 1)) * DFF + c;
                    pv[0] = *(const f32x4*)sp; pv[1] = *(const f32x4*)(sp + 4);
                } else if (m > 0) { pv[0] = gprev[0]; pv[1] = gprev[1]; }
                else {
                    const int gidx = 2 * ai + wr;
                    if (gidx > 0) { const LAS float* hp = halo + ((gidx - 1) * 2 + (fr & 1)) * 128 + cl; pv[0] = *(const LAS f32x4*)hp; pv[1] = *(const LAS f32x4*)(hp + 4); }
                    else { pv[0] = (f32x4){0.f, 0.f, 0.f, 0.f}; pv[1] = pv[0]; defer = u.pm > 0; }
                }
                const f32x4 u0 = acc[ai][1][m][0] * rstd, u1 = acc[ai][1][m][1] * rstd;
                f32x4 h[2];
#pragma unroll
                for (int n = 0; n < 2; ++n)
#pragma unroll
                    for (int e = 0; e < 4; ++e) {
                        const float cur = gc[n][e], pvv = pv[n][e];
                        const int ci = __float_as_int(cur), pi_ = __float_as_int(pvv);
                        const float g1 = __int_as_float(__builtin_amdgcn_update_dpp(__builtin_amdgcn_update_dpp(0, pi_, 0x121, 0xf, 0xf, false), ci, 0x111, 0xf, 0xf, false));
                        const float g2 = __int_as_float(__builtin_amdgcn_update_dpp(__builtin_amdgcn_update_dpp(0, pi_, 0x122, 0xf, 0xf, false), ci, 0x112, 0xf, 0xf, false));
                        const float y = bb[n][e] + w0[n][e] * g2 + w1[n][e] * g1 + w2[n][e] * cur;
                        h[n][e] = siluf(y) * (n == 0 ? u0[e] : u1[e]);
                    }
                if (defer && fr < 2) {
                    float* o = frg + ((size_t)u.pm * 2 + fr) * DFF + c; *(f32x4*)o = gc[0]; *(f32x4*)(o + 4) = gc[1];
                    o = fru + ((size_t)u.pm * 2 + fr) * DFF + c; *(f32x4*)o = u0; *(f32x4*)(o + 4) = u1;
                } else {
                    v4u w; w.x = pk2(h[0][0], h[0][1]); w.y = pk2(h[0][2], h[0][3]); w.z = pk2(h[1][0], h[1][1]); w.w = pk2(h[1][2], h[1][3]);
                    *(v4u*)(HID + (size_t)row * DFF + c) = w;
                }
                if (!sample && ai == 1 && m == 3 && wr == 1 && fr >= 14) { float* o = lrg + ((size_t)u.pm * 2 + (fr - 14)) * DFF + c; *(f32x4*)o = gc[0]; *(f32x4*)(o + 4) = gc[1]; }
                if (row >= MP - 2) {
                    float* o = nullptr;
                    if (row < MP) o = out + O_FP + (size_t)(row - (MP - 2)) * DFF + c;
                    else { const int rr = row - MP, i = rr & 15; if (i >= 14) o = out + O_FS + (size_t)((rr >> 4) * 2 + (i - 14)) * DFF + c; }
                    if (o) { *(f32x4*)o = gc[0]; *(f32x4*)(o + 4) = gc[1]; }
                }
                gprev[0] = gc[0]; gprev[1] = gc[1];
            }
        }
    }
};

struct EpiDown {
    static constexpr bool PERM = true, AFTER_DRAIN = false;
    float* out; float* rs; float* slabs; bf16* x2b;
    __device__ __forceinline__ void operator()(const pg8::f32x4 (&acc)[2][2][4][2], const pg8::Unit& u, int wr, int wc, int fr, int fq) const {
        if (u.slab >= 0) { store_slab(slabs + (size_t)u.slab * 65536, acc, wr, wc, fr, fq); return; }
        const int row0 = u.pm * 256 + wr * 64 + fr;
        const int c0 = u.pn * 256 + wc * 32 + 8 * fq;
#pragma unroll
        for (int ai = 0; ai < 2; ++ai)
#pragma unroll
        for (int mh = 0; mh < 2; ++mh) {
            f32x4 xr[2][2][2];
#pragma unroll
            for (int m = 0; m < 2; ++m) { const bf16* xrow = x2b + (size_t)(row0 + ai * 128 + (2 * mh + m) * 16) * DM;
#pragma unroll
                for (int bj = 0; bj < 2; ++bj) { const v4u w = *(const v4u*)(xrow + c0 + bj * 128);
                    xr[m][bj][0] = (f32x4){bflo(w.x), bfhi(w.x), bflo(w.y), bfhi(w.y)}; xr[m][bj][1] = (f32x4){bflo(w.z), bfhi(w.z), bflo(w.w), bfhi(w.w)}; } }
            asm volatile("" ::: "memory");
#pragma unroll
            for (int m = 0; m < 2; ++m) {
                const int mm = 2 * mh + m, row = row0 + ai * 128 + mm * 16;
                float ss = 0.f;
#pragma unroll
                for (int bj = 0; bj < 2; ++bj) {
                    const f32x4 v0 = acc[ai][bj][mm][0] + xr[m][bj][0], v1 = acc[ai][bj][mm][1] + xr[m][bj][1];
                    v4u w; w.x = pk2(v0[0], v0[1]); w.y = pk2(v0[2], v0[3]); w.z = pk2(v1[0], v1[1]); w.w = pk2(v1[2], v1[3]);
                    *(v4u*)(x2b + (size_t)row * DM + c0 + bj * 128) = w;
                    ss += (v0[0] * v0[0] + v0[1] * v0[1]) + (v0[2] * v0[2] + v0[3] * v0[3]) + (v1[0] * v1[0] + v1[1] * v1[1]) + (v1[2] * v1[2] + v1[3] * v1[3]);
                }
                ss += __shfl_xor(ss, 16); ss += __shfl_xor(ss, 32);
                if (fq == 0) rs[(size_t)row * 32 + u.pn * 4 + wc] = ss;
            }
        }
    }
};

__device__ __forceinline__ int crow(int r, int hi) { return (r & 3) + 8 * (r >> 2) + 4 * hi; }
#define MFMA32(a, b, c) __builtin_amdgcn_mfma_f32_32x32x16_bf16((a), (b), (c), 0, 0, 0)

constexpr int SL_XT = 0, SL_XT_ROW = 144, SL_XT_HEAD = 64 * 144;
constexpr int SL_BN = 73728, SL_N_ROW = 272;
constexpr int SL_CN = SL_BN + 64 * 272;
constexpr int SL_BT = SL_CN + 64 * 272, SL_BT_ROW = 144;
constexpr int SL_DT = SL_BT + 128 * 144;
constexpr int SL_AC = SL_DT + 2048;
constexpr int SL_W = SL_AC + 2048;
constexpr int SL_END = SL_W + 2048;
static_assert(SL_END <= LDSCTL_OFF, "ssd lds");

struct SsdUnit { int cid, g, T, rbase, batch; };
__device__ __forceinline__ SsdUnit ssd_unit(int u) {
    SsdUnit s;
    if (u < 256) { s.cid = u >> 1; s.g = u & 1; s.T = 64; s.rbase = 64 * s.cid; s.batch = -1; }
    else { const int v = u - 256; s.batch = v >> 1; s.g = v & 1; s.cid = 128 + s.batch; s.T = 16; s.rbase = MP + 16 * s.batch; }
    return s;
}

__device__ __forceinline__ void ssd_local(const Args& A, LAS unsigned char* lds, int u) {
    const SsdUnit su = ssd_unit(u);
    int tid_ = threadIdx.x; asm volatile("" : "+v"(tid_));
    const int tid = tid_, lane = tid & 63, wid = __builtin_amdgcn_readfirstlane(tid >> 6), r32 = lane & 31, hi = lane >> 5;
    unsigned char* ws = A.ws;
    const bf16* XBC = (const bf16*)(ws + WS_XBC);
    const float* DT = (const float*)(ws + WS_DT);
    if (tid < 384) {
        const int tq = tid & 3, cgi = tid >> 2, t0 = 16 * tq;
        int col; if (cgi < 64) col = 512 * su.g + 8 * cgi; else if (cgi < 80) col = 1024 + 128 * su.g + 8 * (cgi - 64); else col = 1280 + 128 * su.g + 8 * (cgi - 80);
        unsigned ow[8][8];
        if (t0 < su.T) {
            const float* cw = A.in[I_CONVW]; const float* cbias = A.in[I_CONVB];
            f32x4 wv[4][2], bb[2];
#pragma unroll
            for (int n = 0; n < 2; ++n) { bb[n] = *(const f32x4*)(cbias + col + 4 * n);
#pragma unroll
                for (int k = 0; k < 4; ++k) wv[k][n] = *(const f32x4*)(cw + k * 1536 + col + 4 * n); }
            float hist[3][8];
#pragma unroll
            for (int k = 0; k < 3; ++k) {
                const int t = t0 - 3 + k;
                if (t >= 0 || (su.batch < 0 && su.cid > 0)) {
                    const v4u raw = *(const v4u*)(XBC + (size_t)(su.rbase + t) * 1536 + col);
                    hist[k][0] = bflo(raw.x); hist[k][1] = bfhi(raw.x); hist[k][2] = bflo(raw.y); hist[k][3] = bfhi(raw.y); hist[k][4] = bflo(raw.z); hist[k][5] = bfhi(raw.z); hist[k][6] = bflo(raw.w); hist[k][7] = bfhi(raw.w);
                } else if (su.batch >= 0) {
                    const float* sp = A.in[I_SCONV] + ((size_t)su.batch * 3 + (3 + t)) * 1536 + col;
                    const f32x4 a = *(const f32x4*)sp, b = *(const f32x4*)(sp + 4);
                    hist[k][0] = a[0]; hist[k][1] = a[1]; hist[k][2] = a[2]; hist[k][3] = a[3]; hist[k][4] = b[0]; hist[k][5] = b[1]; hist[k][6] = b[2]; hist[k][7] = b[3];
                } else {
#pragma unroll
                    for (int e = 0; e < 8; ++e) hist[k][e] = 0.f;
                }
            }
            v4u rawv[16];
#pragma unroll
            for (int tt = 0; tt < 16; ++tt) rawv[tt] = *(const v4u*)(XBC + (size_t)(su.rbase + t0 + tt) * 1536 + col);
            float prev[8];
#pragma unroll
            for (int tt = 0; tt < 16; ++tt) {
                const v4u raw = rawv[tt];
                float v[8], o[8]; v[0] = bflo(raw.x); v[1] = bfhi(raw.x); v[2] = bflo(raw.y); v[3] = bfhi(raw.y); v[4] = bflo(raw.z); v[5] = bfhi(raw.z); v[6] = bflo(raw.w); v[7] = bfhi(raw.w);
#pragma unroll
                for (int e = 0; e < 8; ++e) { const float y = bb[e >> 2][e & 3] + wv[0][e >> 2][e & 3] * hist[0][e] + wv[1][e >> 2][e & 3] * hist[1][e] + wv[2][e >> 2][e & 3] * hist[2][e] + wv[3][e >> 2][e & 3] * v[e];
                    o[e] = siluf(y); hist[0][e] = hist[1][e]; hist[1][e] = hist[2][e]; hist[2][e] = v[e]; }
                if (cgi >= 64) {
                    v4u w; w.x = pk2(o[0], o[1]); w.y = pk2(o[2], o[3]); w.z = pk2(o[4], o[5]); w.w = pk2(o[6], o[7]);
                    const int n0 = 8 * ((cgi - 64) & 15), t = t0 + tt;
                    if (cgi < 80) *(LAS v4u*)(lds + SL_BN + t * SL_N_ROW + n0 * 2) = w;
                    else { *(LAS v4u*)(lds + SL_CN + t * SL_N_ROW + n0 * 2) = w; *(v4u*)((bf16*)(ws + WS_CB) + ((size_t)su.cid * 64 + t) * 256 + su.g * 128 + n0) = w; }
                }
                if (tt & 1) {
#pragma unroll
                    for (int e = 0; e < 8; ++e) ow[e][tt >> 1] = pk2(prev[e], o[e]);
                } else {
#pragma unroll
                    for (int e = 0; e < 8; ++e) prev[e] = o[e];
                }
            }
        } else {
#pragma unroll
            for (int e = 0; e < 8; ++e)
#pragma unroll
                for (int k = 0; k < 8; ++k) ow[e][k] = 0u;
            { unsigned z1 = 0u; asm volatile("" : "+v"(z1)); ow[0][0] = z1; }
            if (cgi >= 64) {
                const int n0 = 8 * ((cgi - 64) & 15); unsigned z0 = 0u; asm volatile("" : "+v"(z0)); const v4u z = {z0, z0, z0, z0};
#pragma unroll
                for (int tt = 0; tt < 16; ++tt) { const int t = t0 + tt;
                    if (cgi < 80) *(LAS v4u*)(lds + SL_BN + t * SL_N_ROW + n0 * 2) = z;
                    else { *(LAS v4u*)(lds + SL_CN + t * SL_N_ROW + n0 * 2) = z; *(v4u*)((bf16*)(ws + WS_CB) + ((size_t)su.cid * 64 + t) * 256 + su.g * 128 + n0) = z; } }
            }
        }
        if (cgi < 80) {
            LAS unsigned char* tb_ = cgi < 64 ? lds + SL_XT + (cgi >> 3) * SL_XT_HEAD + (8 * (cgi & 7)) * SL_XT_ROW + t0 * 2 : lds + SL_BT + (8 * (cgi - 64)) * SL_BT_ROW + t0 * 2;
#pragma unroll
            for (int e = 0; e < 8; ++e) { const v4u a = {ow[e][0], ow[e][1], ow[e][2], ow[e][3]}, b = {ow[e][4], ow[e][5], ow[e][6], ow[e][7]};
                *(LAS v4u*)(tb_ + e * SL_XT_ROW) = a; *(LAS v4u*)(tb_ + e * SL_XT_ROW + 16) = b; }
        }
    }
    {
        const int h = 8 * su.g + wid;
        const float dt = lane < su.T ? DT[(size_t)(su.rbase + lane) * 16 + h] : 0.f;
        const float a = -__expf(A.in[I_ALOG][h]);
        float x = dt * a;
#pragma unroll
        for (int off = 1; off < 64; off <<= 1) { const float v = __shfl_up(x, off); if (lane >= off) x += v; }
        const float tot = __shfl(x, 63);
        LAS float* dl = (LAS float*)(lds + SL_DT) + wid * 64; LAS float* al = (LAS float*)(lds + SL_AC) + wid * 64; LAS float* wl = (LAS float*)(lds + SL_W) + wid * 64;
        dl[lane] = dt; al[lane] = x; wl[lane] = __expf(tot - x) * dt;
        ((float*)(ws + WS_ACUM))[((size_t)su.cid * 16 + h) * 64 + lane] = x;
        if (lane == 63) ((float*)(ws + WS_CD))[su.cid * 16 + h] = __expf(tot);
    }
    __syncthreads();
    {
        const int h = 8 * su.g + wid;
        const float dskip = A.in[I_DSKIP][h];
        const LAS unsigned char* bn = lds + SL_BN; const LAS unsigned char* cn = lds + SL_CN; const LAS unsigned char* bt = lds + SL_BT;
        const LAS unsigned char* xt = lds + SL_XT + wid * SL_XT_HEAD;
        const LAS float* dl = (const LAS float*)(lds + SL_DT) + wid * 64; const LAS float* al = (const LAS float*)(lds + SL_AC) + wid * 64; const LAS float* wl = (const LAS float*)(lds + SL_W) + wid * 64;
        f32x16 cb00 = {}, cb01 = {}, cb11 = {};
#pragma unroll
        for (int ks = 0; ks < 8; ++ks) {
            const int kb = (16 * ks + 8 * hi) * 2;
            const bf16x8 b0 = *(const LAS bf16x8*)(bn + r32 * SL_N_ROW + kb), b1 = *(const LAS bf16x8*)(bn + (32 + r32) * SL_N_ROW + kb);
            const bf16x8 c0 = *(const LAS bf16x8*)(cn + r32 * SL_N_ROW + kb), c1 = *(const LAS bf16x8*)(cn + (32 + r32) * SL_N_ROW + kb);
            cb00 = MFMA32(b0, c0, cb00); cb01 = MFMA32(b0, c1, cb01); cb11 = MFMA32(b1, c1, cb11);
        }
        const float at0 = al[r32], at1 = al[32 + r32];
        bf16x8 X00[2], X01[2], X11[2];
        {
            float m00[16], m01[16], m11[16];
#pragma unroll
            for (int r = 0; r < 16; ++r) {
                const int s0 = crow(r, hi), s1 = 32 + s0;
                const float as0 = al[s0], as1 = al[s1], ds0 = dl[s0], ds1 = dl[s1];
                float v = (s0 <= r32) ? cb00[r] * __expf(at0 - as0) * ds0 : 0.f; if (s0 == r32) v += dskip; m00[r] = v;
                m01[r] = cb01[r] * __expf(at1 - as0) * ds0;
                v = (s0 <= r32) ? cb11[r] * __expf(at1 - as1) * ds1 : 0.f; if (s0 == r32) v += dskip; m11[r] = v;
            }
#pragma unroll
            for (int sp = 0; sp < 2; ++sp) {
                v4u w;
                w.x = pk2(m00[8 * sp + 0], m00[8 * sp + 1]); w.y = pk2(m00[8 * sp + 2], m00[8 * sp + 3]); w.z = pk2(m00[8 * sp + 4], m00[8 * sp + 5]); w.w = pk2(m00[8 * sp + 6], m00[8 * sp + 7]); X00[sp] = __builtin_bit_cast(bf16x8, w);
                w.x = pk2(m01[8 * sp + 0], m01[8 * sp + 1]); w.y = pk2(m01[8 * sp + 2], m01[8 * sp + 3]); w.z = pk2(m01[8 * sp + 4], m01[8 * sp + 5]); w.w = pk2(m01[8 * sp + 6], m01[8 * sp + 7]); X01[sp] = __builtin_bit_cast(bf16x8, w);
                w.x = pk2(m11[8 * sp + 0], m11[8 * sp + 1]); w.y = pk2(m11[8 * sp + 2], m11[8 * sp + 3]); w.z = pk2(m11[8 * sp + 4], m11[8 * sp + 5]); w.w = pk2(m11[8 * sp + 6], m11[8 * sp + 7]); X11[sp] = __builtin_bit_cast(bf16x8, w);
            }
        }
        unsigned* yp = (unsigned*)(ws + WS_YP) + ((size_t)su.cid * 16 + h) * 2048 + lane;
#pragma unroll
        for (int pi = 0; pi < 2; ++pi) {
            f32x16 y0 = {}, y1 = {};
#pragma unroll
            for (int i = 0; i < 2; ++i)
#pragma unroll
                for (int sp = 0; sp < 2; ++sp) {
                    const LAS unsigned char* ap = xt + (32 * pi + r32) * SL_XT_ROW + (32 * i + 16 * sp + 4 * hi) * 2;
                    const v2u lo = *(const LAS v2u*)ap, hh = *(const LAS v2u*)(ap + 16);
                    const v4u aw = {lo.x, lo.y, hh.x, hh.y}; const bf16x8 af = __builtin_bit_cast(bf16x8, aw);
                    if (i == 0) { y0 = MFMA32(af, X00[sp], y0); y1 = MFMA32(af, X01[sp], y1); }
                    else y1 = MFMA32(af, X11[sp], y1);
                }
#pragma unroll
            for (int r = 0; r < 16; r += 2) { yp[((pi * 2 + 0) * 8 + (r >> 1)) * 64] = pk2(y0[r], y0[r + 1]); yp[((pi * 2 + 1) * 8 + (r >> 1)) * 64] = pk2(y1[r], y1[r + 1]); }
        }
        bf16* sch = (bf16*)(ws + WS_SCH) + ((size_t)su.cid * 16 + h) * 8192;
#pragma unroll
        for (int pi = 0; pi < 2; ++pi) {
            f32x16 s0 = {}, s1 = {}, s2 = {}, s3 = {};
#pragma unroll
            for (int ks = 0; ks < 4; ++ks) {
                const int sb = 16 * ks + 8 * hi;
                const v4u raw = *(const LAS v4u*)(xt + (32 * pi + r32) * SL_XT_ROW + sb * 2);
                const f32x4 wa = *(const LAS f32x4*)(wl + sb), wb = *(const LAS f32x4*)(wl + sb + 4);
                v4u aw; aw.x = pk2(bflo(raw.x) * wa[0], bfhi(raw.x) * wa[1]); aw.y = pk2(bflo(raw.y) * wa[2], bfhi(raw.y) * wa[3]);
                aw.z = pk2(bflo(raw.z) * wb[0], bfhi(raw.z) * wb[1]); aw.w = pk2(bflo(raw.w) * wb[2], bfhi(raw.w) * wb[3]);
                const bf16x8 xf = __builtin_bit_cast(bf16x8, aw);
                const bf16x8 q0 = *(const LAS bf16x8*)(bt + (0 + r32) * SL_BT_ROW + sb * 2), q1 = *(const LAS bf16x8*)(bt + (32 + r32) * SL_BT_ROW + sb * 2);
                const bf16x8 q2 = *(const LAS bf16x8*)(bt + (64 + r32) * SL_BT_ROW + sb * 2), q3 = *(const LAS bf16x8*)(bt + (96 + r32) * SL_BT_ROW + sb * 2);
                s0 = MFMA32(q0, xf, s0); s1 = MFMA32(q1, xf, s1); s2 = MFMA32(q2, xf, s2); s3 = MFMA32(q3, xf, s3);
            }
            bf16* orow = sch + (size_t)(32 * pi + r32) * 128 + 4 * hi;
#pragma unroll
            for (int q = 0; q < 4; ++q) {
                v2u w;
                w.x = pk2(s0[4 * q], s0[4 * q + 1]); w.y = pk2(s0[4 * q + 2], s0[4 * q + 3]); *(v2u*)(orow + 0 + 8 * q) = w;
                w.x = pk2(s1[4 * q], s1[4 * q + 1]); w.y = pk2(s1[4 * q + 2], s1[4 * q + 3]); *(v2u*)(orow + 32 + 8 * q) = w;
                w.x = pk2(s2[4 * q], s2[4 * q + 1]); w.y = pk2(s2[4 * q + 2], s2[4 * q + 3]); *(v2u*)(orow + 64 + 8 * q) = w;
                w.x = pk2(s3[4 * q], s3[4 * q + 1]); w.y = pk2(s3[4 * q + 2], s3[4 * q + 3]); *(v2u*)(orow + 96 + 8 * q) = w;
            }
        }
    }
    __syncthreads();
}

__device__ __forceinline__ void ssd_scan(const Args& A, int item, int tid) {
    unsigned char* ws = A.ws;
    const int e4 = item * 2048 + 4 * tid, h = __builtin_amdgcn_readfirstlane(e4 >> 13);
    const v2u* SCH = (const v2u*)(ws + WS_SCH) + (e4 >> 2); const float* CD = (const float*)(ws + WS_CD) + h; v2u* HP = (v2u*)(ws + WS_HPREV) + (e4 >> 2);
    float st0 = 0.f, st1 = 0.f, st2 = 0.f, st3 = 0.f;
    for (int c0 = 0; c0 < 128; c0 += 32) {
        v2u sv[32]; float d[32];
#pragma unroll
        for (int k = 0; k < 32; ++k) { sv[k] = SCH[(size_t)(c0 + k) * 32768]; d[k] = CD[(c0 + k) * 16]; }
#pragma unroll
        for (int k = 0; k < 32; ++k) { v2u o; o.x = pk2(st0, st1); o.y = pk2(st2, st3); HP[(size_t)(c0 + k) * 32768] = o;
            st0 = d[k] * st0 + bflo(sv[k].x); st1 = d[k] * st1 + bfhi(sv[k].x); st2 = d[k] * st2 + bflo(sv[k].y); st3 = d[k] * st3 + bfhi(sv[k].y); }
    }
    { f32x4 o = {st0, st1, st2, st3}; *(f32x4*)(A.out + O_SP + e4) = o; }
    for (int b0 = 0; b0 < 32; b0 += 16) {
        v2u sv[16]; float d[16]; f32x4 h0[16];
#pragma unroll
        for (int k = 0; k < 16; ++k) { sv[k] = SCH[(size_t)(128 + b0 + k) * 32768]; d[k] = CD[(128 + b0 + k) * 16]; h0[k] = *(const f32x4*)(A.in[I_SSM] + (size_t)(b0 + k) * 131072 + e4); }
#pragma unroll
        for (int k = 0; k < 16; ++k) { v2u o; o.x = pk2(h0[k][0], h0[k][1]); o.y = pk2(h0[k][2], h0[k][3]); HP[(size_t)(128 + b0 + k) * 32768] = o;
            f32x4 r = {d[k] * h0[k][0] + bflo(sv[k].x), d[k] * h0[k][1] + bfhi(sv[k].x), d[k] * h0[k][2] + bflo(sv[k].y), d[k] * h0[k][3] + bfhi(sv[k].y)};
            *(f32x4*)(A.out + O_SS + (size_t)(b0 + k) * 131072 + e4) = r; }
    }
}

__device__ __forceinline__ void ssd_out(const Args& A, LAS unsigned char* lds, int u) {
    const SsdUnit su = ssd_unit(u);
    int tid_ = threadIdx.x; asm volatile("" : "+v"(tid_));
    const int tid = tid_, lane = tid & 63, wid = __builtin_amdgcn_readfirstlane(tid >> 6), r32 = lane & 31, hi = lane >> 5;
    unsigned char* ws = A.ws;
    const int h = 8 * su.g + wid;
    const bf16* HP = (const bf16*)(ws + WS_HPREV) + ((size_t)su.cid * 16 + h) * 8192;
    const bf16* CB = (const bf16*)(ws + WS_CB) + (size_t)su.cid * 64 * 256 + su.g * 128;
    const float* acum = (const float*)(ws + WS_ACUM) + ((size_t)su.cid * 16 + h) * 64;
    const unsigned* yp = (const unsigned*)(ws + WS_YP) + ((size_t)su.cid * 16 + h) * 2048 + lane;
    const bf16* Z = (const bf16*)(ws + WS_Z);
    float ac_[2]; v2u zz_[2][2][4]; unsigned ya_[2][2][4], yb_[2][2][4]; f32x4 gg_[2][4];
    { const float* gn0 = A.in[I_GSSM] + 512 * su.g + 64 * wid + 4 * hi;
#pragma unroll
      for (int pi = 0; pi < 2; ++pi)
#pragma unroll
        for (int q = 0; q < 4; ++q) gg_[pi][q] = *(const f32x4*)(gn0 + 32 * pi + 8 * q); }
#pragma unroll
    for (int j = 0; j < 2; ++j) {
        const int t = 32 * j + r32;
        ac_[j] = acum[t];
        const bf16* zr = Z + (size_t)(su.rbase + (t < su.T ? t : 0)) * 1024 + 512 * su.g + 64 * wid;
#pragma unroll
        for (int pi = 0; pi < 2; ++pi)
#pragma unroll
            for (int q = 0; q < 4; ++q) { zz_[j][pi][q] = *(const v2u*)(zr + 32 * pi + 8 * q + 4 * hi);
                ya_[j][pi][q] = yp[((pi * 2 + j) * 8 + 2 * q + 0) * 64]; yb_[j][pi][q] = yp[((pi * 2 + j) * 8 + 2 * q + 1) * 64]; }
    }
    f32x16 acc[2][2] = {};
#pragma unroll
    for (int kh = 0; kh < 2; ++kh) {
        bf16x8 fa0[4], fa1[4], fb0[4], fb1[4];
#pragma unroll
        for (int k = 0; k < 4; ++k) { const int kb = 16 * (4 * kh + k) + 8 * hi;
            fa0[k] = *(const bf16x8*)(HP + (size_t)r32 * 128 + kb); fa1[k] = *(const bf16x8*)(HP + (size_t)(32 + r32) * 128 + kb);
            fb0[k] = *(const bf16x8*)(CB + (size_t)r32 * 256 + kb); fb1[k] = *(const bf16x8*)(CB + (size_t)(32 + r32) * 256 + kb); }
#pragma unroll
        for (int k = 0; k < 4; ++k) { acc[0][0] = MFMA32(fa0[k], fb0[k], acc[0][0]); acc[0][1] = MFMA32(fa0[k], fb1[k], acc[0][1]); acc[1][0] = MFMA32(fa1[k], fb0[k], acc[1][0]); acc[1][1] = MFMA32(fa1[k], fb1[k], acc[1][1]); }
    }
    float ssq[2] = {0.f, 0.f};
#pragma unroll
    for (int j = 0; j < 2; ++j) {
        const float ea = __expf(ac_[j]);
#pragma unroll
        for (int pi = 0; pi < 2; ++pi)
#pragma unroll
            for (int q = 0; q < 4; ++q) {
                const v2u zz = zz_[j][pi][q];
                const float z0 = bflo(zz.x), z1 = bfhi(zz.x), z2 = bflo(zz.y), z3 = bfhi(zz.y);
                const unsigned ya = ya_[j][pi][q], yb = yb_[j][pi][q];
                float y;
                y = (bflo(ya) + ea * acc[pi][j][4 * q + 0]) * siluf(z0); acc[pi][j][4 * q + 0] = y; ssq[j] += y * y;
                y = (bfhi(ya) + ea * acc[pi][j][4 * q + 1]) * siluf(z1); acc[pi][j][4 * q + 1] = y; ssq[j] += y * y;
                y = (bflo(yb) + ea * acc[pi][j][4 * q + 2]) * siluf(z2); acc[pi][j][4 * q + 2] = y; ssq[j] += y * y;
                y = (bfhi(yb) + ea * acc[pi][j][4 * q + 3]) * siluf(z3); acc[pi][j][4 * q + 3] = y; ssq[j] += y * y;
            }
        ssq[j] += __shfl_xor(ssq[j], 32);
    }
    LAS float* red = (LAS float*)lds;
    if (hi == 0) { red[wid * 64 + r32] = ssq[0]; red[wid * 64 + 32 + r32] = ssq[1]; }
    __syncthreads();
    bf16* A2 = (bf16*)(ws + WS_A2);
#pragma unroll
    for (int j = 0; j < 2; ++j) {
        const int t = 32 * j + r32;
        float tot = 0.f;
#pragma unroll
        for (int w = 0; w < 8; ++w) tot += red[w * 64 + t];
        const float rstd = 1.0f / sqrtf(tot * (1.0f / 512.f) + EPS);
        if (t < su.T) {
            bf16* orow = A2 + (size_t)(su.rbase + t) * 2048 + 1024 + 512 * su.g + 64 * wid;
#pragma unroll
            for (int pi = 0; pi < 2; ++pi)
#pragma unroll
                for (int q = 0; q < 4; ++q) {
                    const int p = 32 * pi + 8 * q + 4 * hi;
                    const f32x4 gg = gg_[pi][q];
                    v2u w; w.x = pk2(acc[pi][j][4 * q + 0] * rstd * gg[0], acc[pi][j][4 * q + 1] * rstd * gg[1]); w.y = pk2(acc[pi][j][4 * q + 2] * rstd * gg[2], acc[pi][j][4 * q + 3] * rstd * gg[3]);
                    *(v2u*)(orow + p) = w;
                }
        }
    }
    __syncthreads();
}

namespace att {
constexpr int KVBLK = 64;
constexpr int SHM_V = 64 * 128 * 2, SHM_K = 64 * 128 * 2;
constexpr int NSLOT = 3;
constexpr int L_V = 0, L_K = NSLOT * SHM_V, L_WS = L_K + NSLOT * SHM_K, L_EX = 0  , L_END = L_WS + NWAVES * 128 * 4;
static_assert(4 * 16384 <= L_WS, "exchange slots fit under the rings");
static_assert(L_END <= LDSCTL_OFF, "attn lds");
constexpr float THR = 6.f;
#define KSWZ(row, colB) ((row) * 256 + ((colB) ^ (((row) & 15) << 4)))
#define SBAR() __builtin_amdgcn_sched_barrier(0)
__device__ __forceinline__ unsigned cvtpk(float lo, float hi) { return pg8::cvt_pk_bf16(lo, hi); }
template <typename TIn> struct Stage;
template <> struct Stage<bf16>  { using T = bf16x8;
  __device__ static __forceinline__ T ld8(const bf16* p) { return *reinterpret_cast<const bf16x8*>(p); }
  __device__ static __forceinline__ bf16x8 tobf(T x) { return x; } };
template <> struct Stage<float> { using T = f32x8;
  __device__ static __forceinline__ T ld8(const float* p) { return *reinterpret_cast<const f32x8*>(p); }
  __device__ static __forceinline__ bf16x8 tobf(T x) {
    v4u w = {cvtpk(x[0], x[1]), cvtpk(x[2], x[3]), cvtpk(x[4], x[5]), cvtpk(x[6], x[7])}; return __builtin_bit_cast(bf16x8, w); } };

__device__ __forceinline__ void partialSM(f32x16& p0, f32x16& p1, float& m_reg, float& mn, float& alpha, float base, float c32) {
  float pm0 = p0[0]; for (int r = 1; r < 16; ++r) pm0 = fmaxf(pm0, p0[r]);
  float pm1 = p1[0]; for (int r = 1; r < 16; ++r) pm1 = fmaxf(pm1, p1[r]);
  float pmax = fmaxf(pm0, pm1 + c32) + base;
  { auto rr = __builtin_amdgcn_permlane32_swap(__float_as_uint(pmax), __float_as_uint(pmax), false, false);
    pmax = fmaxf(__uint_as_float(rr[0]), __uint_as_float(rr[1])); }
  if (__builtin_expect(__all(pmax - m_reg <= THR), 1)) { mn = m_reg; alpha = 1.f; }
  else { mn = fmaxf(m_reg, pmax); alpha = __builtin_amdgcn_exp2f(m_reg - mn); m_reg = mn; }
  const float off0 = base - mn, off1 = off0 + c32;
  for (int r = 0; r < 16; ++r) p0[r] = __builtin_amdgcn_exp2f(p0[r] + off0);
  for (int r = 0; r < 16; ++r) p1[r] = p1[r] + off1;
}
__device__ __forceinline__ void finishSM(f32x16& p0, f32x16& p1, float alpha, float& l_reg, bf16x8& pa0, bf16x8& pa1, bf16x8& pa2, bf16x8& pa3) {
  for (int r = 0; r < 16; ++r) p1[r] = __builtin_amdgcn_exp2f(p1[r]);
  float ps = 0; for (int r = 0; r < 16; ++r) ps += p0[r]; for (int r = 0; r < 16; ++r) ps += p1[r];
  { auto rr = __builtin_amdgcn_permlane32_swap(__float_as_uint(ps), __float_as_uint(ps), false, false);
    ps = __uint_as_float(rr[0]) + __uint_as_float(rr[1]); }
  l_reg = l_reg * alpha + ps;
#define PK4(P, BASE, OUT) do { unsigned a0 = cvtpk(P[BASE + 0], P[BASE + 1]), a1 = cvtpk(P[BASE + 2], P[BASE + 3]);   \
    unsigned b0 = cvtpk(P[BASE + 4], P[BASE + 5]), b1 = cvtpk(P[BASE + 6], P[BASE + 7]);                              \
    auto r0 = __builtin_amdgcn_permlane32_swap(a0, b0, false, false); auto r1 = __builtin_amdgcn_permlane32_swap(a1, b1, false, false); \
    v4u w = {r0[0], r1[0], r0[1], r1[1]}; OUT = __builtin_bit_cast(bf16x8, w); } while (0)
  PK4(p0, 0, pa0); PK4(p0, 8, pa1); PK4(p1, 0, pa2); PK4(p1, 8, pa3);
#undef PK4
}
__device__ __forceinline__ void qkt(f32x16& p0, f32x16& p1, const char* Ks, const bf16x8* qr, const float* kc, int r32, int hi, int mapoff) {
  { const f32x4 k0 = *(const f32x4*)kc, k1 = *(const f32x4*)(kc + 4), k2 = *(const f32x4*)(kc + 8), k3 = *(const f32x4*)(kc + 12);
    p0 = (f32x16){k0[0], k0[1], k0[2], k0[3], k1[0], k1[1], k1[2], k1[3], k2[0], k2[1], k2[2], k2[3], k3[0], k3[1], k3[2], k3[3]}; p1 = p0; }
#pragma unroll
  for (int d0 = 0; d0 < 4; ++d0) { const int cb = (mapoff + d0 * 16 + hi * 8) * 2;
    const bf16x8 b0 = *reinterpret_cast<const bf16x8*>(Ks + KSWZ(r32, cb));
    const bf16x8 b1 = *reinterpret_cast<const bf16x8*>(Ks + KSWZ(32 + r32, cb));
    p0 = __builtin_amdgcn_mfma_f32_32x32x16_bf16(b0, qr[d0], p0, 0, 0, 0);
    p1 = __builtin_amdgcn_mfma_f32_32x32x16_bf16(b1, qr[d0], p1, 0, 0, 0); }
}
__device__ __forceinline__ int v_st(int k, int c) { const int kk = (k & ~0xC) | ((k & 4) << 1) | ((k & 8) >> 1); return ((kk >> 3) * 4 + (c >> 5)) * 512 + ((kk & 7) * 32 + (c & 31)) * 2; }
__device__ __forceinline__ int v_rd_base(int lane) { return ((lane & 3) << 3) | (((lane >> 2) & 3) << 6) | (((lane >> 4) & 1) << 5) | (((lane >> 5) & 1) << 8); }
constexpr int v_rd_off(int d0, int ks, int half) { return d0 * 512 + ks * 4096 + half * 2048; }
template <int OFF> __device__ __forceinline__ s16x4 tr_read(int vb) {
  s16x4 r; asm volatile("ds_read_b64_tr_b16 %0, %1 offset:%2" : "=&v"(r) : "v"(vb), "i"(OFF) : "memory"); return r;
}
template <int D0> __device__ __forceinline__ void pv_one(f32x16& od, int vb, bf16x8 pa0, bf16x8 pa1, bf16x8 pa2, bf16x8 pa3) {
  const s16x4 l0 = tr_read<v_rd_off(D0, 0, 0)>(vb), h0 = tr_read<v_rd_off(D0, 0, 1)>(vb), l1 = tr_read<v_rd_off(D0, 1, 0)>(vb), h1 = tr_read<v_rd_off(D0, 1, 1)>(vb);
  const s16x4 l2 = tr_read<v_rd_off(D0, 2, 0)>(vb), h2 = tr_read<v_rd_off(D0, 2, 1)>(vb), l3 = tr_read<v_rd_off(D0, 3, 0)>(vb), h3 = tr_read<v_rd_off(D0, 3, 1)>(vb);
  asm volatile("s_waitcnt lgkmcnt(0)" ::: "memory"); SBAR();
#define PK(L, H) (bf16x8){L[0], L[1], L[2], L[3], H[0], H[1], H[2], H[3]}
  od = __builtin_amdgcn_mfma_f32_32x32x16_bf16(pa0, PK(l0, h0), od, 0, 0, 0);
  od = __builtin_amdgcn_mfma_f32_32x32x16_bf16(pa1, PK(l1, h1), od, 0, 0, 0);
  od = __builtin_amdgcn_mfma_f32_32x32x16_bf16(pa2, PK(l2, h2), od, 0, 0, 0);
  od = __builtin_amdgcn_mfma_f32_32x32x16_bf16(pa3, PK(l3, h3), od, 0, 0, 0);
#undef PK
}
__device__ __forceinline__ void pv_d0(f32x16* o, int vb, bf16x8 pa0, bf16x8 pa1, bf16x8 pa2, bf16x8 pa3) {
  pv_one<0>(o[0], vb, pa0, pa1, pa2, pa3); pv_one<1>(o[1], vb, pa0, pa1, pa2, pa3); pv_one<2>(o[2], vb, pa0, pa1, pa2, pa3); pv_one<3>(o[3], vb, pa0, pa1, pa2, pa3);
}

struct SrcPrompt {
  const bf16* Kh; const bf16* Vh;
  __device__ __forceinline__ const bf16* kp(int t) const { return Kh + (size_t)t * 64 * 1024; }
  __device__ __forceinline__ const bf16* vp(int t) const { return Vh + (size_t)t * 64 * 1024; }
  __device__ __forceinline__ int nvalid(int) const { return 64; }
};
struct SrcSample {
  const float* Kc; const float* Vc; const float* Kn; const float* Vn;
  __device__ __forceinline__ const float* kp(int t) const { return t < 16 ? Kc + (size_t)t * 64 * 1024 : Kn; }
  __device__ __forceinline__ const float* vp(int t) const { return t < 16 ? Vc + (size_t)t * 64 * 1024 : Vn; }
  __device__ __forceinline__ int nvalid(int t) const { return t < 16 ? 64 : 16; }
};

template <typename TKV, int SD, int nvd, bool FIX, class Src>
__device__ __forceinline__ void attn_core(f32x16 (&o)[4], const bf16* qrow, float qposf, float c, int cq, int t0, int NT, const Src& src, char* lds, LAS unsigned char* lds3, int mapoff, float kmaxn) {
  using St = Stage<TKV>;
  int tid_ = threadIdx.x; asm volatile("" : "+v"(tid_));
  const int tid = tid_, wid = tid >> 6, lane = tid & 63, r32 = lane & 31, hi = lane >> 5;
  char* V_lds = lds + L_V; char* K_lds = lds + L_K;
  float* wsf = (float*)(lds + L_WS) + wid * 128; float* li_l = wsf; float* al_l = wsf + 32; float* kc = wsf + 64;
  float m_reg = -1e30f, l_reg = 0; bf16x8 qr[4];
#pragma unroll
  for (int d = 0; d < 4; ++d) o[d] = f32x16{};
#pragma unroll
  for (int d0 = 0; d0 < 4; ++d0) qr[d0] = *reinterpret_cast<const bf16x8*>(qrow + d0 * 16);
  if (lane < 16) kc[lane] = c * (float)((lane & 3) + 8 * (lane >> 2));
  asm volatile("s_waitcnt lgkmcnt(0)" ::: "memory");
  const float c32 = 32.f * c, c2 = 2.f * c;
  const float qrel = (float)(4 * hi) - qposf;
  const int sr = tid >> 4, sc = (tid & 15) * 8, vst0 = v_st(sr, sc), kst0 = KSWZ(sr, sc * 2);
  const int vb0 = (int)(uintptr_t)V_lds + v_rd_base(lane);
  struct { typename St::T vs0, vs1, ks0, ks1; } sr_[SD];
#define SLOAD(i, t) do { const int nv_ = src.nvalid(t); const int r0_ = sr < nv_ ? sr : nv_ - 1, r1_ = 32 + sr < nv_ ? 32 + sr : nv_ - 1; \
    const TKV* kp_ = src.kp(t); const TKV* vp_ = src.vp(t); \
    sr_[i].vs0 = St::ld8(vp_ + (size_t)r0_ * 1024 + sc); sr_[i].vs1 = St::ld8(vp_ + (size_t)r1_ * 1024 + sc); \
    sr_[i].ks0 = St::ld8(kp_ + (size_t)r0_ * 1024 + sc); sr_[i].ks1 = St::ld8(kp_ + (size_t)r1_ * 1024 + sc); } while (0)
#define SWRITE(b, i) do { *(bf16x8*)(V_lds + (b) * SHM_V + vst0) = St::tobf(sr_[i].vs0);          \
    *(bf16x8*)(V_lds + (b) * SHM_V + vst0 + 8192) = St::tobf(sr_[i].vs1);               \
    *(bf16x8*)(K_lds + (b) * SHM_K + kst0) = St::tobf(sr_[i].ks0);                       \
    *(bf16x8*)(K_lds + (b) * SHM_K + kst0 + 8192) = St::tobf(sr_[i].ks1); } while (0)
#define SWRITE3(off, i) do { *(bf16x8*)(V_lds + (off) + vst0) = St::tobf(sr_[i].vs0);          \
    *(bf16x8*)(V_lds + (off) + vst0 + 8192) = St::tobf(sr_[i].vs1);               \
    *(bf16x8*)(K_lds + (off) + kst0) = St::tobf(sr_[i].ks0);                       \
    *(bf16x8*)(K_lds + (off) + kst0 + 8192) = St::tobf(sr_[i].ks1); } while (0)
#define SWAIT() do { if constexpr (SD == 2) asm volatile("s_waitcnt vmcnt(4)" ::: "memory"); else asm volatile("s_waitcnt vmcnt(0)" ::: "memory"); } while (0)
#define RESC(a) do { if (__any((a) < 1.f)) { int tl_ = threadIdx.x; asm volatile("" : "+v"(tl_)); const int hi_ = (tl_ >> 5) & 1; if (hi_ == 0) al_l[tl_ & 31] = (a); asm volatile("s_waitcnt lgkmcnt(0)" ::: "memory"); \
    for (int d = 0; d < 4; ++d) for (int r = 0; r < 16; ++r) o[d][r] *= al_l[crow(r, hi_)]; } } while (0)
#define POST(P0, P1, t) do { if ((t) == cq) { const float d0_ = (float)(64 * (t)) + qrel; \
      for (int r = 0; r < 16; ++r) { const float d_ = d0_ + (float)((r & 3) + 8 * (r >> 2)); P0[r] -= c2 * fmaxf(d_, 0.f); P1[r] -= c2 * fmaxf(d_ + 32.f, 0.f); } \
      if (nvd < 64) { for (int r = 0; r < 16; ++r) { const int kk_ = crow(r, hi); if (kk_ >= nvd) P0[r] = -1e30f; if (kk_ + 32 >= nvd) P1[r] = -1e30f; } } } } while (0)
#define BASE(t) ((t) > cq ? -1e30f : c * ((float)(64 * (t)) + qrel))
  if constexpr (SD == 2) {
  f32x16 p0, p1; float mn, al; bf16x8 pa0, pa1, pa2, pa3;
  SLOAD(0, t0); SLOAD(1, t0 + 1); SWRITE(0, 0); __syncthreads();
#define STEP1(t, bsel, nset, cset, havenext, haveload) do { \
    if (haveload) SLOAD(cset, (t) + 2); \
    SBAR(); qkt(p0, p1, K_lds + (bsel) * SHM_K, qr, kc, r32, hi, mapoff); POST(p0, p1, t); \
    partialSM(p0, p1, m_reg, mn, al, BASE(t), c32); RESC(al); \
    finishSM(p0, p1, al, l_reg, pa0, pa1, pa2, pa3); SBAR(); \
    pv_d0(o, vb0 + (bsel) * SHM_V, pa0, pa1, pa2, pa3); \
    if (havenext) { SWRITE((bsel) ^ 1, nset); } \
    __syncthreads(); } while (0)
  for (int t = t0; t < NT; t += 2) {
    STEP1(t, 0, 1, 0, true, t + 2 < NT);
    STEP1(t + 1, 1, 0, 1, t + 2 < NT, t + 3 < NT);
  }
#undef STEP1
  } else {
  f32x16 pA0, pA1, pB0, pB1; float mnA, mnB, alA, alB; bf16x8 pa0, pa1, pa2, pa3;
  const int n_ = NT - t0;
  unsigned ksrc0, vsrc0;
  { const int L = tid * 16;
    { const int row = L >> 8, csw = (L >> 4) & 15; ksrc0 = (unsigned)(row * 1024 + ((csw ^ (row & 15)) * 8)) * 2u; }
    { const int st = L >> 9, within = (L & 511) >> 1, kk = (st >> 2) * 8 + (within >> 5), cc = (st & 3) * 32 + (within & 31), k = (kk & ~0xC) | ((kk & 4) << 1) | ((kk & 8) >> 1); vsrc0 = (unsigned)(k * 1024 + cc) * 2u; } }
  const unsigned dmaw = (unsigned)__builtin_amdgcn_readfirstlane(wid) * 1024u;
#define DMA3(off, t) do { const char* kp_ = (const char*)src.kp(t); const char* vp_ = (const char*)src.vp(t); _Pragma("unroll") for (int p_ = 0; p_ < 2; ++p_) { \
      __builtin_amdgcn_global_load_lds((const unsigned*)(kp_ + ksrc0 + p_ * 65536), (LAS unsigned*)(lds3 + L_K + (off) + p_ * 8192 + dmaw), 16, 0, 0); \
      __builtin_amdgcn_global_load_lds((const unsigned*)(vp_ + vsrc0 + p_ * 65536), (LAS unsigned*)(lds3 + L_V + (off) + p_ * 8192 + dmaw), 16, 0, 0); } } while (0)
  float mref = 0.f;
  if constexpr (FIX) {
    float q2 = 0.f;
#pragma unroll
    for (int d0 = 0; d0 < 4; ++d0) { const v4u w = __builtin_bit_cast(v4u, qr[d0]);
      q2 += bflo(w.x) * bflo(w.x) + bfhi(w.x) * bfhi(w.x) + bflo(w.y) * bflo(w.y) + bfhi(w.y) * bfhi(w.y) + bflo(w.z) * bflo(w.z) + bfhi(w.z) * bfhi(w.z) + bflo(w.w) * bflo(w.w) + bfhi(w.w) * bfhi(w.w); }
    { auto rr = __builtin_amdgcn_permlane32_swap(__float_as_uint(q2), __float_as_uint(q2), false, false); q2 = __uint_as_float(rr[0]) + __uint_as_float(rr[1]); }
    mref = 1.02f * sqrtf(q2) * kmaxn + 0.5f;
    alA = 1.f; alB = 1.f;
  }
#define PSM(C0, C1, mnC, alC, t_) do { if constexpr (FIX) { const float off0_ = BASE(t_) - mref, off1_ = off0_ + c32; \
      for (int r = 0; r < 16; ++r) C0[r] = __builtin_amdgcn_exp2f(C0[r] + off0_); for (int r = 0; r < 16; ++r) C1[r] = C1[r] + off1_; } \
    else { partialSM(C0, C1, m_reg, mnC, alC, BASE(t_), c32); } } while (0)
  DMA3(0, t0); DMA3(16384, t0 + 1); __syncthreads();
  qkt(pA0, pA1, K_lds, qr, kc, r32, hi, mapoff); POST(pA0, pA1, t0); PSM(pA0, pA1, mnA, alA, t0);
  int s_prev = 0, s_cur = 16384, s_next = 32768;
#define ROT3() do { s_prev = s_cur; s_cur = s_next; s_next = s_next == 32768 ? 0 : s_next + 16384; asm volatile("" : "+s"(s_prev), "+s"(s_cur), "+s"(s_next)); } while (0)
#define STEP3(C0, C1, mnC, alC, P0, P1, alP, i_) do { const int t_ = t0 + (i_); \
    if ((i_) + 1 < n_) { DMA3(s_next, t_ + 1); } \
    SBAR(); qkt(C0, C1, K_lds + s_cur, qr, kc, r32, hi, mapoff); POST(C0, C1, t_); \
    finishSM(P0, P1, alP, l_reg, pa0, pa1, pa2, pa3); SBAR(); \
    pv_d0(o, vb0 + s_prev, pa0, pa1, pa2, pa3); PSM(C0, C1, mnC, alC, t_); \
    if constexpr (!FIX) { RESC(alC); } __syncthreads(); ROT3(); } while (0)
  int i3 = 1;
  for (; i3 + 1 <= n_ - 2; i3 += 2) {
    STEP3(pB0, pB1, mnB, alB, pA0, pA1, alA, i3);
    STEP3(pA0, pA1, mnA, alA, pB0, pB1, alB, i3 + 1);
  }
  STEP3(pB0, pB1, mnB, alB, pA0, pA1, alA, i3);
  finishSM(pB0, pB1, alB, l_reg, pa0, pa1, pa2, pa3); SBAR();
  pv_d0(o, vb0 + s_prev, pa0, pa1, pa2, pa3);
#undef STEP3
#undef ROT3
#undef PSM
  }
  { int tl_ = threadIdx.x; asm volatile("" : "+v"(tl_)); const int hi_ = (tl_ >> 5) & 1;
  if (hi_ == 0) li_l[tl_ & 31] = l_reg; asm volatile("s_waitcnt lgkmcnt(0)" ::: "memory");
#pragma unroll
  for (int r = 0; r < 16; ++r) { const float rl = __builtin_amdgcn_rcpf(li_l[crow(r, hi_)]);
#pragma unroll
    for (int d = 0; d < 4; ++d) o[d][r] *= rl; } }
#undef SLOAD
#undef SWRITE
#undef SWRITE3
#undef SWAIT
#undef RESC
#undef POST
#undef BASE
}

__device__ __forceinline__ void attn_finish(f32x16 (&o)[4], float lam, const float* gsub, bf16* A2h, int rowbase, int nrows, bool store, char* lds) {
  int tid_ = threadIdx.x; asm volatile("" : "+v"(tid_));
  const int tid = tid_, wid = tid >> 6, lane = tid & 63, r32 = lane & 31, hi = lane >> 5;
  float* ex = (float*)(lds + L_EX) + (wid & 3) * 4096 + lane;
  __syncthreads();
  if (wid >= 4) {
#pragma unroll
    for (int d = 0; d < 4; ++d)
#pragma unroll
      for (int r = 0; r < 16; ++r) ex[(d * 16 + r) * 64] = lam * o[d][r];
  }
  __syncthreads();
  if (wid < 4) {
    float g[4];
#pragma unroll
    for (int d = 0; d < 4; ++d) g[d] = gsub[32 * d + r32] * (1.0f - LAM_INIT);
#pragma unroll
    for (int r = 0; r < 16; ++r) {
      float ss = 0.f;
#pragma unroll
      for (int d = 0; d < 4; ++d) { const float a = o[d][r] - ex[(d * 16 + r) * 64]; o[d][r] = a; ss += a * a; }
      ss += __shfl_xor(ss, 1); ss += __shfl_xor(ss, 2); ss += __shfl_xor(ss, 4); ss += __shfl_xor(ss, 8); ss += __shfl_xor(ss, 16);
      const float rstd = 1.0f / sqrtf(ss * (1.0f / 128.f) + EPS);
#pragma unroll
      for (int d = 0; d < 4; ++d) o[d][r] *= rstd * g[d];
    }
    unsigned short* stg = (unsigned short*)(lds + L_EX) + (wid & 3) * 8192;
#pragma unroll
    for (int r = 0; r < 16; ++r) {
      const int row = crow(r, hi);
#pragma unroll
      for (int d = 0; d < 4; ++d) stg[row * 136 + 32 * d + r32] = (unsigned short)f2bf(o[d][r]);
    }
    asm volatile("s_waitcnt lgkmcnt(0)" ::: "memory");
    if (store) {
#pragma unroll
      for (int i = 0; i < 8; ++i) {
        const int id = lane + 64 * i, row = id >> 4, c16 = id & 15;
        if (row < nrows) *(v4u*)(A2h + (size_t)(rowbase + row) * 2048 + c16 * 8) = *(const v4u*)(stg + row * 136 + c16 * 8);
      }
    }
  }
  __syncthreads();
}
#undef SBAR
}

constexpr int N_PHASES = 8;
constexpr int NSL5 = 8, NSL9 = 11;
constexpr int N_LAUNCHES = MK_N_LAUNCHES;

__global__ void __launch_bounds__(NWAVES * 64, 2) hymba_fwd(Args args) {
    extern __shared__ __attribute__((aligned(16))) unsigned char lds_raw[];
    LAS unsigned char* lds = (LAS unsigned char*)lds_raw;
    volatile LAS unsigned* MISC = (volatile LAS unsigned*)(lds + LDSCTL_OFF);
    const int tid = threadIdx.x, lane = tid & 63, wave = __builtin_amdgcn_readfirstlane(tid >> 6);
    const int G = gridDim.x; const int bx = blockIdx.x;
    const int vcu = (G % 8 == 0) ? (bx % 8) * (G / 8) + bx / 8 : bx;
    unsigned char* ws = args.ws;
    gu32* ctl = (gu32*)(ws + WS_CTL);
    for (int u = tid; u < (LDS_BYTES - LDSCTL_OFF) / 4; u += NWAVES * 64) ((LAS unsigned*)(lds + LDSCTL_OFF))[u] = 0u;
    __syncthreads();
    XcdBarrier bar; bar.bar = (unsigned*)(ctl + CW_BAR); bar.x = 0; bar.st = nullptr;
    if (N_LAUNCHES == 1) bar = xcd_barrier_post((unsigned*)(ctl + CW_BAR), MISC + 8);
    const int lo = args.ph_lo, hi_ph = args.ph_hi;
#ifndef PHASE_MASK
#define PHASE_MASK 0xff
#endif
#define IN(k) (((PHASE_MASK >> (k)) & 1) && lo <= (k) && (k) < hi_ph)
#ifdef PROBE_PHASE
    unsigned long long pr_a = 0, pr_b = 0;
#define PSTART(k) do { if ((k) == PROBE_PHASE) pr_a = __builtin_amdgcn_s_memrealtime(); } while (0)
#define PEND(k) do { if ((k) == PROBE_PHASE) pr_b = __builtin_amdgcn_s_memrealtime(); } while (0)
#else
#define PSTART(k) do {} while (0)
#define PEND(k) do {} while (0)
#endif
#define SEAM(k) do { if (IN(k) && IN((k) + 1)) xcd_barrier(bar); PEND(k); PSTART((k) + 1); } while (0)

    bf16* WIN = (bf16*)(ws + WS_WIN); bf16* WOUT = (bf16*)(ws + WS_WOUT); bf16* WGU = (bf16*)(ws + WS_WGU); bf16* WDN = (bf16*)(ws + WS_WDN);
    bf16* XN = (bf16*)(ws + WS_XN);

    PSTART(0);
    if (IN(0)) {
        {
            LAS float* scr = (LAS float*)(lds + wave * 16896);
            const int gw = vcu * NWAVES + wave, NGW = G * NWAVES;
            constexpr int NITEM = 32 * 88;
            f32x4 v[16];
            int itn = gw;
            P0Item cur{};
            if (itn < NITEM) { cur = p0_item(args, ws, itn); p0_load(cur, v, lane); }
            while (itn < NITEM) {
                p0_to_lds(cur, v, scr, lane);
                const P0Item done = cur;
                itn += NGW;
                if (itn < NITEM) { cur = p0_item(args, ws, itn); p0_load(cur, v, lane); }
                p0_store(done, scr, lane);
            }
        }
        __syncthreads();
        {
            LAS float* wT = (LAS float*)lds;
            for (int k = tid; k < DM; k += NWAVES * 64) {
                const float* src = args.in[I_WIN] + (size_t)k * DIN + NPROJ;
#pragma unroll
                for (int q = 0; q < 4; ++q) { const f32x4 v = *(const f32x4*)(src + 4 * q); wT[(4 * q + 0) * DM + k] = v[0]; wT[(4 * q + 1) * DM + k] = v[1]; wT[(4 * q + 2) * DM + k] = v[2]; wT[(4 * q + 3) * DM + k] = v[3]; }
            }
            __syncthreads();
            const int gw = vcu * NWAVES + wave, NGW = G * NWAVES;
            const float* gmix = args.in[I_GMIX];
            float* DT = (float*)(ws + WS_DT);
            f32x4 gm[8];
#pragma unroll
            for (int j = 0; j < 8; ++j) gm[j] = *(const f32x4*)(gmix + 4 * lane + 256 * j);
            f32x4 nx[8];
            { const int m = gw; if (m < MT) { const float* xrow = m < MP ? args.in[I_XP] + (size_t)m * DM : args.in[I_XS] + (size_t)(m - MP) * DM;
#pragma unroll
                for (int j = 0; j < 8; ++j) nx[j] = *(const f32x4*)(xrow + 4 * lane + 256 * j); } }
            for (int m = gw; m < MT; m += NGW) {
                f32x4 v[8]; float s = 0.f;
#pragma unroll
                for (int j = 0; j < 8; ++j) { v[j] = nx[j]; s += (v[j][0] * v[j][0] + v[j][1] * v[j][1]) + (v[j][2] * v[j][2] + v[j][3] * v[j][3]); }
                { const int m2 = m + NGW; if (m2 < MT) { const float* xrow = m2 < MP ? args.in[I_XP] + (size_t)m2 * DM : args.in[I_XS] + (size_t)(m2 - MP) * DM;
#pragma unroll
                    for (int j = 0; j < 8; ++j) nx[j] = *(const f32x4*)(xrow + 4 * lane + 256 * j); } }
                const float rstd = 1.0f / sqrtf(wave_sum(s) * (1.0f / DM) + EPS);
#pragma unroll
                for (int j = 0; j < 8; ++j) { v[j] = v[j] * rstd * gm[j];
                    v2u w; w.x = pk2(v[j][0], v[j][1]); w.y = pk2(v[j][2], v[j][3]); *(v2u*)(XN + (size_t)m * DM + 4 * lane + 256 * j) = w; }
                float a[16];
#pragma unroll
                for (int jj = 0; jj < 16; ++jj) {
                    float t = 0.f;
#pragma unroll
                    for (int j = 0; j < 8; ++j) { const f32x4 w = *(const LAS f32x4*)(wT + jj * DM + 4 * lane + 256 * j); t += (v[j][0] * w[0] + v[j][1] * w[1]) + (v[j][2] * w[2] + v[j][3] * w[3]); }
                    a[jj] = t;
                    if ((jj & 1) == 1) __builtin_amdgcn_sched_barrier(0);
                }
                float b8[8], c4[4], d2[2], e1;
                { const bool up = lane & 32;
#pragma unroll
                  for (int q = 0; q < 8; ++q) { const float snd = up ? a[q] : a[q + 8], kp = up ? a[q + 8] : a[q]; b8[q] = kp + __shfl_xor(snd, 32); } }
                { const bool up = lane & 16;
#pragma unroll
                  for (int q = 0; q < 4; ++q) { const float snd = up ? b8[q] : b8[q + 4], kp = up ? b8[q + 4] : b8[q]; c4[q] = kp + __shfl_xor(snd, 16); } }
                { const bool up = lane & 8;
#pragma unroll
                  for (int q = 0; q < 2; ++q) { const float snd = up ? c4[q] : c4[q + 2], kp = up ? c4[q + 2] : c4[q]; d2[q] = kp + __shfl_xor(snd, 8); } }
                { const bool up = lane & 4; const float snd = up ? d2[0] : d2[1], kp = up ? d2[1] : d2[0]; e1 = kp + __shfl_xor(snd, 4); }
                e1 += __shfl_xor(e1, 2); e1 += __shfl_xor(e1, 1);
                if ((lane & 3) == 0) { const int jj = ((lane >> 5) & 1) * 8 + ((lane >> 4) & 1) * 4 + ((lane >> 3) & 1) * 2 + ((lane >> 2) & 1);
                    const float xx = e1 + args.in[I_DTB][jj]; DT[(size_t)m * 16 + jj] = fmaxf(xx, 0.f) + log1pf(__expf(-fabsf(xx))); }
            }
        }
        __syncthreads();
    }
    SEAM(0);

    if (IN(1)) {
        pg8::Gemm g{XN, WIN, MT, NPROJ, DM}; pg8::StaticOrder S; S.init(MT, NPROJ, DM, G, bx);
        EpiInProj E{(bf16*)(ws + WS_Q), (bf16*)(ws + WS_K), (bf16*)(ws + WS_V), (bf16*)(ws + WS_Z), (bf16*)(ws + WS_XBC), args.out, (unsigned*)(ctl + CW_QK)};
        pg8::gemm_phase<EpiInProj, pg8::StaticOrder, false, true>(lds, g, S, E);
    }
    SEAM(1);

    if (IN(2)) {
        const bf16* Qb = (const bf16*)(ws + WS_Q); const bf16* Kb = (const bf16*)(ws + WS_K); const bf16* Vb = (const bf16*)(ws + WS_V);
        bf16* A2 = (bf16*)(ws + WS_A2);
        volatile LAS int* qslot = (volatile LAS int*)(lds + LDSCTL_OFF + 64);
        volatile LAS float* blkc = (volatile LAS float*)(lds + LDSCTL_OFF + 128);
        if (wave == 0) {
            const int l6 = tid & 63;
            const float a = args.in[I_LQ1][l6] * args.in[I_LK1][l6], b = args.in[I_LQ2][l6] * args.in[I_LK2][l6];
            const float lamv = __expf(wave_sum(a)) - __expf(wave_sum(b)) + LAM_INIT;
            if (l6 == 0) blkc[0] = lamv;
            if (l6 < 8) {
                float qkb = 0.f;
#pragma unroll
                for (int m = 0; m < 2; ++m) { const unsigned* w = (const unsigned*)(ctl + CW_QK) + 2 * (2 * l6 + m);
                    const float q2 = __uint_as_float(__hip_atomic_load(w, __ATOMIC_RELAXED, __HIP_MEMORY_SCOPE_AGENT)) + __uint_as_float(__hip_atomic_load(w + 1, __ATOMIC_RELAXED, __HIP_MEMORY_SCOPE_AGENT));
                    const float k2 = __uint_as_float(__hip_atomic_load(w + 32, __ATOMIC_RELAXED, __HIP_MEMORY_SCOPE_AGENT)) + __uint_as_float(__hip_atomic_load(w + 33, __ATOMIC_RELAXED, __HIP_MEMORY_SCOPE_AGENT));
                    qkb = fmaxf(qkb, sqrtf(q2 * k2)); blkc[16 + 2 * l6 + m] = sqrtf(k2); }
                blkc[8 + l6] = (2.f * 1.02f * qkb + att::THR + 180.f) / (exp2f(-(float)(l6 + 1)) * LOG2E);
                blkc[32 + l6] = (2.f * 1.02f * qkb + 1.f <= 90.f) ? 1.f : 0.f;
            }
        }
        __syncthreads();
        constexpr int NA1 = 256, NA2 = 128, NA3 = 128;
        constexpr int Q_A0 = 256, Q_LOC = Q_A0 + 320, Q_ATT1 = Q_LOC + NA1, Q_SCAN = Q_ATT1 + 64, Q_ATT2 = Q_SCAN + NA2, Q_OUT = Q_ATT2 + 320, Q_CONV = Q_OUT + (512 - NA1 - NA2), Q_END = Q_CONV + 592;
#define ITEM_DONE(word) do { asm volatile("s_waitcnt vmcnt(0)" ::: "memory"); __syncthreads(); \
            if (tid == 0) { __builtin_amdgcn_fence(__ATOMIC_RELEASE, "agent"); asm volatile("s_waitcnt vmcnt(0)" ::: "memory"); (void)atomicAdd((unsigned*)(ctl + (word)), 1u); } } while (0)
#define ITEM_WAIT(word, need) do { if (tid == 0) { unsigned sp_ = 0; while (__hip_atomic_load((unsigned*)(ctl + (word)), __ATOMIC_RELAXED, __HIP_MEMORY_SCOPE_AGENT) < (unsigned)(need)) { __builtin_amdgcn_s_sleep(8); if (++sp_ > (1u << 22)) break; } \
            __builtin_amdgcn_fence(__ATOMIC_ACQUIRE, "agent"); asm volatile("s_waitcnt vmcnt(0)" ::: "memory"); } __syncthreads(); } while (0)
        for (;;) {
            __syncthreads();
            if (tid == 0) *qslot = (int)atomicAdd((unsigned*)(ctl + CW_QUEUE), 1u);
            __syncthreads();
            const int p = *qslot;
            if (p >= Q_END) break;
            if (p >= Q_CONV) {
                int tw_ = threadIdx.x; asm volatile("" : "+v"(tw_));
                const int wv2 = __builtin_amdgcn_readfirstlane(tw_ >> 6), ln2 = tw_ & 63;
                LAS float* scr = (LAS float*)(lds + wv2 * 16896);
                const int it0 = 32 * 88 + (p - Q_CONV) * 16 + wv2 * 2;
                f32x4 v[16];
                const P0Item a = p0_item(args, ws, it0); p0_load(a, v, ln2); p0_to_lds(a, v, scr, ln2);
                const P0Item b = p0_item(args, ws, it0 + 1); p0_load(b, v, ln2);
                p0_store(a, scr, ln2); p0_to_lds(b, v, scr, ln2); p0_store(b, scr, ln2);
                continue;
            }
            if (p >= Q_A0 && p < Q_LOC) { ssd_local(args, lds, p - Q_A0); ITEM_DONE(CW_LDONE); continue; }
            if (p >= Q_ATT1 && p < Q_SCAN) { ITEM_WAIT(CW_LDONE, 320); { int te_ = tid; asm volatile("" : "+v"(te_)); ssd_scan(args, p - Q_ATT1, te_); } ITEM_DONE(CW_SDONE); continue; }
            if (p >= Q_ATT2 && p < Q_OUT) { ITEM_WAIT(CW_SDONE, 64); ssd_out(args, lds, p - Q_ATT2); continue; }
            const int ap = p < Q_A0 ? p : (p < Q_ATT1 ? p - Q_LOC + 256 : (p < Q_ATT2 ? p - Q_SCAN + 256 + NA1 : p - Q_OUT + 256 + NA1 + NA2));
            const int grp = ap / 3, rr = ap - 3 * grp;
            int tl_ = threadIdx.x; asm volatile("" : "+v"(tl_));
            const int r32 = tl_ & 31, hi = (tl_ >> 5) & 1, wv_ = __builtin_amdgcn_readfirstlane(tl_ >> 6), map = wv_ >> 2, w4 = wv_ & 3;
            const float lam = blkc[0];
            f32x16 o[4];
            if (rr == 1) {
                const int b = grp & 31, h = grp >> 5;
                const float cs = exp2f(-(float)(h + 1)) * LOG2E;
                const int qi = r32 < 16 ? r32 : 15;
                const bf16* qrow = Qb + (size_t)(MP + 16 * b + qi) * 1024 + h * 128 + map * 64 + hi * 8;
                att::SrcSample src{args.in[I_CK] + ((size_t)b * 1024 * 8 + h) * 128, args.in[I_CV] + ((size_t)b * 1024 * 8 + h) * 128,
                                   args.out + O_KS + (size_t)(16 * b) * 1024 + h * 128, args.out + O_VS + (size_t)(16 * b) * 1024 + h * 128};
                att::attn_core<float, 2, 16, false, att::SrcSample>(o, qrow, (float)(1024 + qi), cs, 16, 0, 18, src, (char*)lds_raw, lds, map * 64, 0.f);
                att::attn_finish(o, lam, args.in[I_GSUB], A2 + h * 128, MP + 16 * b, 16, w4 == 0, (char*)lds_raw);
            } else {
                const int q = 2 * grp + (rr == 2 ? 1 : 0), j = 63 - (q >> 3), h = 7 - (q & 7);
                const float cs = exp2f(-(float)(h + 1)) * LOG2E;
                const float wv = blkc[8 + h];
                int t0 = (int)ceilf(((float)(128 * j - 63) - wv) * (1.0f / 64.f)); t0 = t0 < 0 ? 0 : (t0 & ~1);
                const int row = 128 * j + 32 * w4 + r32;
                const bf16* qrow = Qb + (size_t)row * 1024 + h * 128 + map * 64 + hi * 8;
                att::SrcPrompt src{Kb + h * 128, Vb + h * 128};
                const float kmx = blkc[16 + 2 * h + map];
                if (blkc[32 + h] != 0.f) att::attn_core<bf16, 1, 64, true, att::SrcPrompt>(o, qrow, (float)row, cs, 2 * j + (w4 >> 1), t0, 2 * j + 2, src, (char*)lds_raw, lds, map * 64, kmx);
                else att::attn_core<bf16, 1, 64, false, att::SrcPrompt>(o, qrow, (float)row, cs, 2 * j + (w4 >> 1), t0, 2 * j + 2, src, (char*)lds_raw, lds, map * 64, kmx);
                att::attn_finish(o, lam, args.in[I_GSUB], A2 + h * 128, 128 * j + 32 * w4, 32, true, (char*)lds_raw);
            }
        }
#undef ITEM_DONE
#undef ITEM_WAIT
    }
    SEAM(2);

    if (IN(3)) {
        pg8::Gemm g{(const bf16*)(ws + WS_A2), WOUT, MT, DM, DM}; pg8::SplitOrder S; S.init(MP, MT, DM, DM, G, bx, NSL5);
        EpiOutProj E{args.in[I_XP], args.in[I_XS], args.out + O_Y, XN, (float*)(ws + WS_RS1), (float*)(ws + WS_SLAB5)};
        pg8::gemm_phase<EpiOutProj, pg8::SplitOrder, true, true>(lds, g, S, E);
    }
    SEAM(3);

    if (IN(4)) {
        int tq_ = threadIdx.x; asm volatile("" : "+v"(tq_)); const int lane = tq_ & 63;
        const int gw = vcu * NWAVES + wave, NGW = G * NWAVES;
        const float* slabs = (const float*)(ws + WS_SLAB5); const float* rs = (const float*)(ws + WS_RS1); float* rstd1 = (float*)(ws + WS_RSTD1);
        for (int rr = (gw & 3) == 0 ? (gw >> 2) : MS; rr < MS; rr += NGW / 4) {
            const int row = MP + rr, pms = rr >> 8, rl = rr & 255;
            const float* xr = args.in[I_XS] + (size_t)rr * DM; float ss = 0.f;
            f32x4 vv[8];
#pragma unroll
            for (int jh = 0; jh < 8; jh += 4) {
                f32x4 ld[4][NSL5 + 1];
#pragma unroll
                for (int jj = 0; jj < 4; ++jj) { const int j = jh + jj; ld[jj][NSL5] = *(const f32x4*)(xr + 4 * lane + 256 * j);
                    const float* sp = slabs + ((size_t)(pms * 8 + j) * NSL5) * 65536 + (size_t)rl * 256 + 4 * lane;
#pragma unroll
                    for (int q = 0; q < NSL5; ++q) ld[jj][q] = *(const f32x4*)(sp + (size_t)q * 65536); }
                asm volatile("" ::: "memory");
#pragma unroll
                for (int jj = 0; jj < 4; ++jj) { f32x4 a = ld[jj][NSL5];
#pragma unroll
                    for (int q = 0; q < NSL5; ++q) a = a + ld[jj][q];
                    vv[jh + jj] = a; }
            }
#pragma unroll
            for (int j = 0; j < 8; ++j) {
                const f32x4 v = vv[j];
                *(f32x4*)(args.out + O_Y + (size_t)row * DM + 4 * lane + 256 * j) = v;
                v2u w; w.x = pk2(v[0], v[1]); w.y = pk2(v[2], v[3]); *(v2u*)(XN + (size_t)row * DM + 4 * lane + 256 * j) = w;
                ss += (v[0] * v[0] + v[1] * v[1]) + (v[2] * v[2] + v[3] * v[3]);
            }
            ss = wave_sum(ss);
            if (lane == 0) rstd1[row] = 1.0f / sqrtf(ss * (1.0f / DM) + EPS);
        }
        for (int row = bx * (NWAVES * 64) + tid; row < MP; row += G * NWAVES * 64) {
            const float* p = rs + (size_t)row * 32; float t = 0.f;
#pragma unroll
            for (int q = 0; q < 8; ++q) { const f32x4 a = *(const f32x4*)(p + 4 * q); t += (a[0] + a[1]) + (a[2] + a[3]); }
            rstd1[row] = 1.0f / sqrtf(t * (1.0f / DM) + EPS);
        }
    }
    SEAM(4);

    if (IN(5)) {
        pg8::Gemm g{XN, WGU, MT, 2 * DFF, DM}; pg8::StaticOrder S; S.init(MT, 2 * DFF, DM, G, bx);
        EpiGateUp E{(bf16*)(ws + WS_HID), (const float*)(ws + WS_RSTD1), args.out, args.in[I_FCW], args.in[I_FCB], args.in[I_SFFN], (float*)(ws + WS_FRG), (float*)(ws + WS_FRU), (float*)(ws + WS_LRG), lds};
        pg8::gemm_phase<EpiGateUp, pg8::StaticOrder, true, true>(lds, g, S, E);
    }
    SEAM(5);

    if (IN(6)) {
        pg8::Gemm g{(const bf16*)(ws + WS_HID), WDN, MT, DM, DFF}; pg8::SplitOrder S; S.init(MP, MT, DM, DFF, G, bx, NSL9);
        {
            pg8::Unit u0;
            if (S.next(0, u0) && u0.slab < 0 && u0.pm > 0) {
                const float* frg = (const float*)(ws + WS_FRG) + (size_t)u0.pm * 2 * DFF; const float* fru = (const float*)(ws + WS_FRU) + (size_t)u0.pm * 2 * DFF;
                const float* lrg = (const float*)(ws + WS_LRG) + (size_t)(u0.pm - 1) * 2 * DFF; bf16* HID = (bf16*)(ws + WS_HID);
                const float* fw = args.in[I_FCW]; const float* fb = args.in[I_FCB];
                for (int task = tid; task < 2 * (DFF / 8); task += NWAVES * 64) {
                    const int r = task / (DFF / 8), col = 8 * (task % (DFF / 8));
                    const float* p2 = r == 0 ? lrg + col : lrg + DFF + col; const float* p1 = r == 0 ? lrg + DFF + col : frg + col; const float* p0 = frg + (size_t)r * DFF + col; const float* pu = fru + (size_t)r * DFF + col;
                    float o[8];
#pragma unroll
                    for (int e = 0; e < 8; ++e) { const float y = fb[col + e] + fw[col + e] * p2[e] + fw[DFF + col + e] * p1[e] + fw[2 * DFF + col + e] * p0[e]; o[e] = siluf(y) * pu[e]; }
                    v4u w; w.x = pk2(o[0], o[1]); w.y = pk2(o[2], o[3]); w.z = pk2(o[4], o[5]); w.w = pk2(o[6], o[7]);
                    *(v4u*)(HID + (size_t)(256 * u0.pm + r) * DFF + col) = w;
                }
                asm volatile("s_waitcnt vmcnt(0)" ::: "memory");
            }
            __syncthreads();
        }
        EpiDown E{args.out + O_Y, (float*)(ws + WS_RS2), (float*)(ws + WS_SLAB9), XN  };
        pg8::gemm_phase<EpiDown, pg8::SplitOrder, true, true>(lds, g, S, E);
    }
    SEAM(6);

    if (IN(7)) {
        int tq_ = threadIdx.x; asm volatile("" : "+v"(tq_)); const int lane = tq_ & 63;
        const int gw = vcu * NWAVES + wave, NGW = G * NWAVES;
        const float* rs = (const float*)(ws + WS_RS2); const float* gf = args.in[I_GFIN]; const float* slabs = (const float*)(ws + WS_SLAB9);
        f32x4 gfv[8];
#pragma unroll
        for (int j = 0; j < 8; ++j) gfv[j] = *(const f32x4*)(gf + 4 * lane + 256 * j);
        const int nprompt = (MP - gw + NGW - 1) / NGW, nsample = (gw & 3) == 0 ? (MS - (gw >> 2) + NGW / 4 - 1) / (NGW / 4) : 0;
        for (int st = 0; st < nprompt + nsample; ++st) {
            const int m = st < nprompt ? gw + st * NGW : MP + (gw >> 2) + (st - nprompt) * (NGW / 4);
            float* row = args.out + O_Y + (size_t)m * DM;
            f32x4 v[8]; float t;
            if (m < MP) {
                t = lane < 32 ? rs[(size_t)m * 32 + lane] : 0.f;
#pragma unroll
                for (int j = 0; j < 8; ++j) { const v2u w = *(const v2u*)(XN + (size_t)m * DM + 4 * lane + 256 * j); v[j] = (f32x4){bflo(w.x), bfhi(w.x), bflo(w.y), bfhi(w.y)}; }
            } else {
                const int rr = m - MP, pms = rr >> 8, rl = rr & 255; t = 0.f;
#pragma unroll
                for (int jh = 0; jh < 8; jh += 2) {
                    f32x4 ld[2][NSL9 + 1];
#pragma unroll
                    for (int jj = 0; jj < 2; ++jj) { const int j = jh + jj; ld[jj][NSL9] = *(const f32x4*)(row + 4 * lane + 256 * j);
                        const float* sp = slabs + ((size_t)(pms * 8 + j) * NSL9) * 65536 + (size_t)rl * 256 + 4 * lane;
#pragma unroll
                        for (int q = 0; q < NSL9; ++q) ld[jj][q] = *(const f32x4*)(sp + (size_t)q * 65536); }
                    asm volatile("" ::: "memory");
#pragma unroll
                    for (int jj = 0; jj < 2; ++jj) { f32x4 a = ld[jj][NSL9];
#pragma unroll
                        for (int q = 0; q < NSL9; ++q) a = a + ld[jj][q];
                        v[jh + jj] = a; t += (a[0] * a[0] + a[1] * a[1]) + (a[2] * a[2] + a[3] * a[3]); }
                }
            }
            t = wave_sum(t);
            const float rstd = 1.0f / sqrtf(t * (1.0f / DM) + EPS);
#pragma unroll
            for (int j = 0; j < 8; ++j) *(f32x4*)(row + 4 * lane + 256 * j) = v[j] * rstd * gfv[j];
        }
    }
    PEND(N_PHASES - 1);
#ifdef PROBE_PHASE
    if (blockIdx.x == 0 && tid == 0) { const unsigned long long d = (pr_b - pr_a) * PROBE_SCALE, t0 = __builtin_amdgcn_s_memrealtime(); while (__builtin_amdgcn_s_memrealtime() - t0 < d) __builtin_amdgcn_s_sleep(16); }
#endif
#undef IN
#undef SEAM
}

extern "C" void kernel_launch(void* const* d_in, const int* in_sizes, int n_in, void* d_out, int out_size, void* d_ws, size_t ws_size, hipStream_t stream) {
    static int grid = 0;
    if (grid == 0) {
        if (n_in != 28 || out_size != (int)O_END || ws_size < WS_END) { fprintf(stderr, "kernel_launch: unexpected shapes: n_in %d out %d ws %zu (need %zu)\n", n_in, out_size, ws_size, (size_t)WS_END); grid = -1; return; }
        int dev = 0, cus = 0;
        if (hipGetDevice(&dev) != hipSuccess || hipDeviceGetAttribute(&cus, hipDeviceAttributeMultiprocessorCount, dev) != hipSuccess) { grid = -1; return; }
        if (hipFuncSetAttribute((const void*)hymba_fwd, hipFuncAttributeMaxDynamicSharedMemorySize, LDS_BYTES) != hipSuccess) { fprintf(stderr, "kernel_launch: hipFuncSetAttribute failed\n"); grid = -1; return; }
        (void)hipGetLastError();
        grid = cus;
    }
    if (grid < 0) return;
    (void)hipMemsetAsync((char*)d_ws + WS_CTL, 0, CTL_ZERO_BYTES, stream);
    Args a{};
    for (int i = 0; i < 28; ++i) a.in[i] = (const float*)d_in[i];
    a.out = (float*)d_out; a.ws = (unsigned char*)d_ws;
    if (N_LAUNCHES == 1) {
        a.ph_lo = 0; a.ph_hi = N_PHASES; a.li = 0;
        hipLaunchKernelGGL(hymba_fwd, dim3(grid), dim3(NWAVES * 64), LDS_BYTES, stream, a);
    } else {
        for (int li = 0; li < N_PHASES; ++li) { a.ph_lo = li; a.ph_hi = li + 1; a.li = li; hipLaunchKernelGGL(hymba_fwd, dim3(grid), dim3(NWAVES * 64), LDS_BYTES, stream, a); }
    }
    const hipError_t le = hipPeekAtLastError();
    if (le != hipSuccess) fprintf(stderr, "kernel_launch: launch failed: %s\n", hipGetErrorName(le));
}
```

```cpp
#include <hip/hip_runtime.h>
#include <hip/hip_bf16.h>
#include <cstdio>
#include <cstdint>

#ifndef MK_N_LAUNCHES
#define MK_N_LAUNCHES 1
#endif

namespace pg8 {
#define PG8_LAS __attribute__((address_space(3)))
typedef unsigned short bf16_t;
typedef short bf16x8 __attribute__((ext_vector_type(8)));
typedef float f32x4 __attribute__((ext_vector_type(4)));
typedef unsigned u32x4 __attribute__((ext_vector_type(4)));
constexpr int BM = 256, BK = 64, HALF = 128, HTB = HALF * BK * 2, STAGE_BYTES = 8 * HTB, NXCD = 8, WGM = 8;

__host__ __device__ __forceinline__ int lds_byte(int r, int c) { const int st = (r >> 4) * 2 + (c >> 5), rr = r & 15, cc = c & 31, ob = rr * 64 + cc * 2; return st * 1024 + (ob ^ (((ob >> 9) & 1) << 5)); }
__host__ __device__ __forceinline__ void stage_rc(int b, int& R, int& C) { const int st = b / 1024, sb = b % 1024, swz = sb ^ (((sb >> 9) & 1) << 5); R = (st >> 1) * 16 + swz / 64; C = (st & 1) * 32 + (swz % 64) / 2; }
__host__ __device__ __forceinline__ int perm32(int rho) { const int n = rho >> 4, i = rho & 15; return 8 * (i >> 2) + 4 * n + (i & 3); }

struct Unit { int pm, pn, k0, nk, slab; };
struct Gemm { const bf16_t* A; const bf16_t* Bt; int M, N, K; };

struct StaticOrder {
    int nM, nN, nwg, G, c, nkt;
    __host__ __device__ void init(int M, int N, int K, int G_, int c_) { nM = M / BM; nN = N / BM; nwg = nM * nN; G = G_; c = c_; nkt = K / BK; }
    __host__ __device__ __forceinline__ bool next(int i, Unit& u) const { return at((long)i * G + c, u); }
    __host__ __device__ __forceinline__ bool at(long L, Unit& u) const {
        if (L >= nwg) return false; u.k0 = 0; u.nk = nkt; u.slab = -1;
        int wgid = (int)L; { const int q = nwg / NXCD, r = nwg % NXCD, xcd = wgid % NXCD, off = wgid / NXCD; wgid = (xcd < r ? xcd * (q + 1) : r * (q + 1) + (xcd - r) * q) + off; }
        const int nig = WGM * nN, gid = wgid / nig, fm = gid * WGM, gsz = (nM - fm) < WGM ? (nM - fm) : WGM;
        u.pm = fm + ((wgid % nig) % gsz); u.pn = (wgid % nig) / gsz; return true;
    }
    __device__ __forceinline__ void a_ready(const Unit&) const {}
    __device__ __forceinline__ void done(const Unit&) const {}
};

struct SplitOrder {
    StaticOrder P; int nN, nsl, nks, ntail;
    __host__ __device__ void init(int MPR, int M, int N, int K, int G_, int c_, int nsl_) { P.init(MPR, N, K, G_, c_); nN = N / BM; nsl = nsl_; nks = (K / BK) / nsl_; ntail = ((M - MPR) / BM) * nN; }
    __host__ __device__ __forceinline__ bool next(int i, Unit& u) const {
        const long L = (long)i * P.G + P.c;
        const int sidx = (int)(L - P.nwg);
        if (sidx >= ntail * nsl) return false;
        int pm, pn, k0, nk, slab;
        if (sidx < 0) {
            int wgid = (int)L; { const int q = P.nwg / NXCD, r = P.nwg % NXCD, xcd = wgid % NXCD, off = wgid / NXCD; wgid = (xcd < r ? xcd * (q + 1) : r * (q + 1) + (xcd - r) * q) + off; }
            const int nig = WGM * P.nN, gid = wgid / nig, fm = gid * WGM, gsz = (P.nM - fm) < WGM ? (P.nM - fm) : WGM;
            pm = fm + ((wgid % nig) % gsz); pn = (wgid % nig) / gsz; k0 = 0; nk = P.nkt; slab = -1;
        } else {
            const int tile = sidx / nsl, sl = sidx % nsl; pm = P.nM + tile / nN; pn = tile % nN; k0 = sl * nks; nk = nks; slab = sidx;
        }
        u.pm = pm; u.pn = pn; u.k0 = k0; u.nk = nk; u.slab = slab; return true;
    }
    __device__ __forceinline__ void a_ready(const Unit&) const {}
    __device__ __forceinline__ void done(const Unit&) const {}
};

typedef float f32x2_t __attribute__((ext_vector_type(2))); typedef __bf16 bf16x2_t __attribute__((ext_vector_type(2)));
__device__ __forceinline__ unsigned cvt_pk_bf16(float lo, float hi) { f32x2_t v = {lo, hi}; bf16x2_t b = __builtin_convertvector(v, bf16x2_t); return __builtin_bit_cast(unsigned, b); }

template <class Epi, class Sched, bool ALIGN_EPI = false, bool SP2 = false>
__device__ __forceinline__ void gemm_phase(PG8_LAS unsigned char* lds, const Gemm g, const Sched& S, const Epi& E) {
    const int tid = threadIdx.x, wid = __builtin_amdgcn_readfirstlane(tid >> 6), lane = tid & 63, wr = wid >> 2, wc = wid & 3, fr = lane & 15, fq = lane >> 4;
    const int K = g.K;
    unsigned voffA[2], voffB[2];
#pragma unroll
    for (int i = 0; i < 2; ++i) { int R, C; stage_rc(tid * 16 + i * 8192, R, C); const int Rb = Epi::PERM ? ((R & ~31) + perm32(R & 31)) : R;
        voffA[i] = (unsigned)(R * K + C) * 2u; voffB[i] = (unsigned)(Rb * K + C) * 2u; }
    const size_t kstep = (size_t)(BK * 2);
    const size_t hstep = (size_t)HALF * K * 2;
    const size_t tstep = 2 * hstep;
    const unsigned ldsw = (unsigned)wid * 1024u;
    const int aoff = lds_byte(wr * 64 + fr, fq * 8), boff = lds_byte(wc * 32 + fr, fq * 8);
#define PG8_SA(b, h) (((b) * 2 + (h)) * HTB)
#define PG8_SB(b, h) ((4 + (b) * 2 + (h)) * HTB)
#define PG8_STAGE(bufoff, gbase, voff) do { _Pragma("unroll") for (int _i = 0; _i < 2; ++_i) \
        __builtin_amdgcn_global_load_lds((const unsigned*)((const char*)(gbase) + (voff)[_i]), (PG8_LAS unsigned*)(lds + (bufoff) + ldsw + _i * 8192), 16, 0, 0); } while (0)
#define PG8_LDA(dst, b, h) do { _Pragma("unroll") for (int m = 0; m < 4; ++m) _Pragma("unroll") for (int k = 0; k < 2; ++k) dst[m][k] = *(const PG8_LAS bf16x8*)(lds + PG8_SA(b, h) + aoff + m * 2048 + k * 1024); } while (0)
#define PG8_LDB(dst, b, h) do { _Pragma("unroll") for (int n = 0; n < 2; ++n) _Pragma("unroll") for (int k = 0; k < 2; ++k) dst[n][k] = *(const PG8_LAS bf16x8*)(lds + PG8_SB(b, h) + boff + n * 2048 + k * 1024); } while (0)
#define PG8_MMA(ai, bj, At, Bt) do { __builtin_amdgcn_s_setprio(1); _Pragma("unroll") for (int m = 0; m < 4; ++m) _Pragma("unroll") for (int n = 0; n < 2; ++n) _Pragma("unroll") for (int k = 0; k < 2; ++k) \
        acc[ai][bj][m][n] = __builtin_amdgcn_mfma_f32_16x16x32_bf16(Bt[n][k], At[m][k], acc[ai][bj][m][n], 0, 0, 0); __builtin_amdgcn_s_setprio(0); } while (0)
#define PG8_WAIT_V(n) asm volatile("s_waitcnt vmcnt(" #n ")" ::: "memory")
#define PG8_WAIT_L(n) asm volatile("s_waitcnt lgkmcnt(" #n ")" ::: "memory")
#define PG8_BAR __builtin_amdgcn_s_barrier()
#define PG8_SCHED __builtin_amdgcn_sched_barrier(0)
    Unit cur, nxt; int ui = 0;
    if (!S.next(0, cur)) return;
    f32x4 acc[2][2][4][2];
#pragma unroll
    for (int a = 0; a < 2; ++a)
#pragma unroll
        for (int b = 0; b < 2; ++b)
#pragma unroll
            for (int m = 0; m < 4; ++m)
#pragma unroll
                for (int n = 0; n < 2; ++n) acc[a][b][m][n] = (f32x4){0.f, 0.f, 0.f, 0.f};
    bf16x8 At[4][2], B0[2][2], B1[2][2];
    const char* cA = (const char*)g.A + (size_t)cur.pm * tstep + (size_t)cur.k0 * kstep; const char* cB = (const char*)g.Bt + (size_t)cur.pn * tstep + (size_t)cur.k0 * kstep;
    S.a_ready(cur);
    if constexpr (SP2) {
        PG8_STAGE(PG8_SB(0, 0), cB, voffB); PG8_STAGE(PG8_SB(0, 1), cB + hstep, voffB); PG8_STAGE(PG8_SA(0, 0), cA, voffA); PG8_STAGE(PG8_SA(0, 1), cA + hstep, voffA);
        if (wr == 1) PG8_BAR;
        PG8_WAIT_V(2); PG8_BAR;
        PG8_STAGE(PG8_SB(1, 0), cB + kstep, voffB); PG8_STAGE(PG8_SA(1, 0), cA + kstep, voffA); PG8_STAGE(PG8_SB(1, 1), cB + hstep + kstep, voffB);
        PG8_WAIT_V(6); PG8_BAR;
    } else {
        PG8_STAGE(PG8_SB(0, 0), cB, voffB); PG8_STAGE(PG8_SA(0, 0), cA, voffA); PG8_STAGE(PG8_SB(0, 1), cB + hstep, voffB); PG8_STAGE(PG8_SA(0, 1), cA + hstep, voffA);
        if (wr == 1) PG8_BAR;
        PG8_WAIT_V(4); PG8_BAR;
        PG8_STAGE(PG8_SB(1, 0), cB + kstep, voffB); PG8_STAGE(PG8_SA(1, 0), cA + kstep, voffA); PG8_STAGE(PG8_SB(1, 1), cB + hstep + kstep, voffB);
        PG8_WAIT_V(6); PG8_BAR;
    }
    for (;;) {
        const bool has_next = S.next(ui + 1, nxt);
        const char* nA = has_next ? (const char*)g.A + (size_t)nxt.pm * tstep + (size_t)nxt.k0 * kstep : cA; const char* nB = has_next ? (const char*)g.Bt + (size_t)nxt.pn * tstep + (size_t)nxt.k0 * kstep : cB;
        const int nt = cur.nk;
        for (int t = 0; t < nt; t += 2) {
            const bool last = (t == nt - 2);
            const char* a1 = cA + (size_t)(t + 1) * kstep;
            const char* a2 = last ? nA : cA + (size_t)(t + 2) * kstep; const char* b2 = last ? nB : cB + (size_t)(t + 2) * kstep;
            const char* a3 = a2 + kstep; const char* b3 = b2 + kstep;
            if (last && has_next) S.a_ready(nxt);
            if constexpr (SP2) {
            PG8_LDB(B0, 0, 0); PG8_LDB(B1, 0, 1); PG8_SCHED; PG8_LDA(At, 0, 0); PG8_STAGE(PG8_SA(1, 1), a1 + hstep, voffA);
            PG8_WAIT_V(8); PG8_WAIT_L(0); PG8_BAR; PG8_MMA(0, 0, At, B0); PG8_MMA(0, 1, At, B1); PG8_BAR; PG8_SCHED;
            PG8_LDA(At, 0, 1); PG8_STAGE(PG8_SB(0, 0), b2, voffB); PG8_STAGE(PG8_SB(0, 1), b2 + hstep, voffB); PG8_STAGE(PG8_SA(0, 0), a2, voffA);
            PG8_WAIT_V(8); PG8_WAIT_L(0); PG8_BAR; PG8_MMA(1, 0, At, B0); PG8_MMA(1, 1, At, B1); PG8_BAR; PG8_SCHED;
            PG8_LDB(B0, 1, 0); PG8_LDB(B1, 1, 1); PG8_SCHED; PG8_LDA(At, 1, 0); PG8_STAGE(PG8_SA(0, 1), a2 + hstep, voffA);
            PG8_WAIT_V(8); PG8_WAIT_L(0); PG8_BAR; PG8_MMA(0, 0, At, B0); PG8_MMA(0, 1, At, B1); PG8_BAR; PG8_SCHED;
            PG8_LDA(At, 1, 1); PG8_STAGE(PG8_SB(1, 0), b3, voffB); PG8_STAGE(PG8_SB(1, 1), b3 + hstep, voffB); PG8_STAGE(PG8_SA(1, 0), a3, voffA);
            PG8_WAIT_V(8); PG8_WAIT_L(0); PG8_BAR; PG8_MMA(1, 0, At, B0); PG8_MMA(1, 1, At, B1); PG8_BAR; PG8_SCHED;
            } else {
            PG8_LDB(B0, 0, 0); PG8_SCHED; PG8_LDA(At, 0, 0); PG8_STAGE(PG8_SA(1, 1), a1 + hstep, voffA);
            PG8_WAIT_L(8); PG8_BAR; PG8_WAIT_L(0); PG8_MMA(0, 0, At, B0); PG8_BAR; PG8_SCHED;
            PG8_LDB(B1, 0, 1); PG8_STAGE(PG8_SB(0, 0), b2, voffB);
            PG8_BAR; PG8_WAIT_L(0); PG8_MMA(0, 1, At, B1); PG8_BAR;
            PG8_LDA(At, 0, 1); PG8_STAGE(PG8_SA(0, 0), a2, voffA);
            PG8_BAR; PG8_WAIT_L(0); PG8_MMA(1, 0, At, B0); PG8_BAR; PG8_SCHED;
            PG8_STAGE(PG8_SB(0, 1), b2 + hstep, voffB);
            PG8_WAIT_V(6); PG8_BAR; PG8_MMA(1, 1, At, B1); PG8_BAR;
            PG8_LDB(B0, 1, 0); PG8_SCHED; PG8_LDA(At, 1, 0); PG8_STAGE(PG8_SA(0, 1), a2 + hstep, voffA);
            PG8_WAIT_L(8); PG8_BAR; PG8_WAIT_L(0); PG8_MMA(0, 0, At, B0); PG8_BAR; PG8_SCHED;
            PG8_LDB(B1, 1, 1); PG8_STAGE(PG8_SB(1, 0), b3, voffB);
            PG8_BAR; PG8_WAIT_L(0); PG8_MMA(0, 1, At, B1); PG8_BAR;
            PG8_LDA(At, 1, 1); PG8_STAGE(PG8_SA(1, 0), a3, voffA);
            PG8_BAR; PG8_WAIT_L(0); PG8_MMA(1, 0, At, B0); PG8_BAR; PG8_SCHED;
            PG8_STAGE(PG8_SB(1, 1), b3 + hstep, voffB);
            PG8_WAIT_V(6); PG8_BAR; PG8_MMA(1, 1, At, B1); PG8_BAR;
            }
        }
        if constexpr (ALIGN_EPI) { if (wr == 0) PG8_BAR; }
        if constexpr (!Epi::AFTER_DRAIN) { E(acc, cur, wr, wc, fr, fq); S.done(cur); }
        if (!has_next) break;
#pragma unroll
        for (int a = 0; a < 2; ++a)
#pragma unroll
            for (int b = 0; b < 2; ++b)
#pragma unroll
                for (int m = 0; m < 4; ++m)
#pragma unroll
                    for (int n = 0; n < 2; ++n) acc[a][b][m][n] = (f32x4){0.f, 0.f, 0.f, 0.f};
        cur = nxt; cA = nA; cB = nB; ++ui;
        if constexpr (ALIGN_EPI) { if (wr == 1) PG8_BAR; }
    }
    PG8_WAIT_V(0);
    if constexpr (!ALIGN_EPI) { if (wr == 0) PG8_BAR; }
    PG8_BAR;
#undef PG8_SA
#undef PG8_SB
#undef PG8_STAGE
#undef PG8_LDA
#undef PG8_LDB
#undef PG8_MMA
#undef PG8_WAIT_V
#undef PG8_WAIT_L
#undef PG8_BAR
#undef PG8_SCHED
}
}

constexpr int NWAVES = 8;
constexpr int MP = 8192, MS = 512, MT = MP + MS;
constexpr int DM = 2048, NPROJ = 5632, DIN = 5648, DFF = 5632, NH = 8, NSH = 16;
constexpr int NCHUNK = 128 + 32;
constexpr float EPS = 1e-6f;
constexpr float LOG2E = 1.4426950408889634f;
constexpr float QSCALE = 0.125f * LOG2E;
constexpr float LAM_INIT = 0.2f;

constexpr size_t O_Y = 0, O_KP = 17825792, O_VP = 26214400, O_CP = 34603008, O_SP = 34607616, O_FP = 34738688,
                 O_KS = 34749952, O_VS = 35274240, O_CS = 35798528, O_SS = 35945984, O_FS = 40140288, O_END = 40500736;

constexpr size_t MiB = 1u << 20;
constexpr size_t WS_CTL = 0, CTL_ZERO_BYTES = 64 * 1024;
constexpr size_t WS_WIN = 2 * MiB, WS_WOUT = 24 * MiB, WS_WGU = 32 * MiB, WS_WDN = 76 * MiB, WS_XN = 98 * MiB;
constexpr size_t WS_Q = 132 * MiB, WS_K = 150 * MiB, WS_V = 168 * MiB, WS_Z = 186 * MiB, WS_XBC = 204 * MiB, WS_DT = 230 * MiB;
constexpr size_t WS_ACUM = 235 * MiB, WS_CD = 236 * MiB, WS_CB = 237 * MiB, WS_A2 = 243 * MiB, WS_SCH = 277 * MiB, WS_HPREV = 357 * MiB, WS_YP = 397 * MiB;
constexpr size_t WS_RS1 = 437 * MiB, WS_RS2 = 439 * MiB, WS_FRG = 441 * MiB, WS_FRU = 443 * MiB, WS_LRG = 445 * MiB, WS_RSTD1 = 447 * MiB, WS_END = 448 * MiB;
constexpr size_t WS_HID = 132 * MiB, WS_G = 226 * MiB, WS_U = 320 * MiB;
constexpr size_t WS_SLAB5 = WS_Q, WS_SLAB9 = WS_G;
static_assert(WS_U + (size_t)MT * DFF * 2 <= WS_RS1, "ffn overlay");
constexpr int CW_BAR = 4096, CW_QK = 8192, CW_QUEUE = 8320, CW_LDONE = 8384, CW_SDONE = 8448;

constexpr int LDS_BYTES = 147456, LDSCTL_OFF = 146432;

#define GAS __attribute__((address_space(1)))
#define LAS __attribute__((address_space(3)))
typedef unsigned short bf16;
typedef unsigned v4u __attribute__((ext_vector_type(4)));
typedef unsigned v2u __attribute__((ext_vector_type(2)));
typedef float f32x2 __attribute__((ext_vector_type(2)));
typedef float f32x4 __attribute__((ext_vector_type(4)));
typedef float f32x8 __attribute__((ext_vector_type(8)));
typedef float f32x16 __attribute__((ext_vector_type(16)));
typedef short bf16x8 __attribute__((ext_vector_type(8)));
typedef short s16x4 __attribute__((ext_vector_type(4)));
typedef GAS unsigned gu32;

__device__ __forceinline__ unsigned f2bf(float f) { unsigned u = __builtin_bit_cast(unsigned, f); return (u + 0x7fffu + ((u >> 16) & 1u)) >> 16; }
__device__ __forceinline__ unsigned pk2(float lo, float hi) { return pg8::cvt_pk_bf16(lo, hi); }
__device__ __forceinline__ float bf2f(unsigned short b) { return __builtin_bit_cast(float, (unsigned)b << 16); }
__device__ __forceinline__ float bflo(unsigned w) { return __builtin_bit_cast(float, w << 16); }
__device__ __forceinline__ float bfhi(unsigned w) { return __builtin_bit_cast(float, w & 0xffff0000u); }
__device__ __forceinline__ float wave_sum(float v) {
#pragma unroll
    for (int o = 1; o < 64; o <<= 1) v += __shfl_xor(v, o);
    return v;
}
__device__ __forceinline__ float siluf(float x) { return x * __builtin_amdgcn_rcpf(1.f + __builtin_amdgcn_exp2f(-LOG2E * x)); }

#define XB_TMO      128
#define XB_XCNT(j)  (256  + 64 * (j))
#define XB_XSUB(j)  (1280 + 64 * (j))
#define XB_XGEN(j)  (2304 + 64 * (j))
#define XB_TOP      3328
#define XB_TOPGEN   3392
#define XCD_BAR_WORDS 3456
#define XB_SPIN_CAP (1u << 18)
__device__ __forceinline__ unsigned xb_ld(unsigned* p)              { return __hip_atomic_load(p, __ATOMIC_RELAXED, __HIP_MEMORY_SCOPE_AGENT); }
__device__ __forceinline__ unsigned xb_add(unsigned* p, unsigned v) { return __hip_atomic_fetch_add(p, v, __ATOMIC_RELAXED, __HIP_MEMORY_SCOPE_AGENT); }
__device__ __forceinline__ unsigned xb_xcc_id() { return (unsigned)__builtin_amdgcn_s_getreg((3 << 11) | 20) & 0xFu; }
#define XB_SPIN(cond, bar) do { unsigned _sp = 0; while (cond) { __builtin_amdgcn_s_sleep(1); \
    if ((++_sp & 255u) == 0u) { if (xb_ld(&(bar)[XB_TMO])) break; if (_sp > XB_SPIN_CAP) { atomicAdd(&(bar)[XB_TMO], 1u); break; } } } } while (0)
struct XcdBarrier { unsigned* bar; unsigned x; volatile LAS unsigned* st; };
__device__ __forceinline__ XcdBarrier xcd_barrier_post(unsigned* bar, volatile LAS unsigned* st) {
    XcdBarrier b; b.bar = bar; b.x = xb_xcc_id(); b.st = st;
    if (threadIdx.x == 0) (void)xb_add(&bar[XB_XCNT(b.x)], 1u);
    return b;
}
__device__ __forceinline__ void xcd_barrier_complete(unsigned* bar, unsigned x, unsigned& nloc, unsigned& nx) {
    const unsigned G = gridDim.x * gridDim.y * gridDim.z;
    unsigned sum, cnt, mine, sp = 0u;
    for (;;) {
        sum = 0u; cnt = 0u; mine = 0u;
#pragma unroll
        for (unsigned j = 0; j < 16; ++j) { const unsigned c = xb_ld(&bar[XB_XCNT(j)]); sum += c; cnt += (c > 0u) ? 1u : 0u; mine = (j == x) ? c : mine; }
        if (sum == G) break;
        __builtin_amdgcn_s_sleep(1);
        if ((++sp & 255u) == 0u) { if (xb_ld(&bar[XB_TMO])) break; if (sp > XB_SPIN_CAP) { atomicAdd(&bar[XB_TMO], 1u); break; } }
    }
    nloc = mine > 0u ? mine : 1u; nx = cnt > 0u ? cnt : 1u;
}
__device__ __forceinline__ void xcd_barrier(const XcdBarrier& b) {
    asm volatile("s_waitcnt vmcnt(0)" ::: "memory");
    __syncthreads();
    if (threadIdx.x == 0) {
        unsigned* bar = b.bar;
        __builtin_amdgcn_s_waitcnt(0);
        unsigned nloc = b.st[0], nx = b.st[1];
        if (nloc == 0u) { xcd_barrier_complete(bar, b.x, nloc, nx); b.st[0] = nloc; b.st[1] = nx; }
        const unsigned old = xb_add(&bar[XB_XSUB(b.x)], 1u);
        const unsigned gen = old / nloc;
        if (old + 1u == (gen + 1u) * nloc) {
            __builtin_amdgcn_fence(__ATOMIC_RELEASE, "agent");
            asm volatile("s_waitcnt vmcnt(0)" ::: "memory");
            const unsigned og = xb_add(&bar[XB_TOP], 1u);
            const unsigned tg = og / nx;
            if (og + 1u == (tg + 1u) * nx) xb_add(&bar[XB_TOPGEN], 1u);
            else XB_SPIN(xb_ld(&bar[XB_TOPGEN]) == tg, bar);
            __builtin_amdgcn_fence(__ATOMIC_ACQUIRE, "agent");
            xb_add(&bar[XB_XGEN(b.x)], 1u);
            asm volatile("s_waitcnt vmcnt(0)" ::: "memory");
        } else {
            XB_SPIN(xb_ld(&bar[XB_XGEN(b.x)]) == gen, bar);
            __builtin_amdgcn_fence(__ATOMIC_ACQUIRE, "agent");
            asm volatile("s_waitcnt vmcnt(0)" ::: "memory");
        }
    }
    __syncthreads();
}

struct Args {
    const float* in[28];
    float* out; unsigned char* ws;
    int ph_lo, ph_hi, li, pad;
};
enum { I_XP = 0, I_XS, I_CK, I_CV, I_SCONV, I_SSM, I_SFFN, I_GMIX, I_WIN, I_LQ1, I_LK1, I_LQ2, I_LK2, I_GSUB, I_CONVW, I_CONVB, I_DTB, I_ALOG, I_DSKIP,
       I_GSSM, I_WOUT, I_GFFN, I_WGATE, I_WUP, I_FCW, I_FCB, I_WDOWN, I_GFIN };

struct P0Item { const float* W; const float* g; bf16* WT; int ldw, K, k0, n0, rowbase; };
__device__ __forceinline__ void p0_load(const P0Item& it, f32x4 (&v)[16], int lane) {
    const int rsub = lane >> 4, c4 = 4 * (lane & 15);
#pragma unroll
    for (int i = 0; i < 16; ++i) v[i] = *(const f32x4*)(it.W + (size_t)(it.k0 + 4 * i + rsub) * it.ldw + it.n0 + c4);
}
__device__ __forceinline__ void p0_to_lds(const P0Item& it, const f32x4 (&v)[16], LAS float* scr, int lane) {
    const int rsub = lane >> 4, c4 = 4 * (lane & 15);
#pragma unroll
    for (int i = 0; i < 16; ++i) { const int r = 4 * i + rsub; f32x4 x = v[i]; if (it.g) x = x * it.g[it.k0 + r];
        LAS float* d = scr + r * 65 + c4; d[0] = x[0]; d[1] = x[1]; d[2] = x[2]; d[3] = x[3]; }
    asm volatile("s_waitcnt lgkmcnt(0)" ::: "memory");
}
__device__ __forceinline__ void p0_store(const P0Item& it, LAS float* scr, int lane) {
    const int c = lane & 7;
#pragma unroll
    for (int j = 0; j < 8; ++j) { const int n = (lane >> 3) + 8 * j; const LAS float* sp = scr + (8 * c) * 65 + n;
        v4u o; o.x = pk2(sp[0 * 65], sp[1 * 65]); o.y = pk2(sp[2 * 65], sp[3 * 65]); o.z = pk2(sp[4 * 65], sp[5 * 65]); o.w = pk2(sp[6 * 65], sp[7 * 65]);
        *(GAS v4u*)(it.WT + (size_t)(it.rowbase + n) * it.K + it.k0 + 8 * c) = o; }
    asm volatile("s_waitcnt lgkmcnt(0)" ::: "memory");
}
__device__ __forceinline__ P0Item p0_item(const Args& A, unsigned char* ws, int r) {
    constexpr int I_A = 32 * 88, I_B = 32 * 32, I_C = 32 * 88, I_D = 32 * 88;
    P0Item it;
    if (r < I_A) { it = P0Item{A.in[I_WIN], nullptr, (bf16*)(ws + WS_WIN), DIN, DM, 64 * (r / 88), 64 * (r % 88), 64 * (r % 88)}; return it; } r -= I_A;
    if (r < I_B) { it = P0Item{A.in[I_WOUT], nullptr, (bf16*)(ws + WS_WOUT), DM, DM, 64 * (r / 32), 64 * (r % 32), 64 * (r % 32)}; return it; } r -= I_B;
    if (r < I_C) { const int n0 = 64 * (r % 88); it = P0Item{A.in[I_WGATE], A.in[I_GFFN], (bf16*)(ws + WS_WGU), DFF, DM, 64 * (r / 88), n0, (n0 >> 7) * 256 + (n0 & 127)}; return it; } r -= I_C;
    if (r < I_D) { const int n0 = 64 * (r % 88); it = P0Item{A.in[I_WUP], A.in[I_GFFN], (bf16*)(ws + WS_WGU), DFF, DM, 64 * (r / 88), n0, (n0 >> 7) * 256 + 128 + (n0 & 127)}; return it; } r -= I_D;
    it = P0Item{A.in[I_WDOWN], nullptr, (bf16*)(ws + WS_WDN), DM, DFF, 64 * (r / 32), 64 * (r % 32), 64 * (r % 32)}; return it;
}

struct EpiInProj {
    static constexpr bool PERM = true, AFTER_DRAIN = false;
    bf16 *Q, *K, *V, *Z, *XBC; float* out; unsigned* qk2;
    __device__ __forceinline__ void operator()(const pg8::f32x4 (&acc)[2][2][4][2], const pg8::Unit& u, int wr, int wc, int fr, int fq) const {
        const int region = u.pn >> 2;
        float nmax[2] = {0.f, 0.f};
        const int row0 = u.pm * 256 + wr * 64 + fr;
        const int cl = wc * 32 + 8 * fq;
#pragma unroll
        for (int ai = 0; ai < 2; ++ai)
#pragma unroll
            for (int m = 0; m < 4; ++m) {
                const int row = row0 + ai * 128 + m * 16;
#pragma unroll
                for (int bj = 0; bj < 2; ++bj) {
                    f32x4 v0 = acc[ai][bj][m][0], v1 = acc[ai][bj][m][1];
                    if (region < 4) {
                        const int c = (u.pn & 3) * 256 + bj * 128 + cl;
                        if (region == 0) { v0 = v0 * QSCALE; v1 = v1 * QSCALE; }
                        if (region < 2) { float ss = (v0[0] * v0[0] + v0[1] * v0[1]) + (v0[2] * v0[2] + v0[3] * v0[3]) + (v1[0] * v1[0] + v1[1] * v1[1]) + (v1[2] * v1[2] + v1[3] * v1[3]);
                            ss += __shfl_xor(ss, 16); ss += __shfl_xor(ss, 32); nmax[bj] = fmaxf(nmax[bj], ss); }
                        v4u w; w.x = pk2(v0[0], v0[1]); w.y = pk2(v0[2], v0[3]); w.z = pk2(v1[0], v1[1]); w.w = pk2(v1[2], v1[3]);
                        bf16* dst = region == 0 ? Q : region == 1 ? K : region == 2 ? V : Z;
                        *(v4u*)(dst + (size_t)row * 1024 + c) = w;
                        if (region == 1 || region == 2) {
                            float* o = out + (row < MP ? (region == 1 ? O_KP : O_VP) + (size_t)row * 1024 : (region == 1 ? O_KS : O_VS) + (size_t)(row - MP) * 1024) + c;
                            *(f32x4*)o = v0; *(f32x4*)(o + 4) = v1;
                        }
                    } else {
                        const int c = (u.pn - 16) * 256 + bj * 128 + cl;
                        v4u w; w.x = pk2(v0[0], v0[1]); w.y = pk2(v0[2], v0[3]); w.z = pk2(v1[0], v1[1]); w.w = pk2(v1[2], v1[3]);
                        *(v4u*)(XBC + (size_t)row * 1536 + c) = w;
                        if (row >= MP - 3) {
                            float* o = nullptr;
                            if (row < MP) o = out + O_CP + (size_t)(row - (MP - 3)) * 1536 + c;
                            else { const int rr = row - MP, i = rr & 15; if (i >= 13) o = out + O_CS + (size_t)((rr >> 4) * 3 + (i - 13)) * 1536 + c; }
                            if (o) { *(f32x4*)o = v0; *(f32x4*)(o + 4) = v1; }
                        }
                    }
                }
            }
        if (region < 2 && u.pm < MP / 256) {
#pragma unroll
            for (int bj = 0; bj < 2; ++bj) { float v = nmax[bj]; v = fmaxf(v, __shfl_xor(v, 1)); v = fmaxf(v, __shfl_xor(v, 2)); v = fmaxf(v, __shfl_xor(v, 4)); v = fmaxf(v, __shfl_xor(v, 8));
                if (fr == 0 && fq == 0) atomicMax(qk2 + region * 32 + (u.pn & 3) * 8 + bj * 4 + wc, __float_as_uint(v)); }
        }
    }
};

__device__ __forceinline__ void store_slab(float* slab, const pg8::f32x4 (&acc)[2][2][4][2], int wr, int wc, int fr, int fq) {
#pragma unroll
    for (int ai = 0; ai < 2; ++ai)
#pragma unroll
        for (int m = 0; m < 4; ++m)
#pragma unroll
            for (int bj = 0; bj < 2; ++bj) { float* o = slab + (size_t)(ai * 128 + wr * 64 + m * 16 + fr) * 256 + bj * 128 + wc * 32 + 8 * fq; *(f32x4*)o = acc[ai][bj][m][0]; *(f32x4*)(o + 4) = acc[ai][bj][m][1]; }
}

struct EpiOutProj {
    static constexpr bool PERM = true, AFTER_DRAIN = false;
    const float* xp; const float* xs; float* out; bf16* x1b; float* rs; float* slabs;
    __device__ __forceinline__ void operator()(const pg8::f32x4 (&acc)[2][2][4][2], const pg8::Unit& u, int wr, int wc, int fr, int fq) const {
        if (u.slab >= 0) { store_slab(slabs + (size_t)u.slab * 65536, acc, wr, wc, fr, fq); return; }
        const int row0 = u.pm * 256 + wr * 64 + fr;
        const int c0 = u.pn * 256 + wc * 32 + 8 * fq;
#pragma unroll
        for (int ai = 0; ai < 2; ++ai)
#pragma unroll
        for (int mh = 0; mh < 2; ++mh) {
            f32x4 xr[2][2][2];
#pragma unroll
            for (int m = 0; m < 2; ++m) { const int row = row0 + ai * 128 + (2 * mh + m) * 16; const float* xrow = row < MP ? xp + (size_t)row * DM : xs + (size_t)(row - MP) * DM;
#pragma unroll
                for (int bj = 0; bj < 2; ++bj) { xr[m][bj][0] = *(const f32x4*)(xrow + c0 + bj * 128); xr[m][bj][1] = *(const f32x4*)(xrow + c0 + bj * 128 + 4); } }
            asm volatile("" ::: "memory");
#pragma unroll
            for (int m = 0; m < 2; ++m) {
                const int mm = 2 * mh + m, row = row0 + ai * 128 + mm * 16;
                float ss = 0.f;
#pragma unroll
                for (int bj = 0; bj < 2; ++bj) {
                    const int c = c0 + bj * 128;
                    const f32x4 v0 = acc[ai][bj][mm][0] + xr[m][bj][0], v1 = acc[ai][bj][mm][1] + xr[m][bj][1];
                    v4u w; w.x = pk2(v0[0], v0[1]); w.y = pk2(v0[2], v0[3]); w.z = pk2(v1[0], v1[1]); w.w = pk2(v1[2], v1[3]);
                    *(v4u*)(x1b + (size_t)row * DM + c) = w;
                    ss += (v0[0] * v0[0] + v0[1] * v0[1]) + (v0[2] * v0[2] + v0[3] * v0[3]) + (v1[0] * v1[0] + v1[1] * v1[1]) + (v1[2] * v1[2] + v1[3] * v1[3]);
                }
                ss += __shfl_xor(ss, 16); ss += __shfl_xor(ss, 32);
                if (fq == 0) rs[(size_t)row * 32 + u.pn * 4 + wc] = ss;
            }
        }
    }
};


constexpr int HALO_OFF = 131072;
struct EpiGateUp {
    static constexpr bool PERM = true, AFTER_DRAIN = false;
    bf16* HID; const float* rs; float* out; const float* fcw; const float* fcb; const float* sffn; float* frg; float* fru; float* lrg; LAS unsigned char* lds;
    __device__ __forceinline__ void operator()(const pg8::f32x4 (&acc)[2][2][4][2], const pg8::Unit& u, int wr, int wc, int fr, int fq) const {
        const int row0 = u.pm * 256 + wr * 64 + fr;
        const int cl = wc * 32 + 8 * fq, c = u.pn * 128 + cl;
        const bool sample = u.pm >= MP / 256;
        f32x4 w0[2], w1[2], w2[2], bb[2];
#pragma unroll
        for (int n = 0; n < 2; ++n) { w0[n] = *(const f32x4*)(fcw + c + 4 * n); w1[n] = *(const f32x4*)(fcw + DFF + c + 4 * n); w2[n] = *(const f32x4*)(fcw + 2 * DFF + c + 4 * n); bb[n] = *(const f32x4*)(fcb + c + 4 * n); }
        float rstd8[2][4];
#pragma unroll
        for (int ai = 0; ai < 2; ++ai)
#pragma unroll
            for (int m = 0; m < 4; ++m) rstd8[ai][m] = rs[row0 + ai * 128 + m * 16];
        LAS float* halo = (LAS float*)(lds + HALO_OFF);
        if (!sample) {
#pragma unroll
            for (int ai = 0; ai < 2; ++ai) {
                const float r3 = rstd8[ai][3];
                if (fr >= 14) { LAS float* hp = halo + ((2 * ai + wr) * 2 + (fr - 14)) * 128 + cl; *(LAS f32x4*)hp = acc[ai][0][3][0] * r3; *(LAS f32x4*)(hp + 4) = acc[ai][0][3][1] * r3; }
            }
        }
        asm volatile("s_waitcnt lgkmcnt(0)" ::: "memory"); __builtin_amdgcn_s_barrier(); asm volatile("" ::: "memory");
#pragma unroll
        for (int ai = 0; ai < 2; ++ai) {
            f32x4 gprev[2] = {(f32x4){0.f, 0.f, 0.f, 0.f}, (f32x4){0.f, 0.f, 0.f, 0.f}};
#pragma unroll
            for (int m = 0; m < 4; ++m) {
                const int row = row0 + ai * 128 + m * 16;
                const float rstd = rstd8[ai][m];
                f32x4 gc[2] = {acc[ai][0][m][0] * rstd, acc[ai][0][m][1] * rstd};
                f32x4 pv[2];
                bool defer = false;
                if (sample) {
                    const int b = (row - fr - MP) >> 4;
                    const float* sp = sffn + ((size_t)b * 2 + (fr & 1)) * DFF + c;
                    pv[0] = *(const f32x4*)sp; pv[1] = *(const f32x4*)(sp + 4);
                } else if (m > 0) { pv[0] = gprev[0]; pv[1] = gprev[1]; }
                else {
                    const int gidx = 2 * ai + wr;
                    if (gidx > 0) { const LAS float* hp = halo + ((gidx - 1) * 2 + (fr & 1)) * 128 + cl; pv[0] = *(const LAS f32x4*)hp; pv[1] = *(const LAS f32x4*)(hp + 4); }
                    else { pv[0] = (f32x4){0.f, 0.f, 0.f, 0.f}; pv[1] = pv[0]; defer = u.pm > 0; }
                }
                const f32x4 u0 = acc[ai][1][m][0] * rstd, u1 = acc[ai][1][m][1] * rstd;
                f32x4 h[2];
#pragma unroll
                for (int n = 0; n < 2; ++n)
#pragma unroll
                    for (int e = 0; e < 4; ++e) {
                        const float cur = gc[n][e], pvv = pv[n][e];
                        const int ci = __float_as_int(cur), pi_ = __float_as_int(pvv);
                        const float g1 = __int_as_float(__builtin_amdgcn_update_dpp(__builtin_amdgcn_update_dpp(0, pi_, 0x121, 0xf, 0xf, false), ci, 0x111, 0xf, 0xf, false));
                        const float g2 = __int_as_float(__builtin_amdgcn_update_dpp(__builtin_amdgcn_update_dpp(0, pi_, 0x122, 0xf, 0xf, false), ci, 0x112, 0xf, 0xf, false));
                        const float y = bb[n][e] + w0[n][e] * g2 + w1[n][e] * g1 + w2[n][e] * cur;
                        h[n][e] = siluf(y) * (n == 0 ? u0[e] : u1[e]);
                    }
                if (defer && fr < 2) {
                    float* o = frg + ((size_t)u.pm * 2 + fr) * DFF + c; *(f32x4*)o = gc[0]; *(f32x4*)(o + 4) = gc[1];
                    o = fru + ((size_t)u.pm * 2 + fr) * DFF + c; *(f32x4*)o = u0; *(f32x4*)(o + 4) = u1;
                } else {
                    v4u w; w.x = pk2(h[0][0], h[0][1]); w.y = pk2(h[0][2], h[0][3]); w.z = pk2(h[1][0], h[1][1]); w.w = pk2(h[1][2], h[1][3]);
                    *(v4u*)(HID + (size_t)row * DFF + c) = w;
                }
                if (!sample && ai == 1 && m == 3 && wr == 1 && fr >= 14) { float* o = lrg + ((size_t)u.pm * 2 + (fr - 14)) * DFF + c; *(f32x4*)o = gc[0]; *(f32x4*)(o + 4) = gc[1]; }
                if (row >= MP - 2) {
                    float* o = nullptr;
                    if (row < MP) o = out + O_FP + (size_t)(row - (MP - 2)) * DFF + c;
                    else { const int rr = row - MP, i = rr & 15; if (i >= 14) o = out + O_FS + (size_t)((rr >> 4) * 2 + (i - 14)) * DFF + c; }
                    if (o) { *(f32x4*)o = gc[0]; *(f32x4*)(o + 4) = gc[1]; }
                }
                gprev[0] = gc[0]; gprev[1] = gc[1];
            }
        }
    }
};

struct EpiDown {
    static constexpr bool PERM = true, AFTER_DRAIN = false;
    float* out; float* rs; float* slabs; bf16* x2b;
    __device__ __forceinline__ void operator()(const pg8::f32x4 (&acc)[2][2][4][2], const pg8::Unit& u, int wr, int wc, int fr, int fq) const {
        if (u.slab >= 0) { store_slab(slabs + (size_t)u.slab * 65536, acc, wr, wc, fr, fq); return; }
        const int row0 = u.pm * 256 + wr * 64 + fr;
        const int c0 = u.pn * 256 + wc * 32 + 8 * fq;
#pragma unroll
        for (int ai = 0; ai < 2; ++ai)
#pragma unroll
        for (int mh = 0; mh < 2; ++mh) {
            f32x4 xr[2][2][2];
#pragma unroll
            for (int m = 0; m < 2; ++m) { const bf16* xrow = x2b + (size_t)(row0 + ai * 128 + (2 * mh + m) * 16) * DM;
#pragma unroll
                for (int bj = 0; bj < 2; ++bj) { const v4u w = *(const v4u*)(xrow + c0 + bj * 128);
                    xr[m][bj][0] = (f32x4){bflo(w.x), bfhi(w.x), bflo(w.y), bfhi(w.y)}; xr[m][bj][1] = (f32x4){bflo(w.z), bfhi(w.z), bflo(w.w), bfhi(w.w)}; } }
            asm volatile("" ::: "memory");
#pragma unroll
            for (int m = 0; m < 2; ++m) {
                const int mm = 2 * mh + m, row = row0 + ai * 128 + mm * 16;
                float ss = 0.f;
#pragma unroll
                for (int bj = 0; bj < 2; ++bj) {
                    const f32x4 v0 = acc[ai][bj][mm][0] + xr[m][bj][0], v1 = acc[ai][bj][mm][1] + xr[m][bj][1];
                    v4u w; w.x = pk2(v0[0], v0[1]); w.y = pk2(v0[2], v0[3]); w.z = pk2(v1[0], v1[1]); w.w = pk2(v1[2], v1[3]);
                    *(v4u*)(x2b + (size_t)row * DM + c0 + bj * 128) = w;
                    ss += (v0[0] * v0[0] + v0[1] * v0[1]) + (v0[2] * v0[2] + v0[3] * v0[3]) + (v1[0] * v1[0] + v1[1] * v1[1]) + (v1[2] * v1[2] + v1[3] * v1[3]);
                }
                ss += __shfl_xor(ss, 16); ss += __shfl_xor(ss, 32);
                if (fq == 0) rs[(size_t)row * 32 + u.pn * 4 + wc] = ss;
            }
        }
    }
};

__device__ __forceinline__ int crow(int r, int hi) { return (r & 3) + 8 * (r >> 2) + 4 * hi; }
#define MFMA32(a, b, c) __builtin_amdgcn_mfma_f32_32x32x16_bf16((a), (b), (c), 0, 0, 0)

constexpr int SL_XT = 0, SL_XT_ROW = 144, SL_XT_HEAD = 64 * 144;
constexpr int SL_BN = 73728, SL_N_ROW = 272;
constexpr int SL_CN = SL_BN + 64 * 272;
constexpr int SL_BT = SL_CN + 64 * 272, SL_BT_ROW = 144;
constexpr int SL_DT = SL_BT + 128 * 144;
constexpr int SL_AC = SL_DT + 2048;
constexpr int SL_W = SL_AC + 2048;
constexpr int SL_END = SL_W + 2048;
static_assert(SL_END <= LDSCTL_OFF, "ssd lds");

struct SsdUnit { int cid, g, T, rbase, batch; };
__device__ __forceinline__ SsdUnit ssd_unit(int u) {
    SsdUnit s;
    if (u < 256) { s.cid = u >> 1; s.g = u & 1; s.T = 64; s.rbase = 64 * s.cid; s.batch = -1; }
    else { const int v = u - 256; s.batch = v >> 1; s.g = v & 1; s.cid = 128 + s.batch; s.T = 16; s.rbase = MP + 16 * s.batch; }
    return s;
}

__device__ __forceinline__ void ssd_local(const Args& A, LAS unsigned char* lds, int u) {
    const SsdUnit su = ssd_unit(u);
    int tid_ = threadIdx.x; asm volatile("" : "+v"(tid_));
    const int tid = tid_, lane = tid & 63, wid = __builtin_amdgcn_readfirstlane(tid >> 6), r32 = lane & 31, hi = lane >> 5;
    unsigned char* ws = A.ws;
    const bf16* XBC = (const bf16*)(ws + WS_XBC);
    const float* DT = (const float*)(ws + WS_DT);
    if (tid < 384) {
        const int tq = tid & 3, cgi = tid >> 2, t0 = 16 * tq;
        int col; if (cgi < 64) col = 512 * su.g + 8 * cgi; else if (cgi < 80) col = 1024 + 128 * su.g + 8 * (cgi - 64); else col = 1280 + 128 * su.g + 8 * (cgi - 80);
        unsigned ow[8][8];
        if (t0 < su.T) {
            const float* cw = A.in[I_CONVW]; const float* cbias = A.in[I_CONVB];
            f32x4 wv[4][2], bb[2];
#pragma unroll
            for (int n = 0; n < 2; ++n) { bb[n] = *(const f32x4*)(cbias + col + 4 * n);
#pragma unroll
                for (int k = 0; k < 4; ++k) wv[k][n] = *(const f32x4*)(cw + k * 1536 + col + 4 * n); }
            float hist[3][8];
#pragma unroll
            for (int k = 0; k < 3; ++k) {
                const int t = t0 - 3 + k;
                if (t >= 0 || (su.batch < 0 && su.cid > 0)) {
                    const v4u raw = *(const v4u*)(XBC + (size_t)(su.rbase + t) * 1536 + col);
                    hist[k][0] = bflo(raw.x); hist[k][1] = bfhi(raw.x); hist[k][2] = bflo(raw.y); hist[k][3] = bfhi(raw.y); hist[k][4] = bflo(raw.z); hist[k][5] = bfhi(raw.z); hist[k][6] = bflo(raw.w); hist[k][7] = bfhi(raw.w);
                } else if (su.batch >= 0) {
                    const float* sp = A.in[I_SCONV] + ((size_t)su.batch * 3 + (3 + t)) * 1536 + col;
                    const f32x4 a = *(const f32x4*)sp, b = *(const f32x4*)(sp + 4);
                    hist[k][0] = a[0]; hist[k][1] = a[1]; hist[k][2] = a[2]; hist[k][3] = a[3]; hist[k][4] = b[0]; hist[k][5] = b[1]; hist[k][6] = b[2]; hist[k][7] = b[3];
                } else {
#pragma unroll
                    for (int e = 0; e < 8; ++e) hist[k][e] = 0.f;
                }
            }
            v4u rawv[16];
#pragma unroll
            for (int tt = 0; tt < 16; ++tt) rawv[tt] = *(const v4u*)(XBC + (size_t)(su.rbase + t0 + tt) * 1536 + col);
            float prev[8];
#pragma unroll
            for (int tt = 0; tt < 16; ++tt) {
                const v4u raw = rawv[tt];
                float v[8], o[8]; v[0] = bflo(raw.x); v[1] = bfhi(raw.x); v[2] = bflo(raw.y); v[3] = bfhi(raw.y); v[4] = bflo(raw.z); v[5] = bfhi(raw.z); v[6] = bflo(raw.w); v[7] = bfhi(raw.w);
#pragma unroll
                for (int e = 0; e < 8; ++e) { const float y = bb[e >> 2][e & 3] + wv[0][e >> 2][e & 3] * hist[0][e] + wv[1][e >> 2][e & 3] * hist[1][e] + wv[2][e >> 2][e & 3] * hist[2][e] + wv[3][e >> 2][e & 3] * v[e];
                    o[e] = siluf(y); hist[0][e] = hist[1][e]; hist[1][e] = hist[2][e]; hist[2][e] = v[e]; }
                if (cgi >= 64) {
                    v4u w; w.x = pk2(o[0], o[1]); w.y = pk2(o[2], o[3]); w.z = pk2(o[4], o[5]); w.w = pk2(o[6], o[7]);
                    const int n0 = 8 * ((cgi - 64) & 15), t = t0 + tt;
                    if (cgi < 80) *(LAS v4u*)(lds + SL_BN + t * SL_N_ROW + n0 * 2) = w;
                    else { *(LAS v4u*)(lds + SL_CN + t * SL_N_ROW + n0 * 2) = w; *(v4u*)((bf16*)(ws + WS_CB) + ((size_t)su.cid * 64 + t) * 256 + su.g * 128 + n0) = w; }
                }
                if (tt & 1) {
#pragma unroll
                    for (int e = 0; e < 8; ++e) ow[e][tt >> 1] = pk2(prev[e], o[e]);
                } else {
#pragma unroll
                    for (int e = 0; e < 8; ++e) prev[e] = o[e];
                }
            }
        } else {
#pragma unroll
            for (int e = 0; e < 8; ++e)
#pragma unroll
                for (int k = 0; k < 8; ++k) ow[e][k] = 0u;
            { unsigned z1 = 0u; asm volatile("" : "+v"(z1)); ow[0][0] = z1; }
            if (cgi >= 64) {
                const int n0 = 8 * ((cgi - 64) & 15); unsigned z0 = 0u; asm volatile("" : "+v"(z0)); const v4u z = {z0, z0, z0, z0};
#pragma unroll
                for (int tt = 0; tt < 16; ++tt) { const int t = t0 + tt;
                    if (cgi < 80) *(LAS v4u*)(lds + SL_BN + t * SL_N_ROW + n0 * 2) = z;
                    else { *(LAS v4u*)(lds + SL_CN + t * SL_N_ROW + n0 * 2) = z; *(v4u*)((bf16*)(ws + WS_CB) + ((size_t)su.cid * 64 + t) * 256 + su.g * 128 + n0) = z; } }
            }
        }
        if (cgi < 80) {
            LAS unsigned char* tb_ = cgi < 64 ? lds + SL_XT + (cgi >> 3) * SL_XT_HEAD + (8 * (cgi & 7)) * SL_XT_ROW + t0 * 2 : lds + SL_BT + (8 * (cgi - 64)) * SL_BT_ROW + t0 * 2;
#pragma unroll
            for (int e = 0; e < 8; ++e) { const v4u a = {ow[e][0], ow[e][1], ow[e][2], ow[e][3]}, b = {ow[e][4], ow[e][5], ow[e][6], ow[e][7]};
                *(LAS v4u*)(tb_ + e * SL_XT_ROW) = a; *(LAS v4u*)(tb_ + e * SL_XT_ROW + 16) = b; }
        }
    }
    {
        const int h = 8 * su.g + wid;
        const float dt = lane < su.T ? DT[(size_t)(su.rbase + lane) * 16 + h] : 0.f;
        const float a = -__expf(A.in[I_ALOG][h]);
        float x = dt * a;
#pragma unroll
        for (int off = 1; off < 64; off <<= 1) { const float v = __shfl_up(x, off); if (lane >= off) x += v; }
        const float tot = __shfl(x, 63);
        LAS float* dl = (LAS float*)(lds + SL_DT) + wid * 64; LAS float* al = (LAS float*)(lds + SL_AC) + wid * 64; LAS float* wl = (LAS float*)(lds + SL_W) + wid * 64;
        dl[lane] = dt; al[lane] = x; wl[lane] = __expf(tot - x) * dt;
        ((float*)(ws + WS_ACUM))[((size_t)su.cid * 16 + h) * 64 + lane] = x;
        if (lane == 63) ((float*)(ws + WS_CD))[su.cid * 16 + h] = __expf(tot);
    }
    __syncthreads();
    {
        const int h = 8 * su.g + wid;
        const float dskip = A.in[I_DSKIP][h];
        const LAS unsigned char* bn = lds + SL_BN; const LAS unsigned char* cn = lds + SL_CN; const LAS unsigned char* bt = lds + SL_BT;
        const LAS unsigned char* xt = lds + SL_XT + wid * SL_XT_HEAD;
        const LAS float* dl = (const LAS float*)(lds + SL_DT) + wid * 64; const LAS float* al = (const LAS float*)(lds + SL_AC) + wid * 64; const LAS float* wl = (const LAS float*)(lds + SL_W) + wid * 64;
        f32x16 cb00 = {}, cb01 = {}, cb11 = {};
#pragma unroll
        for (int ks = 0; ks < 8; ++ks) {
            const int kb = (16 * ks + 8 * hi) * 2;
            const bf16x8 b0 = *(const LAS bf16x8*)(bn + r32 * SL_N_ROW + kb), b1 = *(const LAS bf16x8*)(bn + (32 + r32) * SL_N_ROW + kb);
            const bf16x8 c0 = *(const LAS bf16x8*)(cn + r32 * SL_N_ROW + kb), c1 = *(const LAS bf16x8*)(cn + (32 + r32) * SL_N_ROW + kb);
            cb00 = MFMA32(b0, c0, cb00); cb01 = MFMA32(b0, c1, cb01); cb11 = MFMA32(b1, c1, cb11);
        }
        const float at0 = al[r32], at1 = al[32 + r32];
        bf16x8 X00[2], X01[2], X11[2];
        {
            float m00[16], m01[16], m11[16];
#pragma unroll
            for (int r = 0; r < 16; ++r) {
                const int s0 = crow(r, hi), s1 = 32 + s0;
                const float as0 = al[s0], as1 = al[s1], ds0 = dl[s0], ds1 = dl[s1];
                float v = (s0 <= r32) ? cb00[r] * __expf(at0 - as0) * ds0 : 0.f; if (s0 == r32) v += dskip; m00[r] = v;
                m01[r] = cb01[r] * __expf(at1 - as0) * ds0;
                v = (s0 <= r32) ? cb11[r] * __expf(at1 - as1) * ds1 : 0.f; if (s0 == r32) v += dskip; m11[r] = v;
            }
#pragma unroll
            for (int sp = 0; sp < 2; ++sp) {
                v4u w;
                w.x = pk2(m00[8 * sp + 0], m00[8 * sp + 1]); w.y = pk2(m00[8 * sp + 2], m00[8 * sp + 3]); w.z = pk2(m00[8 * sp + 4], m00[8 * sp + 5]); w.w = pk2(m00[8 * sp + 6], m00[8 * sp + 7]); X00[sp] = __builtin_bit_cast(bf16x8, w);
                w.x = pk2(m01[8 * sp + 0], m01[8 * sp + 1]); w.y = pk2(m01[8 * sp + 2], m01[8 * sp + 3]); w.z = pk2(m01[8 * sp + 4], m01[8 * sp + 5]); w.w = pk2(m01[8 * sp + 6], m01[8 * sp + 7]); X01[sp] = __builtin_bit_cast(bf16x8, w);
                w.x = pk2(m11[8 * sp + 0], m11[8 * sp + 1]); w.y = pk2(m11[8 * sp + 2], m11[8 * sp + 3]); w.z = pk2(m11[8 * sp + 4], m11[8 * sp + 5]); w.w = pk2(m11[8 * sp + 6], m11[8 * sp + 7]); X11[sp] = __builtin_bit_cast(bf16x8, w);
            }
        }
        unsigned* yp = (unsigned*)(ws + WS_YP) + ((size_t)su.cid * 16 + h) * 2048 + lane;
#pragma unroll
        for (int pi = 0; pi < 2; ++pi) {
            f32x16 y0 = {}, y1 = {};
#pragma unroll
            for (int i = 0; i < 2; ++i)
#pragma unroll
                for (int sp = 0; sp < 2; ++sp) {
                    const LAS unsigned char* ap = xt + (32 * pi + r32) * SL_XT_ROW + (32 * i + 16 * sp + 4 * hi) * 2;
                    const v2u lo = *(const LAS v2u*)ap, hh = *(const LAS v2u*)(ap + 16);
                    const v4u aw = {lo.x, lo.y, hh.x, hh.y}; const bf16x8 af = __builtin_bit_cast(bf16x8, aw);
                    if (i == 0) { y0 = MFMA32(af, X00[sp], y0); y1 = MFMA32(af, X01[sp], y1); }
                    else y1 = MFMA32(af, X11[sp], y1);
                }
#pragma unroll
            for (int r = 0; r < 16; r += 2) { yp[((pi * 2 + 0) * 8 + (r >> 1)) * 64] = pk2(y0[r], y0[r + 1]); yp[((pi * 2 + 1) * 8 + (r >> 1)) * 64] = pk2(y1[r], y1[r + 1]); }
        }
        bf16* sch = (bf16*)(ws + WS_SCH) + ((size_t)su.cid * 16 + h) * 8192;
#pragma unroll
        for (int pi = 0; pi < 2; ++pi) {
            f32x16 s0 = {}, s1 = {}, s2 = {}, s3 = {};
#pragma unroll
            for (int ks = 0; ks < 4; ++ks) {
                const int sb = 16 * ks + 8 * hi;
                const v4u raw = *(const LAS v4u*)(xt + (32 * pi + r32) * SL_XT_ROW + sb * 2);
                const f32x4 wa = *(const LAS f32x4*)(wl + sb), wb = *(const LAS f32x4*)(wl + sb + 4);
                v4u aw; aw.x = pk2(bflo(raw.x) * wa[0], bfhi(raw.x) * wa[1]); aw.y = pk2(bflo(raw.y) * wa[2], bfhi(raw.y) * wa[3]);
                aw.z = pk2(bflo(raw.z) * wb[0], bfhi(raw.z) * wb[1]); aw.w = pk2(bflo(raw.w) * wb[2], bfhi(raw.w) * wb[3]);
                const bf16x8 xf = __builtin_bit_cast(bf16x8, aw);
                const bf16x8 q0 = *(const LAS bf16x8*)(bt + (0 + r32) * SL_BT_ROW + sb * 2), q1 = *(const LAS bf16x8*)(bt + (32 + r32) * SL_BT_ROW + sb * 2);
                const bf16x8 q2 = *(const LAS bf16x8*)(bt + (64 + r32) * SL_BT_ROW + sb * 2), q3 = *(const LAS bf16x8*)(bt + (96 + r32) * SL_BT_ROW + sb * 2);
                s0 = MFMA32(q0, xf, s0); s1 = MFMA32(q1, xf, s1); s2 = MFMA32(q2, xf, s2); s3 = MFMA32(q3, xf, s3);
            }
            bf16* orow = sch + (size_t)(32 * pi + r32) * 128 + 4 * hi;
#pragma unroll
            for (int q = 0; q < 4; ++q) {
                v2u w;
                w.x = pk2(s0[4 * q], s0[4 * q + 1]); w.y = pk2(s0[4 * q + 2], s0[4 * q + 3]); *(v2u*)(orow + 0 + 8 * q) = w;
                w.x = pk2(s1[4 * q], s1[4 * q + 1]); w.y = pk2(s1[4 * q + 2], s1[4 * q + 3]); *(v2u*)(orow + 32 + 8 * q) = w;
                w.x = pk2(s2[4 * q], s2[4 * q + 1]); w.y = pk2(s2[4 * q + 2], s2[4 * q + 3]); *(v2u*)(orow + 64 + 8 * q) = w;
                w.x = pk2(s3[4 * q], s3[4 * q + 1]); w.y = pk2(s3[4 * q + 2], s3[4 * q + 3]); *(v2u*)(orow + 96 + 8 * q) = w;
            }
        }
    }
    __syncthreads();
}

__device__ __forceinline__ void ssd_scan(const Args& A, int item, int tid) {
    unsigned char* ws = A.ws;
    const int e4 = item * 2048 + 4 * tid, h = __builtin_amdgcn_readfirstlane(e4 >> 13);
    const v2u* SCH = (const v2u*)(ws + WS_SCH) + (e4 >> 2); const float* CD = (const float*)(ws + WS_CD) + h; v2u* HP = (v2u*)(ws + WS_HPREV) + (e4 >> 2);
    float st0 = 0.f, st1 = 0.f, st2 = 0.f, st3 = 0.f;
    for (int c0 = 0; c0 < 128; c0 += 32) {
        v2u sv[32]; float d[32];
#pragma unroll
        for (int k = 0; k < 32; ++k) { sv[k] = SCH[(size_t)(c0 + k) * 32768]; d[k] = CD[(c0 + k) * 16]; }
#pragma unroll
        for (int k = 0; k < 32; ++k) { v2u o; o.x = pk2(st0, st1); o.y = pk2(st2, st3); HP[(size_t)(c0 + k) * 32768] = o;
            st0 = d[k] * st0 + bflo(sv[k].x); st1 = d[k] * st1 + bfhi(sv[k].x); st2 = d[k] * st2 + bflo(sv[k].y); st3 = d[k] * st3 + bfhi(sv[k].y); }
    }
    { f32x4 o = {st0, st1, st2, st3}; *(f32x4*)(A.out + O_SP + e4) = o; }
    for (int b0 = 0; b0 < 32; b0 += 16) {
        v2u sv[16]; float d[16]; f32x4 h0[16];
#pragma unroll
        for (int k = 0; k < 16; ++k) { sv[k] = SCH[(size_t)(128 + b0 + k) * 32768]; d[k] = CD[(128 + b0 + k) * 16]; h0[k] = *(const f32x4*)(A.in[I_SSM] + (size_t)(b0 + k) * 131072 + e4); }
#pragma unroll
        for (int k = 0; k < 16; ++k) { v2u o; o.x = pk2(h0[k][0], h0[k][1]); o.y = pk2(h0[k][2], h0[k][3]); HP[(size_t)(128 + b0 + k) * 32768] = o;
            f32x4 r = {d[k] * h0[k][0] + bflo(sv[k].x), d[k] * h0[k][1] + bfhi(sv[k].x), d[k] * h0[k][2] + bflo(sv[k].y), d[k] * h0[k][3] + bfhi(sv[k].y)};
            *(f32x4*)(A.out + O_SS + (size_t)(b0 + k) * 131072 + e4) = r; }
    }
}

__device__ __forceinline__ void ssd_out(const Args& A, LAS unsigned char* lds, int u) {
    const SsdUnit su = ssd_unit(u);
    int tid_ = threadIdx.x; asm volatile("" : "+v"(tid_));
    const int tid = tid_, lane = tid & 63, wid = __builtin_amdgcn_readfirstlane(tid >> 6), r32 = lane & 31, hi = lane >> 5;
    unsigned char* ws = A.ws;
    const int h = 8 * su.g + wid;
    const bf16* HP = (const bf16*)(ws + WS_HPREV) + ((size_t)su.cid * 16 + h) * 8192;
    const bf16* CB = (const bf16*)(ws + WS_CB) + (size_t)su.cid * 64 * 256 + su.g * 128;
    const float* acum = (const float*)(ws + WS_ACUM) + ((size_t)su.cid * 16 + h) * 64;
    const unsigned* yp = (const unsigned*)(ws + WS_YP) + ((size_t)su.cid * 16 + h) * 2048 + lane;
    const bf16* Z = (const bf16*)(ws + WS_Z);
    float ac_[2]; v2u zz_[2][2][4]; unsigned ya_[2][2][4], yb_[2][2][4]; f32x4 gg_[2][4];
    { const float* gn0 = A.in[I_GSSM] + 512 * su.g + 64 * wid + 4 * hi;
#pragma unroll
      for (int pi = 0; pi < 2; ++pi)
#pragma unroll
        for (int q = 0; q < 4; ++q) gg_[pi][q] = *(const f32x4*)(gn0 + 32 * pi + 8 * q); }
#pragma unroll
    for (int j = 0; j < 2; ++j) {
        const int t = 32 * j + r32;
        ac_[j] = acum[t];
        const bf16* zr = Z + (size_t)(su.rbase + (t < su.T ? t : 0)) * 1024 + 512 * su.g + 64 * wid;
#pragma unroll
        for (int pi = 0; pi < 2; ++pi)
#pragma unroll
            for (int q = 0; q < 4; ++q) { zz_[j][pi][q] = *(const v2u*)(zr + 32 * pi + 8 * q + 4 * hi);
                ya_[j][pi][q] = yp[((pi * 2 + j) * 8 + 2 * q + 0) * 64]; yb_[j][pi][q] = yp[((pi * 2 + j) * 8 + 2 * q + 1) * 64]; }
    }
    f32x16 acc[2][2] = {};
#pragma unroll
    for (int kh = 0; kh < 2; ++kh) {
        bf16x8 fa0[4], fa1[4], fb0[4], fb1[4];
#pragma unroll
        for (int k = 0; k < 4; ++k) { const int kb = 16 * (4 * kh + k) + 8 * hi;
            fa0[k] = *(const bf16x8*)(HP + (size_t)r32 * 128 + kb); fa1[k] = *(const bf16x8*)(HP + (size_t)(32 + r32) * 128 + kb);
            fb0[k] = *(const bf16x8*)(CB + (size_t)r32 * 256 + kb); fb1[k] = *(const bf16x8*)(CB + (size_t)(32 + r32) * 256 + kb); }
#pragma unroll
        for (int k = 0; k < 4; ++k) { acc[0][0] = MFMA32(fa0[k], fb0[k], acc[0][0]); acc[0][1] = MFMA32(fa0[k], fb1[k], acc[0][1]); acc[1][0] = MFMA32(fa1[k], fb0[k], acc[1][0]); acc[1][1] = MFMA32(fa1[k], fb1[k], acc[1][1]); }
    }
    float ssq[2] = {0.f, 0.f};
#pragma unroll
    for (int j = 0; j < 2; ++j) {
        const float ea = __expf(ac_[j]);
#pragma unroll
        for (int pi = 0; pi < 2; ++pi)
#pragma unroll
            for (int q = 0; q < 4; ++q) {
                const v2u zz = zz_[j][pi][q];
                const float z0 = bflo(zz.x), z1 = bfhi(zz.x), z2 = bflo(zz.y), z3 = bfhi(zz.y);
                const unsigned ya = ya_[j][pi][q], yb = yb_[j][pi][q];
                float y;
                y = (bflo(ya) + ea * acc[pi][j][4 * q + 0]) * siluf(z0); acc[pi][j][4 * q + 0] = y; ssq[j] += y * y;
                y = (bfhi(ya) + ea * acc[pi][j][4 * q + 1]) * siluf(z1); acc[pi][j][4 * q + 1] = y; ssq[j] += y * y;
                y = (bflo(yb) + ea * acc[pi][j][4 * q + 2]) * siluf(z2); acc[pi][j][4 * q + 2] = y; ssq[j] += y * y;
                y = (bfhi(yb) + ea * acc[pi][j][4 * q + 3]) * siluf(z3); acc[pi][j][4 * q + 3] = y; ssq[j] += y * y;
            }
        ssq[j] += __shfl_xor(ssq[j], 32);
    }
    LAS float* red = (LAS float*)lds;
    if (hi == 0) { red[wid * 64 + r32] = ssq[0]; red[wid * 64 + 32 + r32] = ssq[1]; }
    __syncthreads();
    bf16* A2 = (bf16*)(ws + WS_A2);
#pragma unroll
    for (int j = 0; j < 2; ++j) {
        const int t = 32 * j + r32;
        float tot = 0.f;
#pragma unroll
        for (int w = 0; w < 8; ++w) tot += red[w * 64 + t];
        const float rstd = 1.0f / sqrtf(tot * (1.0f / 512.f) + EPS);
        if (t < su.T) {
            bf16* orow = A2 + (size_t)(su.rbase + t) * 2048 + 1024 + 512 * su.g + 64 * wid;
#pragma unroll
            for (int pi = 0; pi < 2; ++pi)
#pragma unroll
                for (int q = 0; q < 4; ++q) {
                    const int p = 32 * pi + 8 * q + 4 * hi;
                    const f32x4 gg = gg_[pi][q];
                    v2u w; w.x = pk2(acc[pi][j][4 * q + 0] * rstd * gg[0], acc[pi][j][4 * q + 1] * rstd * gg[1]); w.y = pk2(acc[pi][j][4 * q + 2] * rstd * gg[2], acc[pi][j][4 * q + 3] * rstd * gg[3]);
                    *(v2u*)(orow + p) = w;
                }
        }
    }
    __syncthreads();
}

namespace att {
constexpr int KVBLK = 64;
constexpr int SHM_V = 64 * 128 * 2, SHM_K = 64 * 128 * 2;
constexpr int NSLOT = 3;
constexpr int L_V = 0, L_K = NSLOT * SHM_V, L_WS = L_K + NSLOT * SHM_K, L_EX = 0  , L_END = L_WS + NWAVES * 128 * 4;
static_assert(4 * 16384 <= L_WS, "exchange slots fit under the rings");
static_assert(L_END <= LDSCTL_OFF, "attn lds");
constexpr float THR = 6.f;
#define KSWZ(row, colB) ((row) * 256 + ((colB) ^ (((row) & 15) << 4)))
#define SBAR() __builtin_amdgcn_sched_barrier(0)
__device__ __forceinline__ unsigned cvtpk(float lo, float hi) { return pg8::cvt_pk_bf16(lo, hi); }
template <typename TIn> struct Stage;
template <> struct Stage<bf16>  { using T = bf16x8;
  __device__ static __forceinline__ T ld8(const bf16* p) { return *reinterpret_cast<const bf16x8*>(p); }
  __device__ static __forceinline__ bf16x8 tobf(T x) { return x; } };
template <> struct Stage<float> { using T = f32x8;
  __device__ static __forceinline__ T ld8(const float* p) { return *reinterpret_cast<const f32x8*>(p); }
  __device__ static __forceinline__ bf16x8 tobf(T x) {
    v4u w = {cvtpk(x[0], x[1]), cvtpk(x[2], x[3]), cvtpk(x[4], x[5]), cvtpk(x[6], x[7])}; return __builtin_bit_cast(bf16x8, w); } };

__device__ __forceinline__ void partialSM(f32x16& p0, f32x16& p1, float& m_reg, float& mn, float& alpha, float base, float c32) {
  float pm0 = p0[0]; for (int r = 1; r < 16; ++r) pm0 = fmaxf(pm0, p0[r]);
  float pm1 = p1[0]; for (int r = 1; r < 16; ++r) pm1 = fmaxf(pm1, p1[r]);
  float pmax = fmaxf(pm0, pm1 + c32) + base;
  { auto rr = __builtin_amdgcn_permlane32_swap(__float_as_uint(pmax), __float_as_uint(pmax), false, false);
    pmax = fmaxf(__uint_as_float(rr[0]), __uint_as_float(rr[1])); }
  if (__builtin_expect(__all(pmax - m_reg <= THR), 1)) { mn = m_reg; alpha = 1.f; }
  else { mn = fmaxf(m_reg, pmax); alpha = __builtin_amdgcn_exp2f(m_reg - mn); m_reg = mn; }
  const float off0 = base - mn, off1 = off0 + c32;
  for (int r = 0; r < 16; ++r) p0[r] = __builtin_amdgcn_exp2f(p0[r] + off0);
  for (int r = 0; r < 16; ++r) p1[r] = p1[r] + off1;
}
__device__ __forceinline__ void finishSM(f32x16& p0, f32x16& p1, float alpha, float& l_reg, bf16x8& pa0, bf16x8& pa1, bf16x8& pa2, bf16x8& pa3) {
  for (int r = 0; r < 16; ++r) p1[r] = __builtin_amdgcn_exp2f(p1[r]);
  float ps = 0; for (int r = 0; r < 16; ++r) ps += p0[r]; for (int r = 0; r < 16; ++r) ps += p1[r];
  { auto rr = __builtin_amdgcn_permlane32_swap(__float_as_uint(ps), __float_as_uint(ps), false, false);
    ps = __uint_as_float(rr[0]) + __uint_as_float(rr[1]); }
  l_reg = l_reg * alpha + ps;
#define PK4(P, BASE, OUT) do { unsigned a0 = cvtpk(P[BASE + 0], P[BASE + 1]), a1 = cvtpk(P[BASE + 2], P[BASE + 3]);   \
    unsigned b0 = cvtpk(P[BASE + 4], P[BASE + 5]), b1 = cvtpk(P[BASE + 6], P[BASE + 7]);                              \
    auto r0 = __builtin_amdgcn_permlane32_swap(a0, b0, false, false); auto r1 = __builtin_amdgcn_permlane32_swap(a1, b1, false, false); \
    v4u w = {r0[0], r1[0], r0[1], r1[1]}; OUT = __builtin_bit_cast(bf16x8, w); } while (0)
  PK4(p0, 0, pa0); PK4(p0, 8, pa1); PK4(p1, 0, pa2); PK4(p1, 8, pa3);
#undef PK4
}
__device__ __forceinline__ void qkt(f32x16& p0, f32x16& p1, const char* Ks, const bf16x8* qr, const float* kc, int r32, int hi, int mapoff) {
  { const f32x4 k0 = *(const f32x4*)kc, k1 = *(const f32x4*)(kc + 4), k2 = *(const f32x4*)(kc + 8), k3 = *(const f32x4*)(kc + 12);
    p0 = (f32x16){k0[0], k0[1], k0[2], k0[3], k1[0], k1[1], k1[2], k1[3], k2[0], k2[1], k2[2], k2[3], k3[0], k3[1], k3[2], k3[3]}; p1 = p0; }
  bf16x8 bk[8];
#pragma unroll
  for (int d0 = 0; d0 < 4; ++d0) { const int cb = (mapoff + d0 * 16 + hi * 8) * 2;
    bk[2 * d0] = *reinterpret_cast<const bf16x8*>(Ks + KSWZ(r32, cb));
    bk[2 * d0 + 1] = *reinterpret_cast<const bf16x8*>(Ks + KSWZ(32 + r32, cb)); }
  asm volatile("s_waitcnt lgkmcnt(0)" ::: "memory"); SBAR();
#pragma unroll
  for (int d0 = 0; d0 < 4; ++d0) {
    p0 = __builtin_amdgcn_mfma_f32_32x32x16_bf16(bk[2 * d0], qr[d0], p0, 0, 0, 0);
    p1 = __builtin_amdgcn_mfma_f32_32x32x16_bf16(bk[2 * d0 + 1], qr[d0], p1, 0, 0, 0); }
}
__device__ __forceinline__ int v_st(int k, int c) { const int kk = (k & ~0xC) | ((k & 4) << 1) | ((k & 8) >> 1); return ((kk >> 3) * 4 + (c >> 5)) * 512 + ((kk & 7) * 32 + (c & 31)) * 2; }
__device__ __forceinline__ int v_rd_base(int lane) { return ((lane & 3) << 3) | (((lane >> 2) & 3) << 6) | (((lane >> 4) & 1) << 5) | (((lane >> 5) & 1) << 8); }
constexpr int v_rd_off(int d0, int ks, int half) { return d0 * 512 + ks * 4096 + half * 2048; }
template <int OFF> __device__ __forceinline__ s16x4 tr_read(int vb) {
  s16x4 r; asm volatile("ds_read_b64_tr_b16 %0, %1 offset:%2" : "=&v"(r) : "v"(vb), "i"(OFF) : "memory"); return r;
}
template <int D0> __device__ __forceinline__ void pv_one(f32x16& od, int vb, bf16x8 pa0, bf16x8 pa1, bf16x8 pa2, bf16x8 pa3) {
  const s16x4 l0 = tr_read<v_rd_off(D0, 0, 0)>(vb), h0 = tr_read<v_rd_off(D0, 0, 1)>(vb), l1 = tr_read<v_rd_off(D0, 1, 0)>(vb), h1 = tr_read<v_rd_off(D0, 1, 1)>(vb);
  const s16x4 l2 = tr_read<v_rd_off(D0, 2, 0)>(vb), h2 = tr_read<v_rd_off(D0, 2, 1)>(vb), l3 = tr_read<v_rd_off(D0, 3, 0)>(vb), h3 = tr_read<v_rd_off(D0, 3, 1)>(vb);
  asm volatile("s_waitcnt lgkmcnt(0)" ::: "memory"); SBAR();
#define PK(L, H) (bf16x8){L[0], L[1], L[2], L[3], H[0], H[1], H[2], H[3]}
  od = __builtin_amdgcn_mfma_f32_32x32x16_bf16(pa0, PK(l0, h0), od, 0, 0, 0);
  od = __builtin_amdgcn_mfma_f32_32x32x16_bf16(pa1, PK(l1, h1), od, 0, 0, 0);
  od = __builtin_amdgcn_mfma_f32_32x32x16_bf16(pa2, PK(l2, h2), od, 0, 0, 0);
  od = __builtin_amdgcn_mfma_f32_32x32x16_bf16(pa3, PK(l3, h3), od, 0, 0, 0);
#undef PK
}
__device__ __forceinline__ void pv_d0(f32x16* o, int vb, bf16x8 pa0, bf16x8 pa1, bf16x8 pa2, bf16x8 pa3) {
  pv_one<0>(o[0], vb, pa0, pa1, pa2, pa3); pv_one<1>(o[1], vb, pa0, pa1, pa2, pa3); pv_one<2>(o[2], vb, pa0, pa1, pa2, pa3); pv_one<3>(o[3], vb, pa0, pa1, pa2, pa3);
}

struct SrcPrompt {
  const bf16* Kh; const bf16* Vh;
  __device__ __forceinline__ const bf16* kp(int t) const { return Kh + (size_t)t * 64 * 1024; }
  __device__ __forceinline__ const bf16* vp(int t) const { return Vh + (size_t)t * 64 * 1024; }
  __device__ __forceinline__ int nvalid(int) const { return 64; }
};
struct SrcSample {
  const float* Kc; const float* Vc; const float* Kn; const float* Vn;
  __device__ __forceinline__ const float* kp(int t) const { return t < 16 ? Kc + (size_t)t * 64 * 1024 : Kn; }
  __device__ __forceinline__ const float* vp(int t) const { return t < 16 ? Vc + (size_t)t * 64 * 1024 : Vn; }
  __device__ __forceinline__ int nvalid(int t) const { return t < 16 ? 64 : 16; }
};

template <typename TKV, int SD, int nvd, bool FIX, class Src>
__device__ __forceinline__ void attn_core(f32x16 (&o)[4], const bf16* qrow, float qposf, float c, int cq, int t0, int NT, const Src& src, char* lds, LAS unsigned char* lds3, int mapoff, float kmaxn) {
  using St = Stage<TKV>;
  int tid_ = threadIdx.x; asm volatile("" : "+v"(tid_));
  const int tid = tid_, wid = tid >> 6, lane = tid & 63, r32 = lane & 31, hi = lane >> 5;
  char* V_lds = lds + L_V; char* K_lds = lds + L_K;
  float* wsf = (float*)(lds + L_WS) + wid * 128; float* li_l = wsf; float* al_l = wsf + 32; float* kc = wsf + 64;
  float m_reg = -1e30f, l_reg = 0; bf16x8 qr[4];
#pragma unroll
  for (int d = 0; d < 4; ++d) o[d] = f32x16{};
#pragma unroll
  for (int d0 = 0; d0 < 4; ++d0) qr[d0] = *reinterpret_cast<const bf16x8*>(qrow + d0 * 16);
  if (lane < 16) kc[lane] = c * (float)((lane & 3) + 8 * (lane >> 2));
  asm volatile("s_waitcnt lgkmcnt(0)" ::: "memory");
  const float c32 = 32.f * c, c2 = 2.f * c;
  const float qrel = (float)(4 * hi) - qposf;
  const int sr = tid >> 4, sc = (tid & 15) * 8, vst0 = v_st(sr, sc), kst0 = KSWZ(sr, sc * 2);
  const int vb0 = (int)(uintptr_t)V_lds + v_rd_base(lane);
  struct { typename St::T vs0, vs1, ks0, ks1; } sr_[SD];
#define SLOAD(i, t) do { const int nv_ = src.nvalid(t); const int r0_ = sr < nv_ ? sr : nv_ - 1, r1_ = 32 + sr < nv_ ? 32 + sr : nv_ - 1; \
    const TKV* kp_ = src.kp(t); const TKV* vp_ = src.vp(t); \
    sr_[i].vs0 = St::ld8(vp_ + (size_t)r0_ * 1024 + sc); sr_[i].vs1 = St::ld8(vp_ + (size_t)r1_ * 1024 + sc); \
    sr_[i].ks0 = St::ld8(kp_ + (size_t)r0_ * 1024 + sc); sr_[i].ks1 = St::ld8(kp_ + (size_t)r1_ * 1024 + sc); } while (0)
#define SWRITE(b, i) do { *(bf16x8*)(V_lds + (b) * SHM_V + vst0) = St::tobf(sr_[i].vs0);          \
    *(bf16x8*)(V_lds + (b) * SHM_V + vst0 + 8192) = St::tobf(sr_[i].vs1);               \
    *(bf16x8*)(K_lds + (b) * SHM_K + kst0) = St::tobf(sr_[i].ks0);                       \
    *(bf16x8*)(K_lds + (b) * SHM_K + kst0 + 8192) = St::tobf(sr_[i].ks1); } while (0)
#define SWRITE3(off, i) do { *(bf16x8*)(V_lds + (off) + vst0) = St::tobf(sr_[i].vs0);          \
    *(bf16x8*)(V_lds + (off) + vst0 + 8192) = St::tobf(sr_[i].vs1);               \
    *(bf16x8*)(K_lds + (off) + kst0) = St::tobf(sr_[i].ks0);                       \
    *(bf16x8*)(K_lds + (off) + kst0 + 8192) = St::tobf(sr_[i].ks1); } while (0)
#define SWAIT() do { if constexpr (SD == 2) asm volatile("s_waitcnt vmcnt(4)" ::: "memory"); else asm volatile("s_waitcnt vmcnt(0)" ::: "memory"); } while (0)
#define RESC(a) do { if (__any((a) < 1.f)) { int tl_ = threadIdx.x; asm volatile("" : "+v"(tl_)); const int hi_ = (tl_ >> 5) & 1; if (hi_ == 0) al_l[tl_ & 31] = (a); asm volatile("s_waitcnt lgkmcnt(0)" ::: "memory"); \
    for (int d = 0; d < 4; ++d) for (int r = 0; r < 16; ++r) o[d][r] *= al_l[crow(r, hi_)]; } } while (0)
#define POST(P0, P1, t) do { if ((t) == cq) { const float d0_ = (float)(64 * (t)) + qrel; \
      for (int r = 0; r < 16; ++r) { const float d_ = d0_ + (float)((r & 3) + 8 * (r >> 2)); P0[r] -= c2 * fmaxf(d_, 0.f); P1[r] -= c2 * fmaxf(d_ + 32.f, 0.f); } \
      if (nvd < 64) { for (int r = 0; r < 16; ++r) { const int kk_ = crow(r, hi); if (kk_ >= nvd) P0[r] = -1e30f; if (kk_ + 32 >= nvd) P1[r] = -1e30f; } } } } while (0)
#define BASE(t) ((t) > cq ? -1e30f : c * ((float)(64 * (t)) + qrel))
  if constexpr (SD == 2) {
  f32x16 p0, p1; float mn, al; bf16x8 pa0, pa1, pa2, pa3;
  SLOAD(0, t0); SLOAD(1, t0 + 1); SWRITE(0, 0); __syncthreads();
#define STEP1(t, bsel, nset, cset, havenext, haveload) do { \
    if (haveload) SLOAD(cset, (t) + 2); \
    SBAR(); qkt(p0, p1, K_lds + (bsel) * SHM_K, qr, kc, r32, hi, mapoff); POST(p0, p1, t); \
    partialSM(p0, p1, m_reg, mn, al, BASE(t), c32); RESC(al); \
    finishSM(p0, p1, al, l_reg, pa0, pa1, pa2, pa3); SBAR(); \
    pv_d0(o, vb0 + (bsel) * SHM_V, pa0, pa1, pa2, pa3); \
    if (havenext) { SWRITE((bsel) ^ 1, nset); } \
    __syncthreads(); } while (0)
  for (int t = t0; t < NT; t += 2) {
    STEP1(t, 0, 1, 0, true, t + 2 < NT);
    STEP1(t + 1, 1, 0, 1, t + 2 < NT, t + 3 < NT);
  }
#undef STEP1
  } else {
  f32x16 C0, C1; float mn = 0.f, al = 1.f; bf16x8 pa0, pa1, pa2, pa3;
  const int n_ = NT - t0;
  unsigned ksrc0, vsrc0;
  { const int L = tid * 16;
    { const int row = L >> 8, csw = (L >> 4) & 15; ksrc0 = (unsigned)(row * 1024 + ((csw ^ (row & 15)) * 8)) * 2u; }
    { const int st = L >> 9, within = (L & 511) >> 1, kk = (st >> 2) * 8 + (within >> 5), cc = (st & 3) * 32 + (within & 31), k = (kk & ~0xC) | ((kk & 4) << 1) | ((kk & 8) >> 1); vsrc0 = (unsigned)(k * 1024 + cc) * 2u; } }
  const unsigned ldsb = (unsigned)__builtin_amdgcn_readfirstlane((int)((unsigned)(uintptr_t)lds3 + (unsigned)wid * 1024u));
#define GLDS16(gp, la) do { unsigned sv_; asm volatile("s_mov_b32 %0, m0\n\ts_mov_b32 m0, %2\n\ts_nop 0\n\tglobal_load_lds_dwordx4 %1, off\n\ts_mov_b32 m0, %0" : "=&s"(sv_) : "v"(gp), "s"(la) : "memory"); } while (0)
#define DMA_K(off, t) do { const char* kp_ = (const char*)src.kp(t) + ksrc0; GLDS16(kp_, ldsb + (unsigned)(L_K + (off))); GLDS16(kp_ + 65536, ldsb + (unsigned)(L_K + 8192 + (off))); } while (0)
#define DMA_V(off, t) do { const char* vp_ = (const char*)src.vp(t) + vsrc0; GLDS16(vp_, ldsb + (unsigned)(L_V + (off))); GLDS16(vp_ + 65536, ldsb + (unsigned)(L_V + 8192 + (off))); } while (0)
#define WAIT_BAR(N) asm volatile("s_waitcnt vmcnt(" #N ") lgkmcnt(0)\n\ts_barrier" ::: "memory")
  float mref = 0.f;
  if constexpr (FIX) {
    float q2 = 0.f;
#pragma unroll
    for (int d0 = 0; d0 < 4; ++d0) { const v4u w = __builtin_bit_cast(v4u, qr[d0]);
      q2 += bflo(w.x) * bflo(w.x) + bfhi(w.x) * bfhi(w.x) + bflo(w.y) * bflo(w.y) + bfhi(w.y) * bfhi(w.y) + bflo(w.z) * bflo(w.z) + bfhi(w.z) * bfhi(w.z) + bflo(w.w) * bflo(w.w) + bfhi(w.w) * bfhi(w.w); }
    { auto rr = __builtin_amdgcn_permlane32_swap(__float_as_uint(q2), __float_as_uint(q2), false, false); q2 = __uint_as_float(rr[0]) + __uint_as_float(rr[1]); }
    mref = 1.02f * sqrtf(q2) * kmaxn + 0.5f;
  }
#define SOFTMAX(t_) do { POST(C0, C1, t_); \
    if constexpr (FIX) { const float off0_ = BASE(t_) - mref, off1_ = off0_ + c32; \
      for (int r = 0; r < 16; ++r) C0[r] = __builtin_amdgcn_exp2f(C0[r] + off0_); for (int r = 0; r < 16; ++r) C1[r] = C1[r] + off1_; } \
    else { partialSM(C0, C1, m_reg, mn, al, BASE(t_), c32); RESC(al); } \
    finishSM(C0, C1, al, l_reg, pa0, pa1, pa2, pa3); } while (0)
  int s_prev = 32768, s_cur = 0, s_next = 16384;
#define ROT3() do { s_prev = s_cur; s_cur = s_next; s_next = s_next == 32768 ? 0 : s_next + 16384; asm volatile("" : "+s"(s_prev), "+s"(s_cur), "+s"(s_next)); } while (0)
#define ISSUE(i_) do { if ((i_) + 2 < n_) { DMA_K(s_prev, t0 + (i_) + 2); } if ((i_) + 1 < n_) { DMA_V(s_next, t0 + (i_) + 1); } } while (0)
#define ENDW(i_) do { if ((i_) + 2 < n_) { WAIT_BAR(4); } else if ((i_) + 1 < n_) { WAIT_BAR(2); } else { WAIT_BAR(0); } } while (0)
  DMA_K(0, t0); DMA_K(16384, t0 + 1); DMA_V(0, t0); ISSUE(0);
  if (2 < n_) { WAIT_BAR(8); } else { WAIT_BAR(6); }
  if (wid < 4) {
    qkt(C0, C1, K_lds, qr, kc, r32, hi, mapoff); SOFTMAX(t0); SBAR();
    ENDW(0); ROT3();
    for (int i = 1; i < n_; ++i) { const int t_ = t0 + i;
      ISSUE(i);
      SBAR(); qkt(C0, C1, K_lds + s_cur, qr, kc, r32, hi, mapoff);
      pv_d0(o, vb0 + s_prev, pa0, pa1, pa2, pa3); SBAR();
      SOFTMAX(t_); SBAR();
      ENDW(i); ROT3(); }
    pv_d0(o, vb0 + s_prev, pa0, pa1, pa2, pa3);
  } else {
    qkt(C0, C1, K_lds, qr, kc, r32, hi, mapoff); SBAR();
    ENDW(0); ROT3();
    for (int i = 1; i < n_; ++i) { const int t_ = t0 + i;
      ISSUE(i);
      SBAR(); SOFTMAX(t_ - 1); SBAR();
      pv_d0(o, vb0 + s_prev, pa0, pa1, pa2, pa3);
      qkt(C0, C1, K_lds + s_cur, qr, kc, r32, hi, mapoff); SBAR();
      ENDW(i); ROT3(); }
    SOFTMAX(t0 + n_ - 1); SBAR();
    pv_d0(o, vb0 + s_prev, pa0, pa1, pa2, pa3);
  }
#undef ISSUE
#undef ENDW
#undef SOFTMAX
#undef ROT3
#undef GLDS16
#undef DMA_K
#undef DMA_V
#undef WAIT_BAR
  }
  { int tl_ = threadIdx.x; asm volatile("" : "+v"(tl_)); const int hi_ = (tl_ >> 5) & 1;
  if (hi_ == 0) li_l[tl_ & 31] = l_reg; asm volatile("s_waitcnt lgkmcnt(0)" ::: "memory");
#pragma unroll
  for (int r = 0; r < 16; ++r) { const float rl = __builtin_amdgcn_rcpf(li_l[crow(r, hi_)]);
#pragma unroll
    for (int d = 0; d < 4; ++d) o[d][r] *= rl; } }
#undef SLOAD
#undef SWRITE
#undef SWRITE3
#undef SWAIT
#undef RESC
#undef POST
#undef BASE
}

__device__ __forceinline__ void attn_finish(f32x16 (&o)[4], float lam, const float* gsub, bf16* A2h, int rowbase, int nrows, bool store, char* lds) {
  int tid_ = threadIdx.x; asm volatile("" : "+v"(tid_));
  const int tid = tid_, wid = tid >> 6, lane = tid & 63, r32 = lane & 31, hi = lane >> 5;
  float* ex = (float*)(lds + L_EX) + (wid & 3) * 4096 + lane;
  __syncthreads();
  if (wid >= 4) {
#pragma unroll
    for (int d = 0; d < 4; ++d)
#pragma unroll
      for (int r = 0; r < 16; ++r) ex[(d * 16 + r) * 64] = lam * o[d][r];
  }
  __syncthreads();
  if (wid < 4) {
    float g[4];
#pragma unroll
    for (int d = 0; d < 4; ++d) g[d] = gsub[32 * d + r32] * (1.0f - LAM_INIT);
#pragma unroll
    for (int r = 0; r < 16; ++r) {
      float ss = 0.f;
#pragma unroll
      for (int d = 0; d < 4; ++d) { const float a = o[d][r] - ex[(d * 16 + r) * 64]; o[d][r] = a; ss += a * a; }
      ss += __shfl_xor(ss, 1); ss += __shfl_xor(ss, 2); ss += __shfl_xor(ss, 4); ss += __shfl_xor(ss, 8); ss += __shfl_xor(ss, 16);
      const float rstd = 1.0f / sqrtf(ss * (1.0f / 128.f) + EPS);
#pragma unroll
      for (int d = 0; d < 4; ++d) o[d][r] *= rstd * g[d];
    }
    unsigned short* stg = (unsigned short*)(lds + L_EX) + (wid & 3) * 8192;
#pragma unroll
    for (int r = 0; r < 16; ++r) {
      const int row = crow(r, hi);
#pragma unroll
      for (int d = 0; d < 4; ++d) stg[row * 136 + 32 * d + r32] = (unsigned short)f2bf(o[d][r]);
    }
    asm volatile("s_waitcnt lgkmcnt(0)" ::: "memory");
    if (store) {
#pragma unroll
      for (int i = 0; i < 8; ++i) {
        const int id = lane + 64 * i, row = id >> 4, c16 = id & 15;
        if (row < nrows) *(v4u*)(A2h + (size_t)(rowbase + row) * 2048 + c16 * 8) = *(const v4u*)(stg + row * 136 + c16 * 8);
      }
    }
  }
  __syncthreads();
}
#undef SBAR
}

constexpr int N_PHASES = 8;
constexpr int NSL5 = 8, NSL9 = 11;
constexpr int N_LAUNCHES = MK_N_LAUNCHES;

__global__ void __launch_bounds__(NWAVES * 64, 2) hymba_fwd(Args args) {
    extern __shared__ __attribute__((aligned(16))) unsigned char lds_raw[];
    LAS unsigned char* lds = (LAS unsigned char*)lds_raw;
    volatile LAS unsigned* MISC = (volatile LAS unsigned*)(lds + LDSCTL_OFF);
    const int tid = threadIdx.x, lane = tid & 63, wave = __builtin_amdgcn_readfirstlane(tid >> 6);
    const int G = gridDim.x; const int bx = blockIdx.x;
    const int vcu = (G % 8 == 0) ? (bx % 8) * (G / 8) + bx / 8 : bx;
    unsigned char* ws = args.ws;
    gu32* ctl = (gu32*)(ws + WS_CTL);
    for (int u = tid; u < (LDS_BYTES - LDSCTL_OFF) / 4; u += NWAVES * 64) ((LAS unsigned*)(lds + LDSCTL_OFF))[u] = 0u;
    __syncthreads();
    XcdBarrier bar; bar.bar = (unsigned*)(ctl + CW_BAR); bar.x = 0; bar.st = nullptr;
    if (N_LAUNCHES == 1) bar = xcd_barrier_post((unsigned*)(ctl + CW_BAR), MISC + 8);
    const int lo = args.ph_lo, hi_ph = args.ph_hi;
#ifndef PHASE_MASK
#define PHASE_MASK 0xff
#endif
#define IN(k) (((PHASE_MASK >> (k)) & 1) && lo <= (k) && (k) < hi_ph)
#ifdef PROBE_PHASE
    unsigned long long pr_a = 0, pr_b = 0;
#define PSTART(k) do { if ((k) == PROBE_PHASE) pr_a = __builtin_amdgcn_s_memrealtime(); } while (0)
#define PEND(k) do { if ((k) == PROBE_PHASE) pr_b = __builtin_amdgcn_s_memrealtime(); } while (0)
#else
#define PSTART(k) do {} while (0)
#define PEND(k) do {} while (0)
#endif
#define SEAM(k) do { if (IN(k) && IN((k) + 1)) xcd_barrier(bar); PEND(k); PSTART((k) + 1); } while (0)

    bf16* WIN = (bf16*)(ws + WS_WIN); bf16* WOUT = (bf16*)(ws + WS_WOUT); bf16* WGU = (bf16*)(ws + WS_WGU); bf16* WDN = (bf16*)(ws + WS_WDN);
    bf16* XN = (bf16*)(ws + WS_XN);

    PSTART(0);
    if (IN(0)) {
        {
            LAS float* scr = (LAS float*)(lds + wave * 16896);
            const int gw = vcu * NWAVES + wave, NGW = G * NWAVES;
            constexpr int NITEM = 32 * 88;
            f32x4 v[16];
            int itn = gw;
            P0Item cur{};
            if (itn < NITEM) { cur = p0_item(args, ws, itn); p0_load(cur, v, lane); }
            while (itn < NITEM) {
                p0_to_lds(cur, v, scr, lane);
                const P0Item done = cur;
                itn += NGW;
                if (itn < NITEM) { cur = p0_item(args, ws, itn); p0_load(cur, v, lane); }
                p0_store(done, scr, lane);
            }
        }
        __syncthreads();
        {
            LAS float* wT = (LAS float*)lds;
            for (int k = tid; k < DM; k += NWAVES * 64) {
                const float* src = args.in[I_WIN] + (size_t)k * DIN + NPROJ;
#pragma unroll
                for (int q = 0; q < 4; ++q) { const f32x4 v = *(const f32x4*)(src + 4 * q); wT[(4 * q + 0) * DM + k] = v[0]; wT[(4 * q + 1) * DM + k] = v[1]; wT[(4 * q + 2) * DM + k] = v[2]; wT[(4 * q + 3) * DM + k] = v[3]; }
            }
            __syncthreads();
            const int gw = vcu * NWAVES + wave, NGW = G * NWAVES;
            const float* gmix = args.in[I_GMIX];
            float* DT = (float*)(ws + WS_DT);
            f32x4 gm[8];
#pragma unroll
            for (int j = 0; j < 8; ++j) gm[j] = *(const f32x4*)(gmix + 4 * lane + 256 * j);
            f32x4 nx[8];
            { const int m = gw; if (m < MT) { const float* xrow = m < MP ? args.in[I_XP] + (size_t)m * DM : args.in[I_XS] + (size_t)(m - MP) * DM;
#pragma unroll
                for (int j = 0; j < 8; ++j) nx[j] = *(const f32x4*)(xrow + 4 * lane + 256 * j); } }
            for (int m = gw; m < MT; m += NGW) {
                f32x4 v[8]; float s = 0.f;
#pragma unroll
                for (int j = 0; j < 8; ++j) { v[j] = nx[j]; s += (v[j][0] * v[j][0] + v[j][1] * v[j][1]) + (v[j][2] * v[j][2] + v[j][3] * v[j][3]); }
                { const int m2 = m + NGW; if (m2 < MT) { const float* xrow = m2 < MP ? args.in[I_XP] + (size_t)m2 * DM : args.in[I_XS] + (size_t)(m2 - MP) * DM;
#pragma unroll
                    for (int j = 0; j < 8; ++j) nx[j] = *(const f32x4*)(xrow + 4 * lane + 256 * j); } }
                const float rstd = 1.0f / sqrtf(wave_sum(s) * (1.0f / DM) + EPS);
#pragma unroll
                for (int j = 0; j < 8; ++j) { v[j] = v[j] * rstd * gm[j];
                    v2u w; w.x = pk2(v[j][0], v[j][1]); w.y = pk2(v[j][2], v[j][3]); *(v2u*)(XN + (size_t)m * DM + 4 * lane + 256 * j) = w; }
                float a[16];
#pragma unroll
                for (int jj = 0; jj < 16; ++jj) {
                    float t = 0.f;
#pragma unroll
                    for (int j = 0; j < 8; ++j) { const f32x4 w = *(const LAS f32x4*)(wT + jj * DM + 4 * lane + 256 * j); t += (v[j][0] * w[0] + v[j][1] * w[1]) + (v[j][2] * w[2] + v[j][3] * w[3]); }
                    a[jj] = t;
                    if ((jj & 1) == 1) __builtin_amdgcn_sched_barrier(0);
                }
                float b8[8], c4[4], d2[2], e1;
                { const bool up = lane & 32;
#pragma unroll
                  for (int q = 0; q < 8; ++q) { const float snd = up ? a[q] : a[q + 8], kp = up ? a[q + 8] : a[q]; b8[q] = kp + __shfl_xor(snd, 32); } }
                { const bool up = lane & 16;
#pragma unroll
                  for (int q = 0; q < 4; ++q) { const float snd = up ? b8[q] : b8[q + 4], kp = up ? b8[q + 4] : b8[q]; c4[q] = kp + __shfl_xor(snd, 16); } }
                { const bool up = lane & 8;
#pragma unroll
                  for (int q = 0; q < 2; ++q) { const float snd = up ? c4[q] : c4[q + 2], kp = up ? c4[q + 2] : c4[q]; d2[q] = kp + __shfl_xor(snd, 8); } }
                { const bool up = lane & 4; const float snd = up ? d2[0] : d2[1], kp = up ? d2[1] : d2[0]; e1 = kp + __shfl_xor(snd, 4); }
                e1 += __shfl_xor(e1, 2); e1 += __shfl_xor(e1, 1);
                if ((lane & 3) == 0) { const int jj = ((lane >> 5) & 1) * 8 + ((lane >> 4) & 1) * 4 + ((lane >> 3) & 1) * 2 + ((lane >> 2) & 1);
                    const float xx = e1 + args.in[I_DTB][jj]; DT[(size_t)m * 16 + jj] = fmaxf(xx, 0.f) + log1pf(__expf(-fabsf(xx))); }
            }
        }
        __syncthreads();
    }
    SEAM(0);

    if (IN(1)) {
        pg8::Gemm g{XN, WIN, MT, NPROJ, DM}; pg8::StaticOrder S; S.init(MT, NPROJ, DM, G, bx);
        EpiInProj E{(bf16*)(ws + WS_Q), (bf16*)(ws + WS_K), (bf16*)(ws + WS_V), (bf16*)(ws + WS_Z), (bf16*)(ws + WS_XBC), args.out, (unsigned*)(ctl + CW_QK)};
        pg8::gemm_phase<EpiInProj, pg8::StaticOrder, false, true>(lds, g, S, E);
    }
    SEAM(1);

    if (IN(2)) {
        const bf16* Qb = (const bf16*)(ws + WS_Q); const bf16* Kb = (const bf16*)(ws + WS_K); const bf16* Vb = (const bf16*)(ws + WS_V);
        bf16* A2 = (bf16*)(ws + WS_A2);
        volatile LAS int* qslot = (volatile LAS int*)(lds + LDSCTL_OFF + 64);
        volatile LAS float* blkc = (volatile LAS float*)(lds + LDSCTL_OFF + 128);
        if (wave == 0) {
            const int l6 = tid & 63;
            const float a = args.in[I_LQ1][l6] * args.in[I_LK1][l6], b = args.in[I_LQ2][l6] * args.in[I_LK2][l6];
            const float lamv = __expf(wave_sum(a)) - __expf(wave_sum(b)) + LAM_INIT;
            if (l6 == 0) blkc[0] = lamv;
            if (l6 < 8) {
                float qkb = 0.f;
#pragma unroll
                for (int m = 0; m < 2; ++m) { const unsigned* w = (const unsigned*)(ctl + CW_QK) + 2 * (2 * l6 + m);
                    const float q2 = __uint_as_float(__hip_atomic_load(w, __ATOMIC_RELAXED, __HIP_MEMORY_SCOPE_AGENT)) + __uint_as_float(__hip_atomic_load(w + 1, __ATOMIC_RELAXED, __HIP_MEMORY_SCOPE_AGENT));
                    const float k2 = __uint_as_float(__hip_atomic_load(w + 32, __ATOMIC_RELAXED, __HIP_MEMORY_SCOPE_AGENT)) + __uint_as_float(__hip_atomic_load(w + 33, __ATOMIC_RELAXED, __HIP_MEMORY_SCOPE_AGENT));
                    qkb = fmaxf(qkb, sqrtf(q2 * k2)); blkc[16 + 2 * l6 + m] = sqrtf(k2); }
                blkc[8 + l6] = (2.f * 1.02f * qkb + att::THR + 180.f) / (exp2f(-(float)(l6 + 1)) * LOG2E);
                blkc[32 + l6] = (2.f * 1.02f * qkb + 1.f <= 90.f) ? 1.f : 0.f;
            }
        }
        __syncthreads();
        constexpr int NA1 = 256, NA2 = 128, NA3 = 128;
        constexpr int Q_A0 = 256, Q_LOC = Q_A0 + 320, Q_ATT1 = Q_LOC + NA1, Q_SCAN = Q_ATT1 + 64, Q_ATT2 = Q_SCAN + NA2, Q_OUT = Q_ATT2 + 320, Q_CONV = Q_OUT + (512 - NA1 - NA2), Q_END = Q_CONV + 592;
#define ITEM_DONE(word) do { asm volatile("s_waitcnt vmcnt(0)" ::: "memory"); __syncthreads(); \
            if (tid == 0) { __builtin_amdgcn_fence(__ATOMIC_RELEASE, "agent"); asm volatile("s_waitcnt vmcnt(0)" ::: "memory"); (void)atomicAdd((unsigned*)(ctl + (word)), 1u); } } while (0)
#define ITEM_WAIT(word, need) do { if (tid == 0) { unsigned sp_ = 0; while (__hip_atomic_load((unsigned*)(ctl + (word)), __ATOMIC_RELAXED, __HIP_MEMORY_SCOPE_AGENT) < (unsigned)(need)) { __builtin_amdgcn_s_sleep(8); if (++sp_ > (1u << 22)) break; } \
            __builtin_amdgcn_fence(__ATOMIC_ACQUIRE, "agent"); asm volatile("s_waitcnt vmcnt(0)" ::: "memory"); } __syncthreads(); } while (0)
#ifdef PROBE_CAT
        volatile LAS unsigned long long* pcs = (volatile LAS unsigned long long*)(lds + LDSCTL_OFF + 512);
        if (tid == 0) { pcs[0] = __builtin_amdgcn_s_memrealtime(); pcs[1] = 99; }
#define PC_MARK(nc) do { if (tid == 0) { const unsigned long long n_ = __builtin_amdgcn_s_memrealtime(); const unsigned long long c_ = pcs[1]; if (c_ < 8) (void)atomicAdd((unsigned long long*)(ctl + 8576) + c_, n_ - pcs[0]); pcs[0] = n_; pcs[1] = (unsigned long long)(nc); } } while (0)
#else
#define PC_MARK(nc) do {} while (0)
#endif
        for (;;) {
            __syncthreads();
            if (tid == 0) *qslot = (int)atomicAdd((unsigned*)(ctl + CW_QUEUE), 1u);
            __syncthreads();
            const int p = *qslot;
            PC_MARK(p >= Q_END ? 6 : p >= Q_CONV ? 5 : (p >= Q_A0 && p < Q_LOC) ? 2 : (p >= Q_ATT1 && p < Q_SCAN) ? 3 : (p >= Q_ATT2 && p < Q_OUT) ? 4 : ((p < Q_A0 ? p : (p < Q_ATT1 ? p - Q_LOC + 256 : (p < Q_ATT2 ? p - Q_SCAN + 256 + NA1 : p - Q_OUT + 256 + NA1 + NA2))) % 3 == 1) ? 1 : 0);
            if (p >= Q_END) break;
            if (p >= Q_CONV) {
                int tw_ = threadIdx.x; asm volatile("" : "+v"(tw_));
                const int wv2 = __builtin_amdgcn_readfirstlane(tw_ >> 6), ln2 = tw_ & 63;
                LAS float* scr = (LAS float*)(lds + wv2 * 16896);
                const int it0 = 32 * 88 + (p - Q_CONV) * 16 + wv2 * 2;
                f32x4 v[16];
                const P0Item a = p0_item(args, ws, it0); p0_load(a, v, ln2); p0_to_lds(a, v, scr, ln2);
                const P0Item b = p0_item(args, ws, it0 + 1); p0_load(b, v, ln2);
                p0_store(a, scr, ln2); p0_to_lds(b, v, scr, ln2); p0_store(b, scr, ln2);
                continue;
            }
            if (p >= Q_A0 && p < Q_LOC) { ssd_local(args, lds, p - Q_A0); ITEM_DONE(CW_LDONE); continue; }
            if (p >= Q_ATT1 && p < Q_SCAN) { ITEM_WAIT(CW_LDONE, 320); { int te_ = tid; asm volatile("" : "+v"(te_)); ssd_scan(args, p - Q_ATT1, te_); } ITEM_DONE(CW_SDONE); continue; }
            if (p >= Q_ATT2 && p < Q_OUT) { ITEM_WAIT(CW_SDONE, 64); ssd_out(args, lds, p - Q_ATT2); continue; }
            const int ap = p < Q_A0 ? p : (p < Q_ATT1 ? p - Q_LOC + 256 : (p < Q_ATT2 ? p - Q_SCAN + 256 + NA1 : p - Q_OUT + 256 + NA1 + NA2));
            const int grp = ap / 3, rr = ap - 3 * grp;
            int tl_ = threadIdx.x; asm volatile("" : "+v"(tl_));
            const int r32 = tl_ & 31, hi = (tl_ >> 5) & 1, wv_ = __builtin_amdgcn_readfirstlane(tl_ >> 6), map = wv_ >> 2, w4 = wv_ & 3;
            const float lam = blkc[0];
            f32x16 o[4];
            if (rr == 1) {
                const int b = grp & 31, h = grp >> 5;
                const float cs = exp2f(-(float)(h + 1)) * LOG2E;
                const int qi = r32 < 16 ? r32 : 15;
                const bf16* qrow = Qb + (size_t)(MP + 16 * b + qi) * 1024 + h * 128 + map * 64 + hi * 8;
                att::SrcSample src{args.in[I_CK] + ((size_t)b * 1024 * 8 + h) * 128, args.in[I_CV] + ((size_t)b * 1024 * 8 + h) * 128,
                                   args.out + O_KS + (size_t)(16 * b) * 1024 + h * 128, args.out + O_VS + (size_t)(16 * b) * 1024 + h * 128};
                att::attn_core<float, 2, 16, false, att::SrcSample>(o, qrow, (float)(1024 + qi), cs, 16, 0, 18, src, (char*)lds_raw, lds, map * 64, 0.f);
                att::attn_finish(o, lam, args.in[I_GSUB], A2 + h * 128, MP + 16 * b, 16, w4 == 0, (char*)lds_raw);
            } else {
                const int q = 2 * grp + (rr == 2 ? 1 : 0), j = 63 - (q >> 3), h = 7 - (q & 7);
                const float cs = exp2f(-(float)(h + 1)) * LOG2E;
                const float wv = blkc[8 + h];
                int t0 = (int)ceilf(((float)(128 * j - 63) - wv) * (1.0f / 64.f)); t0 = t0 < 0 ? 0 : (t0 & ~1);
                const int row = 128 * j + 32 * w4 + r32;
                const bf16* qrow = Qb + (size_t)row * 1024 + h * 128 + map * 64 + hi * 8;
                att::SrcPrompt src{Kb + h * 128, Vb + h * 128};
                const float kmx = blkc[16 + 2 * h + map];
                if (blkc[32 + h] != 0.f) att::attn_core<bf16, 1, 64, true, att::SrcPrompt>(o, qrow, (float)row, cs, 2 * j + (w4 >> 1), t0, 2 * j + 2, src, (char*)lds_raw, lds, map * 64, kmx);
                else att::attn_core<bf16, 1, 64, false, att::SrcPrompt>(o, qrow, (float)row, cs, 2 * j + (w4 >> 1), t0, 2 * j + 2, src, (char*)lds_raw, lds, map * 64, kmx);
                att::attn_finish(o, lam, args.in[I_GSUB], A2 + h * 128, 128 * j + 32 * w4, 32, true, (char*)lds_raw);
            }
        }
#undef ITEM_DONE
#undef ITEM_WAIT
    }
    SEAM(2);
#ifdef PROBE_CAT
    if (tid == 0) { const unsigned long long n_ = __builtin_amdgcn_s_memrealtime(); (void)atomicAdd((unsigned long long*)(ctl + 8576) + 6, n_ - *(volatile LAS unsigned long long*)(lds + LDSCTL_OFF + 512)); }
#endif

    if (IN(3)) {
        pg8::Gemm g{(const bf16*)(ws + WS_A2), WOUT, MT, DM, DM}; pg8::SplitOrder S; S.init(MP, MT, DM, DM, G, bx, NSL5);
        EpiOutProj E{args.in[I_XP], args.in[I_XS], args.out + O_Y, XN, (float*)(ws + WS_RS1), (float*)(ws + WS_SLAB5)};
        pg8::gemm_phase<EpiOutProj, pg8::SplitOrder, true, true>(lds, g, S, E);
    }
    SEAM(3);

    if (IN(4)) {
        int tq_ = threadIdx.x; asm volatile("" : "+v"(tq_)); const int lane = tq_ & 63;
        const int gw = vcu * NWAVES + wave, NGW = G * NWAVES;
        const float* slabs = (const float*)(ws + WS_SLAB5); const float* rs = (const float*)(ws + WS_RS1); float* rstd1 = (float*)(ws + WS_RSTD1);
        for (int rr = (gw & 3) == 0 ? (gw >> 2) : MS; rr < MS; rr += NGW / 4) {
            const int row = MP + rr, pms = rr >> 8, rl = rr & 255;
            const float* xr = args.in[I_XS] + (size_t)rr * DM; float ss = 0.f;
            f32x4 vv[8];
#pragma unroll
            for (int jh = 0; jh < 8; jh += 4) {
                f32x4 ld[4][NSL5 + 1];
#pragma unroll
                for (int jj = 0; jj < 4; ++jj) { const int j = jh + jj; ld[jj][NSL5] = *(const f32x4*)(xr + 4 * lane + 256 * j);
                    const float* sp = slabs + ((size_t)(pms * 8 + j) * NSL5) * 65536 + (size_t)rl * 256 + 4 * lane;
#pragma unroll
                    for (int q = 0; q < NSL5; ++q) ld[jj][q] = *(const f32x4*)(sp + (size_t)q * 65536); }
                asm volatile("" ::: "memory");
#pragma unroll
                for (int jj = 0; jj < 4; ++jj) { f32x4 a = ld[jj][NSL5];
#pragma unroll
                    for (int q = 0; q < NSL5; ++q) a = a + ld[jj][q];
                    vv[jh + jj] = a; }
            }
#pragma unroll
            for (int j = 0; j < 8; ++j) {
                const f32x4 v = vv[j];
                *(f32x4*)(args.out + O_Y + (size_t)row * DM + 4 * lane + 256 * j) = v;
                v2u w; w.x = pk2(v[0], v[1]); w.y = pk2(v[2], v[3]); *(v2u*)(XN + (size_t)row * DM + 4 * lane + 256 * j) = w;
                ss += (v[0] * v[0] + v[1] * v[1]) + (v[2] * v[2] + v[3] * v[3]);
            }
            ss = wave_sum(ss);
            if (lane == 0) rstd1[row] = 1.0f / sqrtf(ss * (1.0f / DM) + EPS);
        }
        for (int row = bx * (NWAVES * 64) + tid; row < MP; row += G * NWAVES * 64) {
            const float* p = rs + (size_t)row * 32; float t = 0.f;
#pragma unroll
            for (int q = 0; q < 8; ++q) { const f32x4 a = *(const f32x4*)(p + 4 * q); t += (a[0] + a[1]) + (a[2] + a[3]); }
            rstd1[row] = 1.0f / sqrtf(t * (1.0f / DM) + EPS);
        }
    }
    SEAM(4);

    if (IN(5)) {
        pg8::Gemm g{XN, WGU, MT, 2 * DFF, DM}; pg8::StaticOrder S; S.init(MT, 2 * DFF, DM, G, bx);
        EpiGateUp E{(bf16*)(ws + WS_HID), (const float*)(ws + WS_RSTD1), args.out, args.in[I_FCW], args.in[I_FCB], args.in[I_SFFN], (float*)(ws + WS_FRG), (float*)(ws + WS_FRU), (float*)(ws + WS_LRG), lds};
        pg8::gemm_phase<EpiGateUp, pg8::StaticOrder, true, true>(lds, g, S, E);
    }
    SEAM(5);

    if (IN(6)) {
        pg8::Gemm g{(const bf16*)(ws + WS_HID), WDN, MT, DM, DFF}; pg8::SplitOrder S; S.init(MP, MT, DM, DFF, G, bx, NSL9);
        {
            pg8::Unit u0;
            if (S.next(0, u0) && u0.slab < 0 && u0.pm > 0) {
                const float* frg = (const float*)(ws + WS_FRG) + (size_t)u0.pm * 2 * DFF; const float* fru = (const float*)(ws + WS_FRU) + (size_t)u0.pm * 2 * DFF;
                const float* lrg = (const float*)(ws + WS_LRG) + (size_t)(u0.pm - 1) * 2 * DFF; bf16* HID = (bf16*)(ws + WS_HID);
                const float* fw = args.in[I_FCW]; const float* fb = args.in[I_FCB];
                for (int task = tid; task < 2 * (DFF / 8); task += NWAVES * 64) {
                    const int r = task / (DFF / 8), col = 8 * (task % (DFF / 8));
                    const float* p2 = r == 0 ? lrg + col : lrg + DFF + col; const float* p1 = r == 0 ? lrg + DFF + col : frg + col; const float* p0 = frg + (size_t)r * DFF + col; const float* pu = fru + (size_t)r * DFF + col;
                    float o[8];
#pragma unroll
                    for (int e = 0; e < 8; ++e) { const float y = fb[col + e] + fw[col + e] * p2[e] + fw[DFF + col + e] * p1[e] + fw[2 * DFF + col + e] * p0[e]; o[e] = siluf(y) * pu[e]; }
                    v4u w; w.x = pk2(o[0], o[1]); w.y = pk2(o[2], o[3]); w.z = pk2(o[4], o[5]); w.w = pk2(o[6], o[7]);
                    *(v4u*)(HID + (size_t)(256 * u0.pm + r) * DFF + col) = w;
                }
                asm volatile("s_waitcnt vmcnt(0)" ::: "memory");
            }
            __syncthreads();
        }
        EpiDown E{args.out + O_Y, (float*)(ws + WS_RS2), (float*)(ws + WS_SLAB9), XN  };
        pg8::gemm_phase<EpiDown, pg8::SplitOrder, true, true>(lds, g, S, E);
    }
    SEAM(6);

    if (IN(7)) {
        int tq_ = threadIdx.x; asm volatile("" : "+v"(tq_)); const int lane = tq_ & 63;
        const int gw = vcu * NWAVES + wave, NGW = G * NWAVES;
        const float* rs = (const float*)(ws + WS_RS2); const float* gf = args.in[I_GFIN]; const float* slabs = (const float*)(ws + WS_SLAB9);
        f32x4 gfv[8];
#pragma unroll
        for (int j = 0; j < 8; ++j) gfv[j] = *(const f32x4*)(gf + 4 * lane + 256 * j);
        const int nprompt = (MP - gw + NGW - 1) / NGW, nsample = (gw & 3) == 0 ? (MS - (gw >> 2) + NGW / 4 - 1) / (NGW / 4) : 0;
        for (int st = 0; st < nprompt + nsample; ++st) {
            const int m = st < nprompt ? gw + st * NGW : MP + (gw >> 2) + (st - nprompt) * (NGW / 4);
            float* row = args.out + O_Y + (size_t)m * DM;
            f32x4 v[8]; float t;
            if (m < MP) {
                t = lane < 32 ? rs[(size_t)m * 32 + lane] : 0.f;
#pragma unroll
                for (int j = 0; j < 8; ++j) { const v2u w = *(const v2u*)(XN + (size_t)m * DM + 4 * lane + 256 * j); v[j] = (f32x4){bflo(w.x), bfhi(w.x), bflo(w.y), bfhi(w.y)}; }
            } else {
                const int rr = m - MP, pms = rr >> 8, rl = rr & 255; t = 0.f;
#pragma unroll
                for (int jh = 0; jh < 8; jh += 2) {
                    f32x4 ld[2][NSL9 + 1];
#pragma unroll
                    for (int jj = 0; jj < 2; ++jj) { const int j = jh + jj; ld[jj][NSL9] = *(const f32x4*)(row + 4 * lane + 256 * j);
                        const float* sp = slabs + ((size_t)(pms * 8 + j) * NSL9) * 65536 + (size_t)rl * 256 + 4 * lane;
#pragma unroll
                        for (int q = 0; q < NSL9; ++q) ld[jj][q] = *(const f32x4*)(sp + (size_t)q * 65536); }
                    asm volatile("" ::: "memory");
#pragma unroll
                    for (int jj = 0; jj < 2; ++jj) { f32x4 a = ld[jj][NSL9];
#pragma unroll
                        for (int q = 0; q < NSL9; ++q) a = a + ld[jj][q];
                        v[jh + jj] = a; t += (a[0] * a[0] + a[1] * a[1]) + (a[2] * a[2] + a[3] * a[3]); }
                }
            }
            t = wave_sum(t);
            const float rstd = 1.0f / sqrtf(t * (1.0f / DM) + EPS);
#pragma unroll
            for (int j = 0; j < 8; ++j) *(f32x4*)(row + 4 * lane + 256 * j) = v[j] * rstd * gfv[j];
        }
    }
    PEND(N_PHASES - 1);
#ifdef PROBE_CAT
    if (blockIdx.x == 0 && tid == 0) { const unsigned long long d = __hip_atomic_load((unsigned long long*)(ctl + 8576) + PROBE_CAT, __ATOMIC_RELAXED, __HIP_MEMORY_SCOPE_AGENT) * PROBE_SCALE / G, t0 = __builtin_amdgcn_s_memrealtime(); while (__builtin_amdgcn_s_memrealtime() - t0 < d) __builtin_amdgcn_s_sleep(16); }
#endif
#ifdef PROBE_PHASE
    if (blockIdx.x == 0 && tid == 0) { const unsigned long long d = (pr_b - pr_a) * PROBE_SCALE, t0 = __builtin_amdgcn_s_memrealtime(); while (__builtin_amdgcn_s_memrealtime() - t0 < d) __builtin_amdgcn_s_sleep(16); }
#endif
#undef IN
#undef SEAM
}

extern "C" void kernel_launch(void* const* d_in, const int* in_sizes, int n_in, void* d_out, int out_size, void* d_ws, size_t ws_size, hipStream_t stream) {
    static int grid = 0;
    if (grid == 0) {
        if (n_in != 28 || out_size != (int)O_END || ws_size < WS_END) { fprintf(stderr, "kernel_launch: unexpected shapes: n_in %d out %d ws %zu (need %zu)\n", n_in, out_size, ws_size, (size_t)WS_END); grid = -1; return; }
        int dev = 0, cus = 0;
        if (hipGetDevice(&dev) != hipSuccess || hipDeviceGetAttribute(&cus, hipDeviceAttributeMultiprocessorCount, dev) != hipSuccess) { grid = -1; return; }
        if (hipFuncSetAttribute((const void*)hymba_fwd, hipFuncAttributeMaxDynamicSharedMemorySize, LDS_BYTES) != hipSuccess) { fprintf(stderr, "kernel_launch: hipFuncSetAttribute failed\n"); grid = -1; return; }
        (void)hipGetLastError();
        grid = cus;
    }
    if (grid < 0) return;
    (void)hipMemsetAsync((char*)d_ws + WS_CTL, 0, CTL_ZERO_BYTES, stream);
    Args a{};
    for (int i = 0; i < 28; ++i) a.in[i] = (const float*)d_in[i];
    a.out = (float*)d_out; a.ws = (unsigned char*)d_ws;
    if (N_LAUNCHES == 1) {
        a.ph_lo = 0; a.ph_hi = N_PHASES; a.li = 0;
        hipLaunchKernelGGL(hymba_fwd, dim3(grid), dim3(NWAVES * 64), LDS_BYTES, stream, a);
    } else {
        for (int li = 0; li < N_PHASES; ++li) { a.ph_lo = li; a.ph_hi = li + 1; a.li = li; hipLaunchKernelGGL(hymba_fwd, dim3(grid), dim3(NWAVES * 64), LDS_BYTES, stream, a); }
    }
    const hipError_t le = hipPeekAtLastError();
    if (le != hipSuccess) fprintf(stderr, "kernel_launch: launch failed: %s\n", hipGetErrorName(le));
}
```

```cpp
#include <hip/hip_runtime.h>
#include <hip/hip_bf16.h>
#include <cstdio>
#include <cstdint>

#ifndef MK_N_LAUNCHES
#define MK_N_LAUNCHES 1
#endif

namespace pg8 {
#define PG8_LAS __attribute__((address_space(3)))
typedef unsigned short bf16_t;
typedef short bf16x8 __attribute__((ext_vector_type(8)));
typedef float f32x4 __attribute__((ext_vector_type(4)));
typedef unsigned u32x4 __attribute__((ext_vector_type(4)));
constexpr int BM = 256, BK = 64, HALF = 128, HTB = HALF * BK * 2, STAGE_BYTES = 8 * HTB, NXCD = 8, WGM = 8;

__host__ __device__ __forceinline__ int lds_byte(int r, int c) { const int st = (r >> 4) * 2 + (c >> 5), rr = r & 15, cc = c & 31, ob = rr * 64 + cc * 2; return st * 1024 + (ob ^ (((ob >> 9) & 1) << 5)); }
__host__ __device__ __forceinline__ void stage_rc(int b, int& R, int& C) { const int st = b / 1024, sb = b % 1024, swz = sb ^ (((sb >> 9) & 1) << 5); R = (st >> 1) * 16 + swz / 64; C = (st & 1) * 32 + (swz % 64) / 2; }
__host__ __device__ __forceinline__ int perm32(int rho) { const int n = rho >> 4, i = rho & 15; return 8 * (i >> 2) + 4 * n + (i & 3); }

struct Unit { int pm, pn, k0, nk, slab; };
struct Gemm { const bf16_t* A; const bf16_t* Bt; int M, N, K; };

struct StaticOrder {
    int nM, nN, nwg, G, c, nkt;
    __host__ __device__ void init(int M, int N, int K, int G_, int c_) { nM = M / BM; nN = N / BM; nwg = nM * nN; G = G_; c = c_; nkt = K / BK; }
    __host__ __device__ __forceinline__ bool next(int i, Unit& u) const { return at((long)i * G + c, u); }
    __host__ __device__ __forceinline__ bool at(long L, Unit& u) const {
        if (L >= nwg) return false; u.k0 = 0; u.nk = nkt; u.slab = -1;
        int wgid = (int)L; { const int q = nwg / NXCD, r = nwg % NXCD, xcd = wgid % NXCD, off = wgid / NXCD; wgid = (xcd < r ? xcd * (q + 1) : r * (q + 1) + (xcd - r) * q) + off; }
        const int nig = WGM * nN, gid = wgid / nig, fm = gid * WGM, gsz = (nM - fm) < WGM ? (nM - fm) : WGM;
        u.pm = fm + ((wgid % nig) % gsz); u.pn = (wgid % nig) / gsz; return true;
    }
    __device__ __forceinline__ void a_ready(const Unit&) const {}
    __device__ __forceinline__ void done(const Unit&) const {}
};

struct SplitOrder {
    StaticOrder P; int nN, nsl, nks, ntail;
    __host__ __device__ void init(int MPR, int M, int N, int K, int G_, int c_, int nsl_) { P.init(MPR, N, K, G_, c_); nN = N / BM; nsl = nsl_; nks = (K / BK) / nsl_; ntail = ((M - MPR) / BM) * nN; }
    __host__ __device__ __forceinline__ bool next(int i, Unit& u) const {
        const long L = (long)i * P.G + P.c;
        const int sidx = (int)(L - P.nwg);
        if (sidx >= ntail * nsl) return false;
        int pm, pn, k0, nk, slab;
        if (sidx < 0) {
            int wgid = (int)L; { const int q = P.nwg / NXCD, r = P.nwg % NXCD, xcd = wgid % NXCD, off = wgid / NXCD; wgid = (xcd < r ? xcd * (q + 1) : r * (q + 1) + (xcd - r) * q) + off; }
            const int nig = WGM * P.nN, gid = wgid / nig, fm = gid * WGM, gsz = (P.nM - fm) < WGM ? (P.nM - fm) : WGM;
            pm = fm + ((wgid % nig) % gsz); pn = (wgid % nig) / gsz; k0 = 0; nk = P.nkt; slab = -1;
        } else {
            const int tile = sidx / nsl, sl = sidx % nsl; pm = P.nM + tile / nN; pn = tile % nN; k0 = sl * nks; nk = nks; slab = sidx;
        }
        u.pm = pm; u.pn = pn; u.k0 = k0; u.nk = nk; u.slab = slab; return true;
    }
    __device__ __forceinline__ void a_ready(const Unit&) const {}
    __device__ __forceinline__ void done(const Unit&) const {}
};

typedef float f32x2_t __attribute__((ext_vector_type(2))); typedef __bf16 bf16x2_t __attribute__((ext_vector_type(2)));
__device__ __forceinline__ unsigned cvt_pk_bf16(float lo, float hi) { f32x2_t v = {lo, hi}; bf16x2_t b = __builtin_convertvector(v, bf16x2_t); return __builtin_bit_cast(unsigned, b); }

template <class Epi, class Sched, bool ALIGN_EPI = false, bool SP2 = false>
__device__ __forceinline__ void gemm_phase(PG8_LAS unsigned char* lds, const Gemm g, const Sched& S, const Epi& E) {
    const int tid = threadIdx.x, wid = __builtin_amdgcn_readfirstlane(tid >> 6), lane = tid & 63, wr = wid >> 2, wc = wid & 3, fr = lane & 15, fq = lane >> 4;
    const int K = g.K;
    unsigned voffA[2], voffB[2];
#pragma unroll
    for (int i = 0; i < 2; ++i) { int R, C; stage_rc(tid * 16 + i * 8192, R, C); const int Rb = Epi::PERM ? ((R & ~31) + perm32(R & 31)) : R;
        voffA[i] = (unsigned)(R * K + C) * 2u; voffB[i] = (unsigned)(Rb * K + C) * 2u; }
    const size_t kstep = (size_t)(BK * 2);
    const size_t hstep = (size_t)HALF * K * 2;
    const size_t tstep = 2 * hstep;
    const unsigned ldsw = (unsigned)wid * 1024u;
    const int aoff = lds_byte(wr * 64 + fr, fq * 8), boff = lds_byte(wc * 32 + fr, fq * 8);
#define PG8_SA(b, h) (((b) * 2 + (h)) * HTB)
#define PG8_SB(b, h) ((4 + (b) * 2 + (h)) * HTB)
#define PG8_STAGE(bufoff, gbase, voff) do { _Pragma("unroll") for (int _i = 0; _i < 2; ++_i) \
        __builtin_amdgcn_global_load_lds((const unsigned*)((const char*)(gbase) + (voff)[_i]), (PG8_LAS unsigned*)(lds + (bufoff) + ldsw + _i * 8192), 16, 0, 0); } while (0)
#define PG8_LDA(dst, b, h) do { _Pragma("unroll") for (int m = 0; m < 4; ++m) _Pragma("unroll") for (int k = 0; k < 2; ++k) dst[m][k] = *(const PG8_LAS bf16x8*)(lds + PG8_SA(b, h) + aoff + m * 2048 + k * 1024); } while (0)
#define PG8_LDB(dst, b, h) do { _Pragma("unroll") for (int n = 0; n < 2; ++n) _Pragma("unroll") for (int k = 0; k < 2; ++k) dst[n][k] = *(const PG8_LAS bf16x8*)(lds + PG8_SB(b, h) + boff + n * 2048 + k * 1024); } while (0)
#define PG8_MMA(ai, bj, At, Bt) do { __builtin_amdgcn_s_setprio(1); _Pragma("unroll") for (int m = 0; m < 4; ++m) _Pragma("unroll") for (int n = 0; n < 2; ++n) _Pragma("unroll") for (int k = 0; k < 2; ++k) \
        acc[ai][bj][m][n] = __builtin_amdgcn_mfma_f32_16x16x32_bf16(Bt[n][k], At[m][k], acc[ai][bj][m][n], 0, 0, 0); __builtin_amdgcn_s_setprio(0); } while (0)
#define PG8_WAIT_V(n) asm volatile("s_waitcnt vmcnt(" #n ")" ::: "memory")
#define PG8_WAIT_L(n) asm volatile("s_waitcnt lgkmcnt(" #n ")" ::: "memory")
#define PG8_BAR __builtin_amdgcn_s_barrier()
#define PG8_SCHED __builtin_amdgcn_sched_barrier(0)
    Unit cur, nxt; int ui = 0;
    if (!S.next(0, cur)) return;
    f32x4 acc[2][2][4][2];
#pragma unroll
    for (int a = 0; a < 2; ++a)
#pragma unroll
        for (int b = 0; b < 2; ++b)
#pragma unroll
            for (int m = 0; m < 4; ++m)
#pragma unroll
                for (int n = 0; n < 2; ++n) acc[a][b][m][n] = (f32x4){0.f, 0.f, 0.f, 0.f};
    bf16x8 At[4][2], B0[2][2], B1[2][2];
    const char* cA = (const char*)g.A + (size_t)cur.pm * tstep + (size_t)cur.k0 * kstep; const char* cB = (const char*)g.Bt + (size_t)cur.pn * tstep + (size_t)cur.k0 * kstep;
    S.a_ready(cur);
    if constexpr (SP2) {
        PG8_STAGE(PG8_SB(0, 0), cB, voffB); PG8_STAGE(PG8_SB(0, 1), cB + hstep, voffB); PG8_STAGE(PG8_SA(0, 0), cA, voffA); PG8_STAGE(PG8_SA(0, 1), cA + hstep, voffA);
        if (wr == 1) PG8_BAR;
        PG8_WAIT_V(2); PG8_BAR;
        PG8_STAGE(PG8_SB(1, 0), cB + kstep, voffB); PG8_STAGE(PG8_SA(1, 0), cA + kstep, voffA); PG8_STAGE(PG8_SB(1, 1), cB + hstep + kstep, voffB);
        PG8_WAIT_V(6); PG8_BAR;
    } else {
        PG8_STAGE(PG8_SB(0, 0), cB, voffB); PG8_STAGE(PG8_SA(0, 0), cA, voffA); PG8_STAGE(PG8_SB(0, 1), cB + hstep, voffB); PG8_STAGE(PG8_SA(0, 1), cA + hstep, voffA);
        if (wr == 1) PG8_BAR;
        PG8_WAIT_V(4); PG8_BAR;
        PG8_STAGE(PG8_SB(1, 0), cB + kstep, voffB); PG8_STAGE(PG8_SA(1, 0), cA + kstep, voffA); PG8_STAGE(PG8_SB(1, 1), cB + hstep + kstep, voffB);
        PG8_WAIT_V(6); PG8_BAR;
    }
    for (;;) {
        const bool has_next = S.next(ui + 1, nxt);
        const char* nA = has_next ? (const char*)g.A + (size_t)nxt.pm * tstep + (size_t)nxt.k0 * kstep : cA; const char* nB = has_next ? (const char*)g.Bt + (size_t)nxt.pn * tstep + (size_t)nxt.k0 * kstep : cB;
        const int nt = cur.nk;
        for (int t = 0; t < nt; t += 2) {
            const bool last = (t == nt - 2);
            const char* a1 = cA + (size_t)(t + 1) * kstep;
            const char* a2 = last ? nA : cA + (size_t)(t + 2) * kstep; const char* b2 = last ? nB : cB + (size_t)(t + 2) * kstep;
            const char* a3 = a2 + kstep; const char* b3 = b2 + kstep;
            if (last && has_next) S.a_ready(nxt);
            if constexpr (SP2) {
            PG8_LDB(B0, 0, 0); PG8_LDB(B1, 0, 1); PG8_SCHED; PG8_LDA(At, 0, 0); PG8_STAGE(PG8_SA(1, 1), a1 + hstep, voffA);
            PG8_WAIT_V(8); PG8_WAIT_L(0); PG8_BAR; PG8_MMA(0, 0, At, B0); PG8_MMA(0, 1, At, B1); PG8_BAR; PG8_SCHED;
            PG8_LDA(At, 0, 1); PG8_STAGE(PG8_SB(0, 0), b2, voffB); PG8_STAGE(PG8_SB(0, 1), b2 + hstep, voffB); PG8_STAGE(PG8_SA(0, 0), a2, voffA);
            PG8_WAIT_V(8); PG8_WAIT_L(0); PG8_BAR; PG8_MMA(1, 0, At, B0); PG8_MMA(1, 1, At, B1); PG8_BAR; PG8_SCHED;
            PG8_LDB(B0, 1, 0); PG8_LDB(B1, 1, 1); PG8_SCHED; PG8_LDA(At, 1, 0); PG8_STAGE(PG8_SA(0, 1), a2 + hstep, voffA);
            PG8_WAIT_V(8); PG8_WAIT_L(0); PG8_BAR; PG8_MMA(0, 0, At, B0); PG8_MMA(0, 1, At, B1); PG8_BAR; PG8_SCHED;
            PG8_LDA(At, 1, 1); PG8_STAGE(PG8_SB(1, 0), b3, voffB); PG8_STAGE(PG8_SB(1, 1), b3 + hstep, voffB); PG8_STAGE(PG8_SA(1, 0), a3, voffA);
            PG8_WAIT_V(8); PG8_WAIT_L(0); PG8_BAR; PG8_MMA(1, 0, At, B0); PG8_MMA(1, 1, At, B1); PG8_BAR; PG8_SCHED;
            } else {
            PG8_LDB(B0, 0, 0); PG8_SCHED; PG8_LDA(At, 0, 0); PG8_STAGE(PG8_SA(1, 1), a1 + hstep, voffA);
            PG8_WAIT_L(8); PG8_BAR; PG8_WAIT_L(0); PG8_MMA(0, 0, At, B0); PG8_BAR; PG8_SCHED;
            PG8_LDB(B1, 0, 1); PG8_STAGE(PG8_SB(0, 0), b2, voffB);
            PG8_BAR; PG8_WAIT_L(0); PG8_MMA(0, 1, At, B1); PG8_BAR;
            PG8_LDA(At, 0, 1); PG8_STAGE(PG8_SA(0, 0), a2, voffA);
            PG8_BAR; PG8_WAIT_L(0); PG8_MMA(1, 0, At, B0); PG8_BAR; PG8_SCHED;
            PG8_STAGE(PG8_SB(0, 1), b2 + hstep, voffB);
            PG8_WAIT_V(6); PG8_BAR; PG8_MMA(1, 1, At, B1); PG8_BAR;
            PG8_LDB(B0, 1, 0); PG8_SCHED; PG8_LDA(At, 1, 0); PG8_STAGE(PG8_SA(0, 1), a2 + hstep, voffA);
            PG8_WAIT_L(8); PG8_BAR; PG8_WAIT_L(0); PG8_MMA(0, 0, At, B0); PG8_BAR; PG8_SCHED;
            PG8_LDB(B1, 1, 1); PG8_STAGE(PG8_SB(1, 0), b3, voffB);
            PG8_BAR; PG8_WAIT_L(0); PG8_MMA(0, 1, At, B1); PG8_BAR;
            PG8_LDA(At, 1, 1); PG8_STAGE(PG8_SA(1, 0), a3, voffA);
            PG8_BAR; PG8_WAIT_L(0); PG8_MMA(1, 0, At, B0); PG8_BAR; PG8_SCHED;
            PG8_STAGE(PG8_SB(1, 1), b3 + hstep, voffB);
            PG8_WAIT_V(6); PG8_BAR; PG8_MMA(1, 1, At, B1); PG8_BAR;
            }
        }
        if constexpr (ALIGN_EPI) { if (wr == 0) PG8_BAR; }
        if constexpr (!Epi::AFTER_DRAIN) { E(acc, cur, wr, wc, fr, fq); S.done(cur); }
        if (!has_next) break;
#pragma unroll
        for (int a = 0; a < 2; ++a)
#pragma unroll
            for (int b = 0; b < 2; ++b)
#pragma unroll
                for (int m = 0; m < 4; ++m)
#pragma unroll
                    for (int n = 0; n < 2; ++n) acc[a][b][m][n] = (f32x4){0.f, 0.f, 0.f, 0.f};
        cur = nxt; cA = nA; cB = nB; ++ui;
        if constexpr (ALIGN_EPI) { if (wr == 1) PG8_BAR; }
    }
    PG8_WAIT_V(0);
    if constexpr (!ALIGN_EPI) { if (wr == 0) PG8_BAR; }
    PG8_BAR;
#undef PG8_SA
#undef PG8_SB
#undef PG8_STAGE
#undef PG8_LDA
#undef PG8_LDB
#undef PG8_MMA
#undef PG8_WAIT_V
#undef PG8_WAIT_L
#undef PG8_BAR
#undef PG8_SCHED
}
}

constexpr int NWAVES = 8;
constexpr int MP = 8192, MS = 512, MT = MP + MS;
constexpr int DM = 2048, NPROJ = 5632, DIN = 5648, DFF = 5632, NH = 8, NSH = 16;
constexpr int NCHUNK = 128 + 32;
constexpr float EPS = 1e-6f;
constexpr float LOG2E = 1.4426950408889634f;
constexpr float QSCALE = 0.125f * LOG2E;
constexpr float LAM_INIT = 0.2f;

constexpr size_t O_Y = 0, O_KP = 17825792, O_VP = 26214400, O_CP = 34603008, O_SP = 34607616, O_FP = 34738688,
                 O_KS = 34749952, O_VS = 35274240, O_CS = 35798528, O_SS = 35945984, O_FS = 40140288, O_END = 40500736;

constexpr size_t MiB = 1u << 20;
constexpr size_t WS_CTL = 0, CTL_ZERO_BYTES = 64 * 1024;
constexpr size_t WS_WIN = 2 * MiB, WS_WOUT = 24 * MiB, WS_WGU = 32 * MiB, WS_WDN = 76 * MiB, WS_XN = 98 * MiB;
constexpr size_t WS_Q = 132 * MiB, WS_K = 150 * MiB, WS_V = 168 * MiB, WS_Z = 186 * MiB, WS_XBC = 204 * MiB, WS_DT = 230 * MiB;
constexpr size_t WS_ACUM = 235 * MiB, WS_CD = 236 * MiB, WS_CB = 237 * MiB, WS_A2 = 243 * MiB, WS_SCH = 277 * MiB, WS_HPREV = 357 * MiB, WS_YP = 397 * MiB;
constexpr size_t WS_RS1 = 437 * MiB, WS_RS2 = 439 * MiB, WS_FRG = 441 * MiB, WS_FRU = 443 * MiB, WS_LRG = 445 * MiB, WS_RSTD1 = 447 * MiB, WS_END = 448 * MiB;
constexpr size_t WS_HID = 132 * MiB, WS_G = 226 * MiB, WS_U = 320 * MiB;
constexpr size_t WS_SLAB5 = WS_Q, WS_SLAB9 = WS_G;
static_assert(WS_U + (size_t)MT * DFF * 2 <= WS_RS1, "ffn overlay");
constexpr int CW_BAR = 4096, CW_QK = 8192, CW_QUEUE = 8320, CW_LDONE = 8384, CW_SDONE = 8448;

constexpr int LDS_BYTES = 147456, LDSCTL_OFF = 146432;

#define GAS __attribute__((address_space(1)))
#define LAS __attribute__((address_space(3)))
typedef unsigned short bf16;
typedef unsigned v4u __attribute__((ext_vector_type(4)));
typedef unsigned v2u __attribute__((ext_vector_type(2)));
typedef float f32x2 __attribute__((ext_vector_type(2)));
typedef float f32x4 __attribute__((ext_vector_type(4)));
typedef float f32x8 __attribute__((ext_vector_type(8)));
typedef float f32x16 __attribute__((ext_vector_type(16)));
typedef short bf16x8 __attribute__((ext_vector_type(8)));
typedef short s16x4 __attribute__((ext_vector_type(4)));
typedef GAS unsigned gu32;

__device__ __forceinline__ unsigned f2bf(float f) { unsigned u = __builtin_bit_cast(unsigned, f); return (u + 0x7fffu + ((u >> 16) & 1u)) >> 16; }
__device__ __forceinline__ unsigned pk2(float lo, float hi) { return pg8::cvt_pk_bf16(lo, hi); }
__device__ __forceinline__ float bf2f(unsigned short b) { return __builtin_bit_cast(float, (unsigned)b << 16); }
__device__ __forceinline__ float bflo(unsigned w) { return __builtin_bit_cast(float, w << 16); }
__device__ __forceinline__ float bfhi(unsigned w) { return __builtin_bit_cast(float, w & 0xffff0000u); }
__device__ __forceinline__ float wave_sum(float v) {
#pragma unroll
    for (int o = 1; o < 64; o <<= 1) v += __shfl_xor(v, o);
    return v;
}
__device__ __forceinline__ float siluf(float x) { return x * __builtin_amdgcn_rcpf(1.f + __builtin_amdgcn_exp2f(-LOG2E * x)); }

#define XB_TMO      128
#define XB_XCNT(j)  (256  + 64 * (j))
#define XB_XSUB(j)  (1280 + 64 * (j))
#define XB_XGEN(j)  (2304 + 64 * (j))
#define XB_TOP      3328
#define XB_TOPGEN   3392
#define XCD_BAR_WORDS 3456
#define XB_SPIN_CAP (1u << 18)
__device__ __forceinline__ unsigned xb_ld(unsigned* p)              { return __hip_atomic_load(p, __ATOMIC_RELAXED, __HIP_MEMORY_SCOPE_AGENT); }
__device__ __forceinline__ unsigned xb_add(unsigned* p, unsigned v) { return __hip_atomic_fetch_add(p, v, __ATOMIC_RELAXED, __HIP_MEMORY_SCOPE_AGENT); }
__device__ __forceinline__ unsigned xb_xcc_id() { return (unsigned)__builtin_amdgcn_s_getreg((3 << 11) | 20) & 0xFu; }
#define XB_SPIN(cond, bar) do { unsigned _sp = 0; while (cond) { __builtin_amdgcn_s_sleep(1); \
    if ((++_sp & 255u) == 0u) { if (xb_ld(&(bar)[XB_TMO])) break; if (_sp > XB_SPIN_CAP) { atomicAdd(&(bar)[XB_TMO], 1u); break; } } } } while (0)
struct XcdBarrier { unsigned* bar; unsigned x; volatile LAS unsigned* st; };
__device__ __forceinline__ XcdBarrier xcd_barrier_post(unsigned* bar, volatile LAS unsigned* st) {
    XcdBarrier b; b.bar = bar; b.x = xb_xcc_id(); b.st = st;
    if (threadIdx.x == 0) (void)xb_add(&bar[XB_XCNT(b.x)], 1u);
    return b;
}
__device__ __forceinline__ void xcd_barrier_complete(unsigned* bar, unsigned x, unsigned& nloc, unsigned& nx) {
    const unsigned G = gridDim.x * gridDim.y * gridDim.z;
    unsigned sum, cnt, mine, sp = 0u;
    for (;;) {
        sum = 0u; cnt = 0u; mine = 0u;
#pragma unroll
        for (unsigned j = 0; j < 16; ++j) { const unsigned c = xb_ld(&bar[XB_XCNT(j)]); sum += c; cnt += (c > 0u) ? 1u : 0u; mine = (j == x) ? c : mine; }
        if (sum == G) break;
        __builtin_amdgcn_s_sleep(1);
        if ((++sp & 255u) == 0u) { if (xb_ld(&bar[XB_TMO])) break; if (sp > XB_SPIN_CAP) { atomicAdd(&bar[XB_TMO], 1u); break; } }
    }
    nloc = mine > 0u ? mine : 1u; nx = cnt > 0u ? cnt : 1u;
}
__device__ __forceinline__ void xcd_barrier(const XcdBarrier& b) {
    asm volatile("s_waitcnt vmcnt(0)" ::: "memory");
    __syncthreads();
    if (threadIdx.x == 0) {
        unsigned* bar = b.bar;
        __builtin_amdgcn_s_waitcnt(0);
        unsigned nloc = b.st[0], nx = b.st[1];
        if (nloc == 0u) { xcd_barrier_complete(bar, b.x, nloc, nx); b.st[0] = nloc; b.st[1] = nx; }
        const unsigned old = xb_add(&bar[XB_XSUB(b.x)], 1u);
        const unsigned gen = old / nloc;
        if (old + 1u == (gen + 1u) * nloc) {
            __builtin_amdgcn_fence(__ATOMIC_RELEASE, "agent");
            asm volatile("s_waitcnt vmcnt(0)" ::: "memory");
            const unsigned og = xb_add(&bar[XB_TOP], 1u);
            const unsigned tg = og / nx;
            if (og + 1u == (tg + 1u) * nx) xb_add(&bar[XB_TOPGEN], 1u);
            else XB_SPIN(xb_ld(&bar[XB_TOPGEN]) == tg, bar);
            __builtin_amdgcn_fence(__ATOMIC_ACQUIRE, "agent");
            xb_add(&bar[XB_XGEN(b.x)], 1u);
            asm volatile("s_waitcnt vmcnt(0)" ::: "memory");
        } else {
            XB_SPIN(xb_ld(&bar[XB_XGEN(b.x)]) == gen, bar);
            __builtin_amdgcn_fence(__ATOMIC_ACQUIRE, "agent");
            asm volatile("s_waitcnt vmcnt(0)" ::: "memory");
        }
    }
    __syncthreads();
}

struct Args {
    const float* in[28];
    float* out; unsigned char* ws;
    int ph_lo, ph_hi, li, pad;
};
enum { I_XP = 0, I_XS, I_CK, I_CV, I_SCONV, I_SSM, I_SFFN, I_GMIX, I_WIN, I_LQ1, I_LK1, I_LQ2, I_LK2, I_GSUB, I_CONVW, I_CONVB, I_DTB, I_ALOG, I_DSKIP,
       I_GSSM, I_WOUT, I_GFFN, I_WGATE, I_WUP, I_FCW, I_FCB, I_WDOWN, I_GFIN };

struct P0Item { const float* W; const float* g; bf16* WT; int ldw, K, k0, n0, rowbase; };
__device__ __forceinline__ void p0_load(const P0Item& it, f32x4 (&v)[16], int lane) {
    const int rsub = lane >> 4, c4 = 4 * (lane & 15);
#pragma unroll
    for (int i = 0; i < 16; ++i) v[i] = *(const f32x4*)(it.W + (size_t)(it.k0 + 4 * i + rsub) * it.ldw + it.n0 + c4);
}
__device__ __forceinline__ void p0_to_lds(const P0Item& it, const f32x4 (&v)[16], LAS float* scr, int lane) {
    const int rsub = lane >> 4, c4 = 4 * (lane & 15);
#pragma unroll
    for (int i = 0; i < 16; ++i) { const int r = 4 * i + rsub; f32x4 x = v[i]; if (it.g) x = x * it.g[it.k0 + r];
        LAS float* d = scr + r * 65 + c4; d[0] = x[0]; d[1] = x[1]; d[2] = x[2]; d[3] = x[3]; }
    asm volatile("s_waitcnt lgkmcnt(0)" ::: "memory");
}
__device__ __forceinline__ void p0_store(const P0Item& it, LAS float* scr, int lane) {
    const int c = lane & 7;
#pragma unroll
    for (int j = 0; j < 8; ++j) { const int n = (lane >> 3) + 8 * j; const LAS float* sp = scr + (8 * c) * 65 + n;
        v4u o; o.x = pk2(sp[0 * 65], sp[1 * 65]); o.y = pk2(sp[2 * 65], sp[3 * 65]); o.z = pk2(sp[4 * 65], sp[5 * 65]); o.w = pk2(sp[6 * 65], sp[7 * 65]);
        *(GAS v4u*)(it.WT + (size_t)(it.rowbase + n) * it.K + it.k0 + 8 * c) = o; }
    asm volatile("s_waitcnt lgkmcnt(0)" ::: "memory");
}
__device__ __forceinline__ P0Item p0_item(const Args& A, unsigned char* ws, int r) {
    constexpr int I_A = 32 * 88, I_B = 32 * 32, I_C = 32 * 88, I_D = 32 * 88;
    P0Item it;
    if (r < I_A) { it = P0Item{A.in[I_WIN], nullptr, (bf16*)(ws + WS_WIN), DIN, DM, 64 * (r / 88), 64 * (r % 88), 64 * (r % 88)}; return it; } r -= I_A;
    if (r < I_B) { it = P0Item{A.in[I_WOUT], nullptr, (bf16*)(ws + WS_WOUT), DM, DM, 64 * (r / 32), 64 * (r % 32), 64 * (r % 32)}; return it; } r -= I_B;
    if (r < I_C) { const int n0 = 64 * (r % 88); it = P0Item{A.in[I_WGATE], A.in[I_GFFN], (bf16*)(ws + WS_WGU), DFF, DM, 64 * (r / 88), n0, (n0 >> 7) * 256 + (n0 & 127)}; return it; } r -= I_C;
    if (r < I_D) { const int n0 = 64 * (r % 88); it = P0Item{A.in[I_WUP], A.in[I_GFFN], (bf16*)(ws + WS_WGU), DFF, DM, 64 * (r / 88), n0, (n0 >> 7) * 256 + 128 + (n0 & 127)}; return it; } r -= I_D;
    it = P0Item{A.in[I_WDOWN], nullptr, (bf16*)(ws + WS_WDN), DM, DFF, 64 * (r / 32), 64 * (r % 32), 64 * (r % 32)}; return it;
}

struct EpiInProj {
    static constexpr bool PERM = true, AFTER_DRAIN = false;
    bf16 *Q, *K, *V, *Z, *XBC; float* out; unsigned* qk2;
    __device__ __forceinline__ void operator()(const pg8::f32x4 (&acc)[2][2][4][2], const pg8::Unit& u, int wr, int wc, int fr, int fq) const {
        const int region = u.pn >> 2;
        float nmax[2] = {0.f, 0.f};
        const int row0 = u.pm * 256 + wr * 64 + fr;
        const int cl = wc * 32 + 8 * fq;
#pragma unroll
        for (int ai = 0; ai < 2; ++ai)
#pragma unroll
            for (int m = 0; m < 4; ++m) {
                const int row = row0 + ai * 128 + m * 16;
#pragma unroll
                for (int bj = 0; bj < 2; ++bj) {
                    f32x4 v0 = acc[ai][bj][m][0], v1 = acc[ai][bj][m][1];
                    if (region < 4) {
                        const int c = (u.pn & 3) * 256 + bj * 128 + cl;
                        if (region == 0) { v0 = v0 * QSCALE; v1 = v1 * QSCALE; }
                        if (region < 2) { float ss = (v0[0] * v0[0] + v0[1] * v0[1]) + (v0[2] * v0[2] + v0[3] * v0[3]) + (v1[0] * v1[0] + v1[1] * v1[1]) + (v1[2] * v1[2] + v1[3] * v1[3]);
                            ss += __shfl_xor(ss, 16); ss += __shfl_xor(ss, 32); nmax[bj] = fmaxf(nmax[bj], ss); }
                        v4u w; w.x = pk2(v0[0], v0[1]); w.y = pk2(v0[2], v0[3]); w.z = pk2(v1[0], v1[1]); w.w = pk2(v1[2], v1[3]);
                        bf16* dst = region == 0 ? Q : region == 1 ? K : region == 2 ? V : Z;
                        *(v4u*)(dst + (size_t)row * 1024 + c) = w;
                        if (region == 1 || region == 2) {
                            float* o = out + (row < MP ? (region == 1 ? O_KP : O_VP) + (size_t)row * 1024 : (region == 1 ? O_KS : O_VS) + (size_t)(row - MP) * 1024) + c;
                            *(f32x4*)o = v0; *(f32x4*)(o + 4) = v1;
                        }
                    } else {
                        const int c = (u.pn - 16) * 256 + bj * 128 + cl;
                        v4u w; w.x = pk2(v0[0], v0[1]); w.y = pk2(v0[2], v0[3]); w.z = pk2(v1[0], v1[1]); w.w = pk2(v1[2], v1[3]);
                        *(v4u*)(XBC + (size_t)row * 1536 + c) = w;
                        if (row >= MP - 3) {
                            float* o = nullptr;
                            if (row < MP) o = out + O_CP + (size_t)(row - (MP - 3)) * 1536 + c;
                            else { const int rr = row - MP, i = rr & 15; if (i >= 13) o = out + O_CS + (size_t)((rr >> 4) * 3 + (i - 13)) * 1536 + c; }
                            if (o) { *(f32x4*)o = v0; *(f32x4*)(o + 4) = v1; }
                        }
                    }
                }
            }
        if (region < 2 && u.pm < MP / 256) {
#pragma unroll
            for (int bj = 0; bj < 2; ++bj) { float v = nmax[bj]; v = fmaxf(v, __shfl_xor(v, 1)); v = fmaxf(v, __shfl_xor(v, 2)); v = fmaxf(v, __shfl_xor(v, 4)); v = fmaxf(v, __shfl_xor(v, 8));
                if (fr == 0 && fq == 0) atomicMax(qk2 + region * 32 + (u.pn & 3) * 8 + bj * 4 + wc, __float_as_uint(v)); }
        }
    }
};

__device__ __forceinline__ void store_slab(float* slab, const pg8::f32x4 (&acc)[2][2][4][2], int wr, int wc, int fr, int fq) {
#pragma unroll
    for (int ai = 0; ai < 2; ++ai)
#pragma unroll
        for (int m = 0; m < 4; ++m)
#pragma unroll
            for (int bj = 0; bj < 2; ++bj) { float* o = slab + (size_t)(ai * 128 + wr * 64 + m * 16 + fr) * 256 + bj * 128 + wc * 32 + 8 * fq; *(f32x4*)o = acc[ai][bj][m][0]; *(f32x4*)(o + 4) = acc[ai][bj][m][1]; }
}

struct EpiOutProj {
    static constexpr bool PERM = true, AFTER_DRAIN = false;
    const float* xp; const float* xs; float* out; bf16* x1b; float* rs; float* slabs;
    __device__ __forceinline__ void operator()(const pg8::f32x4 (&acc)[2][2][4][2], const pg8::Unit& u, int wr, int wc, int fr, int fq) const {
        if (u.slab >= 0) { store_slab(slabs + (size_t)u.slab * 65536, acc, wr, wc, fr, fq); return; }
        const int row0 = u.pm * 256 + wr * 64 + fr;
        const int c0 = u.pn * 256 + wc * 32 + 8 * fq;
#pragma unroll
        for (int ai = 0; ai < 2; ++ai)
#pragma unroll
        for (int mh = 0; mh < 2; ++mh) {
            f32x4 xr[2][2][2];
#pragma unroll
            for (int m = 0; m < 2; ++m) { const int row = row0 + ai * 128 + (2 * mh + m) * 16; const float* xrow = row < MP ? xp + (size_t)row * DM : xs + (size_t)(row - MP) * DM;
#pragma unroll
                for (int bj = 0; bj < 2; ++bj) { xr[m][bj][0] = *(const f32x4*)(xrow + c0 + bj * 128); xr[m][bj][1] = *(const f32x4*)(xrow + c0 + bj * 128 + 4); } }
            asm volatile("" ::: "memory");
#pragma unroll
            for (int m = 0; m < 2; ++m) {
                const int mm = 2 * mh + m, row = row0 + ai * 128 + mm * 16;
                float ss = 0.f;
#pragma unroll
                for (int bj = 0; bj < 2; ++bj) {
                    const int c = c0 + bj * 128;
                    const f32x4 v0 = acc[ai][bj][mm][0] + xr[m][bj][0], v1 = acc[ai][bj][mm][1] + xr[m][bj][1];
                    v4u w; w.x = pk2(v0[0], v0[1]); w.y = pk2(v0[2], v0[3]); w.z = pk2(v1[0], v1[1]); w.w = pk2(v1[2], v1[3]);
                    *(v4u*)(x1b + (size_t)row * DM + c) = w;
                    ss += (v0[0] * v0[0] + v0[1] * v0[1]) + (v0[2] * v0[2] + v0[3] * v0[3]) + (v1[0] * v1[0] + v1[1] * v1[1]) + (v1[2] * v1[2] + v1[3] * v1[3]);
                }
                ss += __shfl_xor(ss, 16); ss += __shfl_xor(ss, 32);
                if (fq == 0) rs[(size_t)row * 32 + u.pn * 4 + wc] = ss;
            }
        }
    }
};


constexpr int HALO_OFF = 131072;
struct EpiGateUp {
    static constexpr bool PERM = true, AFTER_DRAIN = false;
    bf16* HID; const float* rs; float* out; const float* fcw; const float* fcb; const float* sffn; float* frg; float* fru; float* lrg; LAS unsigned char* lds;
    __device__ __forceinline__ void operator()(const pg8::f32x4 (&acc)[2][2][4][2], const pg8::Unit& u, int wr, int wc, int fr, int fq) const {
        const int row0 = u.pm * 256 + wr * 64 + fr;
        const int cl = wc * 32 + 8 * fq, c = u.pn * 128 + cl;
        const bool sample = u.pm >= MP / 256;
        f32x4 w0[2], w1[2], w2[2], bb[2];
#pragma unroll
        for (int n = 0; n < 2; ++n) { w0[n] = *(const f32x4*)(fcw + c + 4 * n); w1[n] = *(const f32x4*)(fcw + DFF + c + 4 * n); w2[n] = *(const f32x4*)(fcw + 2 * DFF + c + 4 * n); bb[n] = *(const f32x4*)(fcb + c + 4 * n); }
        float rstd8[2][4];
#pragma unroll
        for (int ai = 0; ai < 2; ++ai)
#pragma unroll
            for (int m = 0; m < 4; ++m) rstd8[ai][m] = rs[row0 + ai * 128 + m * 16];
        LAS float* halo = (LAS float*)(lds + HALO_OFF);
        if (!sample) {
#pragma unroll
            for (int ai = 0; ai < 2; ++ai) {
                const float r3 = rstd8[ai][3];
                if (fr >= 14) { LAS float* hp = halo + ((2 * ai + wr) * 2 + (fr - 14)) * 128 + cl; *(LAS f32x4*)hp = acc[ai][0][3][0] * r3; *(LAS f32x4*)(hp + 4) = acc[ai][0][3][1] * r3; }
            }
        }
        asm volatile("s_waitcnt lgkmcnt(0)" ::: "memory"); __builtin_amdgcn_s_barrier(); asm volatile("" ::: "memory");
#pragma unroll
        for (int ai = 0; ai < 2; ++ai) {
            f32x4 gprev[2] = {(f32x4){0.f, 0.f, 0.f, 0.f}, (f32x4){0.f, 0.f, 0.f, 0.f}};
#pragma unroll
            for (int m = 0; m < 4; ++m) {
                const int row = row0 + ai * 128 + m * 16;
                const float rstd = rstd8[ai][m];
                f32x4 gc[2] = {acc[ai][0][m][0] * rstd, acc[ai][0][m][1] * rstd};
                f32x4 pv[2];
                bool defer = false;
                if (sample) {
                    const int b = (row - fr - MP) >> 4;
                    const float* sp = sffn + ((size_t)b * 2 + (fr & 1)) * DFF + c;
                    pv[0] = *(const f32x4*)sp; pv[1] = *(const f32x4*)(sp + 4);
                } else if (m > 0) { pv[0] = gprev[0]; pv[1] = gprev[1]; }
                else {
                    const int gidx = 2 * ai + wr;
                    if (gidx > 0) { const LAS float* hp = halo + ((gidx - 1) * 2 + (fr & 1)) * 128 + cl; pv[0] = *(const LAS f32x4*)hp; pv[1] = *(const LAS f32x4*)(hp + 4); }
                    else { pv[0] = (f32x4){0.f, 0.f, 0.f, 0.f}; pv[1] = pv[0]; defer = u.pm > 0; }
                }
                const f32x4 u0 = acc[ai][1][m][0] * rstd, u1 = acc[ai][1][m][1] * rstd;
                f32x4 h[2];
#pragma unroll
                for (int n = 0; n < 2; ++n)
#pragma unroll
                    for (int e = 0; e < 4; ++e) {
                        const float cur = gc[n][e], pvv = pv[n][e];
                        const int ci = __float_as_int(cur), pi_ = __float_as_int(pvv);
                        const float g1 = __int_as_float(__builtin_amdgcn_update_dpp(__builtin_amdgcn_update_dpp(0, pi_, 0x121, 0xf, 0xf, false), ci, 0x111, 0xf, 0xf, false));
                        const float g2 = __int_as_float(__builtin_amdgcn_update_dpp(__builtin_amdgcn_update_dpp(0, pi_, 0x122, 0xf, 0xf, false), ci, 0x112, 0xf, 0xf, false));
                        const float y = bb[n][e] + w0[n][e] * g2 + w1[n][e] * g1 + w2[n][e] * cur;
                        h[n][e] = siluf(y) * (n == 0 ? u0[e] : u1[e]);
                    }
                if (defer && fr < 2) {
                    float* o = frg + ((size_t)u.pm * 2 + fr) * DFF + c; *(f32x4*)o = gc[0]; *(f32x4*)(o + 4) = gc[1];
                    o = fru + ((size_t)u.pm * 2 + fr) * DFF + c; *(f32x4*)o = u0; *(f32x4*)(o + 4) = u1;
                } else {
                    v4u w; w.x = pk2(h[0][0], h[0][1]); w.y = pk2(h[0][2], h[0][3]); w.z = pk2(h[1][0], h[1][1]); w.w = pk2(h[1][2], h[1][3]);
                    *(v4u*)(HID + (size_t)row * DFF + c) = w;
                }
                if (!sample && ai == 1 && m == 3 && wr == 1 && fr >= 14) { float* o = lrg + ((size_t)u.pm * 2 + (fr - 14)) * DFF + c; *(f32x4*)o = gc[0]; *(f32x4*)(o + 4) = gc[1]; }
                if (row >= MP - 2) {
                    float* o = nullptr;
                    if (row < MP) o = out + O_FP + (size_t)(row - (MP - 2)) * DFF + c;
                    else { const int rr = row - MP, i = rr & 15; if (i >= 14) o = out + O_FS + (size_t)((rr >> 4) * 2 + (i - 14)) * DFF + c; }
                    if (o) { *(f32x4*)o = gc[0]; *(f32x4*)(o + 4) = gc[1]; }
                }
                gprev[0] = gc[0]; gprev[1] = gc[1];
            }
        }
    }
};

struct EpiDown {
    static constexpr bool PERM = true, AFTER_DRAIN = false;
    float* out; float* rs; float* slabs; bf16* x2b;
    __device__ __forceinline__ void operator()(const pg8::f32x4 (&acc)[2][2][4][2], const pg8::Unit& u, int wr, int wc, int fr, int fq) const {
        if (u.slab >= 0) { store_slab(slabs + (size_t)u.slab * 65536, acc, wr, wc, fr, fq); return; }
        const int row0 = u.pm * 256 + wr * 64 + fr;
        const int c0 = u.pn * 256 + wc * 32 + 8 * fq;
#pragma unroll
        for (int ai = 0; ai < 2; ++ai)
#pragma unroll
        for (int mh = 0; mh < 2; ++mh) {
            f32x4 xr[2][2][2];
#pragma unroll
            for (int m = 0; m < 2; ++m) { const bf16* xrow = x2b + (size_t)(row0 + ai * 128 + (2 * mh + m) * 16) * DM;
#pragma unroll
                for (int bj = 0; bj < 2; ++bj) { const v4u w = *(const v4u*)(xrow + c0 + bj * 128);
                    xr[m][bj][0] = (f32x4){bflo(w.x), bfhi(w.x), bflo(w.y), bfhi(w.y)}; xr[m][bj][1] = (f32x4){bflo(w.z), bfhi(w.z), bflo(w.w), bfhi(w.w)}; } }
            asm volatile("" ::: "memory");
#pragma unroll
            for (int m = 0; m < 2; ++m) {
                const int mm = 2 * mh + m, row = row0 + ai * 128 + mm * 16;
                float ss = 0.f;
#pragma unroll
                for (int bj = 0; bj < 2; ++bj) {
                    const f32x4 v0 = acc[ai][bj][mm][0] + xr[m][bj][0], v1 = acc[ai][bj][mm][1] + xr[m][bj][1];
                    v4u w; w.x = pk2(v0[0], v0[1]); w.y = pk2(v0[2], v0[3]); w.z = pk2(v1[0], v1[1]); w.w = pk2(v1[2], v1[3]);
                    *(v4u*)(x2b + (size_t)row * DM + c0 + bj * 128) = w;
                    ss += (v0[0] * v0[0] + v0[1] * v0[1]) + (v0[2] * v0[2] + v0[3] * v0[3]) + (v1[0] * v1[0] + v1[1] * v1[1]) + (v1[2] * v1[2] + v1[3] * v1[3]);
                }
                ss += __shfl_xor(ss, 16); ss += __shfl_xor(ss, 32);
                if (fq == 0) rs[(size_t)row * 32 + u.pn * 4 + wc] = ss;
            }
        }
    }
};

__device__ __forceinline__ int crow(int r, int hi) { return (r & 3) + 8 * (r >> 2) + 4 * hi; }
#define MFMA32(a, b, c) __builtin_amdgcn_mfma_f32_32x32x16_bf16((a), (b), (c), 0, 0, 0)

constexpr int SL_XT = 0, SL_XT_ROW = 144, SL_XT_HEAD = 64 * 144;
constexpr int SL_BN = 73728, SL_N_ROW = 272;
constexpr int SL_CN = SL_BN + 64 * 272;
constexpr int SL_BT = SL_CN + 64 * 272, SL_BT_ROW = 144;
constexpr int SL_DT = SL_BT + 128 * 144;
constexpr int SL_AC = SL_DT + 2048;
constexpr int SL_W = SL_AC + 2048;
constexpr int SL_END = SL_W + 2048;
static_assert(SL_END <= LDSCTL_OFF, "ssd lds");

struct SsdUnit { int cid, g, T, rbase, batch; };
__device__ __forceinline__ SsdUnit ssd_unit(int u) {
    SsdUnit s;
    if (u < 256) { s.cid = u >> 1; s.g = u & 1; s.T = 64; s.rbase = 64 * s.cid; s.batch = -1; }
    else { const int v = u - 256; s.batch = v >> 1; s.g = v & 1; s.cid = 128 + s.batch; s.T = 16; s.rbase = MP + 16 * s.batch; }
    return s;
}

__device__ __forceinline__ void ssd_local(const Args& A, LAS unsigned char* lds, int u) {
    const SsdUnit su = ssd_unit(u);
    int tid_ = threadIdx.x; asm volatile("" : "+v"(tid_));
    const int tid = tid_, lane = tid & 63, wid = __builtin_amdgcn_readfirstlane(tid >> 6), r32 = lane & 31, hi = lane >> 5;
    unsigned char* ws = A.ws;
    const bf16* XBC = (const bf16*)(ws + WS_XBC);
    const float* DT = (const float*)(ws + WS_DT);
    if (tid < 384) {
        const int tq = tid & 3, cgi = tid >> 2, t0 = 16 * tq;
        int col; if (cgi < 64) col = 512 * su.g + 8 * cgi; else if (cgi < 80) col = 1024 + 128 * su.g + 8 * (cgi - 64); else col = 1280 + 128 * su.g + 8 * (cgi - 80);
        unsigned ow[8][8];
        if (t0 < su.T) {
            const float* cw = A.in[I_CONVW]; const float* cbias = A.in[I_CONVB];
            f32x4 wv[4][2], bb[2];
#pragma unroll
            for (int n = 0; n < 2; ++n) { bb[n] = *(const f32x4*)(cbias + col + 4 * n);
#pragma unroll
                for (int k = 0; k < 4; ++k) wv[k][n] = *(const f32x4*)(cw + k * 1536 + col + 4 * n); }
            float hist[3][8];
#pragma unroll
            for (int k = 0; k < 3; ++k) {
                const int t = t0 - 3 + k;
                if (t >= 0 || (su.batch < 0 && su.cid > 0)) {
                    const v4u raw = *(const v4u*)(XBC + (size_t)(su.rbase + t) * 1536 + col);
                    hist[k][0] = bflo(raw.x); hist[k][1] = bfhi(raw.x); hist[k][2] = bflo(raw.y); hist[k][3] = bfhi(raw.y); hist[k][4] = bflo(raw.z); hist[k][5] = bfhi(raw.z); hist[k][6] = bflo(raw.w); hist[k][7] = bfhi(raw.w);
                } else if (su.batch >= 0) {
                    const float* sp = A.in[I_SCONV] + ((size_t)su.batch * 3 + (3 + t)) * 1536 + col;
                    const f32x4 a = *(const f32x4*)sp, b = *(const f32x4*)(sp + 4);
                    hist[k][0] = a[0]; hist[k][1] = a[1]; hist[k][2] = a[2]; hist[k][3] = a[3]; hist[k][4] = b[0]; hist[k][5] = b[1]; hist[k][6] = b[2]; hist[k][7] = b[3];
                } else {
#pragma unroll
                    for (int e = 0; e < 8; ++e) hist[k][e] = 0.f;
                }
            }
            v4u rawv[16];
#pragma unroll
            for (int tt = 0; tt < 16; ++tt) rawv[tt] = *(const v4u*)(XBC + (size_t)(su.rbase + t0 + tt) * 1536 + col);
            float prev[8];
#pragma unroll
            for (int tt = 0; tt < 16; ++tt) {
                const v4u raw = rawv[tt];
                float v[8], o[8]; v[0] = bflo(raw.x); v[1] = bfhi(raw.x); v[2] = bflo(raw.y); v[3] = bfhi(raw.y); v[4] = bflo(raw.z); v[5] = bfhi(raw.z); v[6] = bflo(raw.w); v[7] = bfhi(raw.w);
#pragma unroll
                for (int e = 0; e < 8; ++e) { const float y = bb[e >> 2][e & 3] + wv[0][e >> 2][e & 3] * hist[0][e] + wv[1][e >> 2][e & 3] * hist[1][e] + wv[2][e >> 2][e & 3] * hist[2][e] + wv[3][e >> 2][e & 3] * v[e];
                    o[e] = siluf(y); hist[0][e] = hist[1][e]; hist[1][e] = hist[2][e]; hist[2][e] = v[e]; }
                if (cgi >= 64) {
                    v4u w; w.x = pk2(o[0], o[1]); w.y = pk2(o[2], o[3]); w.z = pk2(o[4], o[5]); w.w = pk2(o[6], o[7]);
                    const int n0 = 8 * ((cgi - 64) & 15), t = t0 + tt;
                    if (cgi < 80) *(LAS v4u*)(lds + SL_BN + t * SL_N_ROW + n0 * 2) = w;
                    else { *(LAS v4u*)(lds + SL_CN + t * SL_N_ROW + n0 * 2) = w; *(v4u*)((bf16*)(ws + WS_CB) + ((size_t)su.cid * 64 + t) * 256 + su.g * 128 + n0) = w; }
                }
                if (tt & 1) {
#pragma unroll
                    for (int e = 0; e < 8; ++e) ow[e][tt >> 1] = pk2(prev[e], o[e]);
                } else {
#pragma unroll
                    for (int e = 0; e < 8; ++e) prev[e] = o[e];
                }
            }
        } else {
#pragma unroll
            for (int e = 0; e < 8; ++e)
#pragma unroll
                for (int k = 0; k < 8; ++k) ow[e][k] = 0u;
            { unsigned z1 = 0u; asm volatile("" : "+v"(z1)); ow[0][0] = z1; }
            if (cgi >= 64) {
                const int n0 = 8 * ((cgi - 64) & 15); unsigned z0 = 0u; asm volatile("" : "+v"(z0)); const v4u z = {z0, z0, z0, z0};
#pragma unroll
                for (int tt = 0; tt < 16; ++tt) { const int t = t0 + tt;
                    if (cgi < 80) *(LAS v4u*)(lds + SL_BN + t * SL_N_ROW + n0 * 2) = z;
                    else { *(LAS v4u*)(lds + SL_CN + t * SL_N_ROW + n0 * 2) = z; *(v4u*)((bf16*)(ws + WS_CB) + ((size_t)su.cid * 64 + t) * 256 + su.g * 128 + n0) = z; } }
            }
        }
        if (cgi < 80) {
            LAS unsigned char* tb_ = cgi < 64 ? lds + SL_XT + (cgi >> 3) * SL_XT_HEAD + (8 * (cgi & 7)) * SL_XT_ROW + t0 * 2 : lds + SL_BT + (8 * (cgi - 64)) * SL_BT_ROW + t0 * 2;
#pragma unroll
            for (int e = 0; e < 8; ++e) { const v4u a = {ow[e][0], ow[e][1], ow[e][2], ow[e][3]}, b = {ow[e][4], ow[e][5], ow[e][6], ow[e][7]};
                *(LAS v4u*)(tb_ + e * SL_XT_ROW) = a; *(LAS v4u*)(tb_ + e * SL_XT_ROW + 16) = b; }
        }
    }
    {
        const int h = 8 * su.g + wid;
        const float dt = lane < su.T ? DT[(size_t)(su.rbase + lane) * 16 + h] : 0.f;
        const float a = -__expf(A.in[I_ALOG][h]);
        float x = dt * a;
#pragma unroll
        for (int off = 1; off < 64; off <<= 1) { const float v = __shfl_up(x, off); if (lane >= off) x += v; }
        const float tot = __shfl(x, 63);
        LAS float* dl = (LAS float*)(lds + SL_DT) + wid * 64; LAS float* al = (LAS float*)(lds + SL_AC) + wid * 64; LAS float* wl = (LAS float*)(lds + SL_W) + wid * 64;
        dl[lane] = dt; al[lane] = x; wl[lane] = __expf(tot - x) * dt;
        ((float*)(ws + WS_ACUM))[((size_t)su.cid * 16 + h) * 64 + lane] = x;
        if (lane == 63) ((float*)(ws + WS_CD))[su.cid * 16 + h] = __expf(tot);
    }
    __syncthreads();
    {
        const int h = 8 * su.g + wid;
        const float dskip = A.in[I_DSKIP][h];
        const LAS unsigned char* bn = lds + SL_BN; const LAS unsigned char* cn = lds + SL_CN; const LAS unsigned char* bt = lds + SL_BT;
        const LAS unsigned char* xt = lds + SL_XT + wid * SL_XT_HEAD;
        const LAS float* dl = (const LAS float*)(lds + SL_DT) + wid * 64; const LAS float* al = (const LAS float*)(lds + SL_AC) + wid * 64; const LAS float* wl = (const LAS float*)(lds + SL_W) + wid * 64;
        f32x16 cb00 = {}, cb01 = {}, cb11 = {};
#pragma unroll
        for (int ks = 0; ks < 8; ++ks) {
            const int kb = (16 * ks + 8 * hi) * 2;
            const bf16x8 b0 = *(const LAS bf16x8*)(bn + r32 * SL_N_ROW + kb), b1 = *(const LAS bf16x8*)(bn + (32 + r32) * SL_N_ROW + kb);
            const bf16x8 c0 = *(const LAS bf16x8*)(cn + r32 * SL_N_ROW + kb), c1 = *(const LAS bf16x8*)(cn + (32 + r32) * SL_N_ROW + kb);
            cb00 = MFMA32(b0, c0, cb00); cb01 = MFMA32(b0, c1, cb01); cb11 = MFMA32(b1, c1, cb11);
        }
        const float at0 = al[r32], at1 = al[32 + r32];
        bf16x8 X00[2], X01[2], X11[2];
        {
            float m00[16], m01[16], m11[16];
#pragma unroll
            for (int r = 0; r < 16; ++r) {
                const int s0 = crow(r, hi), s1 = 32 + s0;
                const float as0 = al[s0], as1 = al[s1], ds0 = dl[s0], ds1 = dl[s1];
                float v = (s0 <= r32) ? cb00[r] * __expf(at0 - as0) * ds0 : 0.f; if (s0 == r32) v += dskip; m00[r] = v;
                m01[r] = cb01[r] * __expf(at1 - as0) * ds0;
                v = (s0 <= r32) ? cb11[r] * __expf(at1 - as1) * ds1 : 0.f; if (s0 == r32) v += dskip; m11[r] = v;
            }
#pragma unroll
            for (int sp = 0; sp < 2; ++sp) {
                v4u w;
                w.x = pk2(m00[8 * sp + 0], m00[8 * sp + 1]); w.y = pk2(m00[8 * sp + 2], m00[8 * sp + 3]); w.z = pk2(m00[8 * sp + 4], m00[8 * sp + 5]); w.w = pk2(m00[8 * sp + 6], m00[8 * sp + 7]); X00[sp] = __builtin_bit_cast(bf16x8, w);
                w.x = pk2(m01[8 * sp + 0], m01[8 * sp + 1]); w.y = pk2(m01[8 * sp + 2], m01[8 * sp + 3]); w.z = pk2(m01[8 * sp + 4], m01[8 * sp + 5]); w.w = pk2(m01[8 * sp + 6], m01[8 * sp + 7]); X01[sp] = __builtin_bit_cast(bf16x8, w);
                w.x = pk2(m11[8 * sp + 0], m11[8 * sp + 1]); w.y = pk2(m11[8 * sp + 2], m11[8 * sp + 3]); w.z = pk2(m11[8 * sp + 4], m11[8 * sp + 5]); w.w = pk2(m11[8 * sp + 6], m11[8 * sp + 7]); X11[sp] = __builtin_bit_cast(bf16x8, w);
            }
        }
        unsigned* yp = (unsigned*)(ws + WS_YP) + ((size_t)su.cid * 16 + h) * 2048 + lane;
#pragma unroll
        for (int pi = 0; pi < 2; ++pi) {
            f32x16 y0 = {}, y1 = {};
#pragma unroll
            for (int i = 0; i < 2; ++i)
#pragma unroll
                for (int sp = 0; sp < 2; ++sp) {
                    const LAS unsigned char* ap = xt + (32 * pi + r32) * SL_XT_ROW + (32 * i + 16 * sp + 4 * hi) * 2;
                    const v2u lo = *(const LAS v2u*)ap, hh = *(const LAS v2u*)(ap + 16);
                    const v4u aw = {lo.x, lo.y, hh.x, hh.y}; const bf16x8 af = __builtin_bit_cast(bf16x8, aw);
                    if (i == 0) { y0 = MFMA32(af, X00[sp], y0); y1 = MFMA32(af, X01[sp], y1); }
                    else y1 = MFMA32(af, X11[sp], y1);
                }
#pragma unroll
            for (int r = 0; r < 16; r += 2) { yp[((pi * 2 + 0) * 8 + (r >> 1)) * 64] = pk2(y0[r], y0[r + 1]); yp[((pi * 2 + 1) * 8 + (r >> 1)) * 64] = pk2(y1[r], y1[r + 1]); }
        }
        bf16* sch = (bf16*)(ws + WS_SCH) + ((size_t)su.cid * 16 + h) * 8192;
#pragma unroll
        for (int pi = 0; pi < 2; ++pi) {
            f32x16 s0 = {}, s1 = {}, s2 = {}, s3 = {};
#pragma unroll
            for (int ks = 0; ks < 4; ++ks) {
                const int sb = 16 * ks + 8 * hi;
                const v4u raw = *(const LAS v4u*)(xt + (32 * pi + r32) * SL_XT_ROW + sb * 2);
                const f32x4 wa = *(const LAS f32x4*)(wl + sb), wb = *(const LAS f32x4*)(wl + sb + 4);
                v4u aw; aw.x = pk2(bflo(raw.x) * wa[0], bfhi(raw.x) * wa[1]); aw.y = pk2(bflo(raw.y) * wa[2], bfhi(raw.y) * wa[3]);
                aw.z = pk2(bflo(raw.z) * wb[0], bfhi(raw.z) * wb[1]); aw.w = pk2(bflo(raw.w) * wb[2], bfhi(raw.w) * wb[3]);
                const bf16x8 xf = __builtin_bit_cast(bf16x8, aw);
                const bf16x8 q0 = *(const LAS bf16x8*)(bt + (0 + r32) * SL_BT_ROW + sb * 2), q1 = *(const LAS bf16x8*)(bt + (32 + r32) * SL_BT_ROW + sb * 2);
                const bf16x8 q2 = *(const LAS bf16x8*)(bt + (64 + r32) * SL_BT_ROW + sb * 2), q3 = *(const LAS bf16x8*)(bt + (96 + r32) * SL_BT_ROW + sb * 2);
                s0 = MFMA32(q0, xf, s0); s1 = MFMA32(q1, xf, s1); s2 = MFMA32(q2, xf, s2); s3 = MFMA32(q3, xf, s3);
            }
            bf16* orow = sch + (size_t)(32 * pi + r32) * 128 + 4 * hi;
#pragma unroll
            for (int q = 0; q < 4; ++q) {
                v2u w;
                w.x = pk2(s0[4 * q], s0[4 * q + 1]); w.y = pk2(s0[4 * q + 2], s0[4 * q + 3]); *(v2u*)(orow + 0 + 8 * q) = w;
                w.x = pk2(s1[4 * q], s1[4 * q + 1]); w.y = pk2(s1[4 * q + 2], s1[4 * q + 3]); *(v2u*)(orow + 32 + 8 * q) = w;
                w.x = pk2(s2[4 * q], s2[4 * q + 1]); w.y = pk2(s2[4 * q + 2], s2[4 * q + 3]); *(v2u*)(orow + 64 + 8 * q) = w;
                w.x = pk2(s3[4 * q], s3[4 * q + 1]); w.y = pk2(s3[4 * q + 2], s3[4 * q + 3]); *(v2u*)(orow + 96 + 8 * q) = w;
            }
        }
    }
    __syncthreads();
}

__device__ __forceinline__ void ssd_scan(const Args& A, int item, int tid) {
    unsigned char* ws = A.ws;
    const int e4 = item * 2048 + 4 * tid, h = __builtin_amdgcn_readfirstlane(e4 >> 13);
    const v2u* SCH = (const v2u*)(ws + WS_SCH) + (e4 >> 2); const float* CD = (const float*)(ws + WS_CD) + h; v2u* HP = (v2u*)(ws + WS_HPREV) + (e4 >> 2);
    float st0 = 0.f, st1 = 0.f, st2 = 0.f, st3 = 0.f;
    for (int c0 = 0; c0 < 128; c0 += 32) {
        v2u sv[32]; float d[32];
#pragma unroll
        for (int k = 0; k < 32; ++k) { sv[k] = SCH[(size_t)(c0 + k) * 32768]; d[k] = CD[(c0 + k) * 16]; }
#pragma unroll
        for (int k = 0; k < 32; ++k) { v2u o; o.x = pk2(st0, st1); o.y = pk2(st2, st3); HP[(size_t)(c0 + k) * 32768] = o;
            st0 = d[k] * st0 + bflo(sv[k].x); st1 = d[k] * st1 + bfhi(sv[k].x); st2 = d[k] * st2 + bflo(sv[k].y); st3 = d[k] * st3 + bfhi(sv[k].y); }
    }
    { f32x4 o = {st0, st1, st2, st3}; *(f32x4*)(A.out + O_SP + e4) = o; }
    for (int b0 = 0; b0 < 32; b0 += 16) {
        v2u sv[16]; float d[16]; f32x4 h0[16];
#pragma unroll
        for (int k = 0; k < 16; ++k) { sv[k] = SCH[(size_t)(128 + b0 + k) * 32768]; d[k] = CD[(128 + b0 + k) * 16]; h0[k] = *(const f32x4*)(A.in[I_SSM] + (size_t)(b0 + k) * 131072 + e4); }
#pragma unroll
        for (int k = 0; k < 16; ++k) { v2u o; o.x = pk2(h0[k][0], h0[k][1]); o.y = pk2(h0[k][2], h0[k][3]); HP[(size_t)(128 + b0 + k) * 32768] = o;
            f32x4 r = {d[k] * h0[k][0] + bflo(sv[k].x), d[k] * h0[k][1] + bfhi(sv[k].x), d[k] * h0[k][2] + bflo(sv[k].y), d[k] * h0[k][3] + bfhi(sv[k].y)};
            *(f32x4*)(A.out + O_SS + (size_t)(b0 + k) * 131072 + e4) = r; }
    }
}

__device__ __forceinline__ void ssd_out(const Args& A, LAS unsigned char* lds, int u) {
    const SsdUnit su = ssd_unit(u);
    int tid_ = threadIdx.x; asm volatile("" : "+v"(tid_));
    const int tid = tid_, lane = tid & 63, wid = __builtin_amdgcn_readfirstlane(tid >> 6), r32 = lane & 31, hi = lane >> 5;
    unsigned char* ws = A.ws;
    const int h = 8 * su.g + wid;
    const bf16* HP = (const bf16*)(ws + WS_HPREV) + ((size_t)su.cid * 16 + h) * 8192;
    const bf16* CB = (const bf16*)(ws + WS_CB) + (size_t)su.cid * 64 * 256 + su.g * 128;
    const float* acum = (const float*)(ws + WS_ACUM) + ((size_t)su.cid * 16 + h) * 64;
    const unsigned* yp = (const unsigned*)(ws + WS_YP) + ((size_t)su.cid * 16 + h) * 2048 + lane;
    const bf16* Z = (const bf16*)(ws + WS_Z);
    float ac_[2]; v2u zz_[2][2][4]; unsigned ya_[2][2][4], yb_[2][2][4]; f32x4 gg_[2][4];
    { const float* gn0 = A.in[I_GSSM] + 512 * su.g + 64 * wid + 4 * hi;
#pragma unroll
      for (int pi = 0; pi < 2; ++pi)
#pragma unroll
        for (int q = 0; q < 4; ++q) gg_[pi][q] = *(const f32x4*)(gn0 + 32 * pi + 8 * q); }
#pragma unroll
    for (int j = 0; j < 2; ++j) {
        const int t = 32 * j + r32;
        ac_[j] = acum[t];
        const bf16* zr = Z + (size_t)(su.rbase + (t < su.T ? t : 0)) * 1024 + 512 * su.g + 64 * wid;
#pragma unroll
        for (int pi = 0; pi < 2; ++pi)
#pragma unroll
            for (int q = 0; q < 4; ++q) { zz_[j][pi][q] = *(const v2u*)(zr + 32 * pi + 8 * q + 4 * hi);
                ya_[j][pi][q] = yp[((pi * 2 + j) * 8 + 2 * q + 0) * 64]; yb_[j][pi][q] = yp[((pi * 2 + j) * 8 + 2 * q + 1) * 64]; }
    }
    f32x16 acc[2][2] = {};
#pragma unroll
    for (int kh = 0; kh < 2; ++kh) {
        bf16x8 fa0[4], fa1[4], fb0[4], fb1[4];
#pragma unroll
        for (int k = 0; k < 4; ++k) { const int kb = 16 * (4 * kh + k) + 8 * hi;
            fa0[k] = *(const bf16x8*)(HP + (size_t)r32 * 128 + kb); fa1[k] = *(const bf16x8*)(HP + (size_t)(32 + r32) * 128 + kb);
            fb0[k] = *(const bf16x8*)(CB + (size_t)r32 * 256 + kb); fb1[k] = *(const bf16x8*)(CB + (size_t)(32 + r32) * 256 + kb); }
#pragma unroll
        for (int k = 0; k < 4; ++k) { acc[0][0] = MFMA32(fa0[k], fb0[k], acc[0][0]); acc[0][1] = MFMA32(fa0[k], fb1[k], acc[0][1]); acc[1][0] = MFMA32(fa1[k], fb0[k], acc[1][0]); acc[1][1] = MFMA32(fa1[k], fb1[k], acc[1][1]); }
    }
    float ssq[2] = {0.f, 0.f};
#pragma unroll
    for (int j = 0; j < 2; ++j) {
        const float ea = __expf(ac_[j]);
#pragma unroll
        for (int pi = 0; pi < 2; ++pi)
#pragma unroll
            for (int q = 0; q < 4; ++q) {
                const v2u zz = zz_[j][pi][q];
                const float z0 = bflo(zz.x), z1 = bfhi(zz.x), z2 = bflo(zz.y), z3 = bfhi(zz.y);
                const unsigned ya = ya_[j][pi][q], yb = yb_[j][pi][q];
                float y;
                y = (bflo(ya) + ea * acc[pi][j][4 * q + 0]) * siluf(z0); acc[pi][j][4 * q + 0] = y; ssq[j] += y * y;
                y = (bfhi(ya) + ea * acc[pi][j][4 * q + 1]) * siluf(z1); acc[pi][j][4 * q + 1] = y; ssq[j] += y * y;
                y = (bflo(yb) + ea * acc[pi][j][4 * q + 2]) * siluf(z2); acc[pi][j][4 * q + 2] = y; ssq[j] += y * y;
                y = (bfhi(yb) + ea * acc[pi][j][4 * q + 3]) * siluf(z3); acc[pi][j][4 * q + 3] = y; ssq[j] += y * y;
            }
        ssq[j] += __shfl_xor(ssq[j], 32);
    }
    LAS float* red = (LAS float*)lds;
    if (hi == 0) { red[wid * 64 + r32] = ssq[0]; red[wid * 64 + 32 + r32] = ssq[1]; }
    __syncthreads();
    bf16* A2 = (bf16*)(ws + WS_A2);
#pragma unroll
    for (int j = 0; j < 2; ++j) {
        const int t = 32 * j + r32;
        float tot = 0.f;
#pragma unroll
        for (int w = 0; w < 8; ++w) tot += red[w * 64 + t];
        const float rstd = 1.0f / sqrtf(tot * (1.0f / 512.f) + EPS);
        if (t < su.T) {
            bf16* orow = A2 + (size_t)(su.rbase + t) * 2048 + 1024 + 512 * su.g + 64 * wid;
#pragma unroll
            for (int pi = 0; pi < 2; ++pi)
#pragma unroll
                for (int q = 0; q < 4; ++q) {
                    const int p = 32 * pi + 8 * q + 4 * hi;
                    const f32x4 gg = gg_[pi][q];
                    v2u w; w.x = pk2(acc[pi][j][4 * q + 0] * rstd * gg[0], acc[pi][j][4 * q + 1] * rstd * gg[1]); w.y = pk2(acc[pi][j][4 * q + 2] * rstd * gg[2], acc[pi][j][4 * q + 3] * rstd * gg[3]);
                    *(v2u*)(orow + p) = w;
                }
        }
    }
    __syncthreads();
}

namespace att {
constexpr int KVBLK = 64;
constexpr int SHM_V = 64 * 128 * 2, SHM_K = 64 * 128 * 2;
constexpr int NSLOT = 3;
constexpr int L_V = 0, L_K = NSLOT * SHM_V, L_WS = L_K + NSLOT * SHM_K, L_EX = 0  , L_END = L_WS + NWAVES * 128 * 4;
static_assert(4 * 16384 <= L_WS, "exchange slots fit under the rings");
static_assert(L_END <= LDSCTL_OFF, "attn lds");
constexpr float THR = 6.f;
#define KSWZ(row, colB) ((row) * 256 + ((colB) ^ (((row) & 15) << 4)))
#define SBAR() __builtin_amdgcn_sched_barrier(0)
__device__ __forceinline__ unsigned cvtpk(float lo, float hi) { return pg8::cvt_pk_bf16(lo, hi); }
template <typename TIn> struct Stage;
template <> struct Stage<bf16>  { using T = bf16x8;
  __device__ static __forceinline__ T ld8(const bf16* p) { return *reinterpret_cast<const bf16x8*>(p); }
  __device__ static __forceinline__ bf16x8 tobf(T x) { return x; } };
template <> struct Stage<float> { using T = f32x8;
  __device__ static __forceinline__ T ld8(const float* p) { return *reinterpret_cast<const f32x8*>(p); }
  __device__ static __forceinline__ bf16x8 tobf(T x) {
    v4u w = {cvtpk(x[0], x[1]), cvtpk(x[2], x[3]), cvtpk(x[4], x[5]), cvtpk(x[6], x[7])}; return __builtin_bit_cast(bf16x8, w); } };

__device__ __forceinline__ void partialSM(f32x16& p0, f32x16& p1, float& m_reg, float& mn, float& alpha, float base, float c32) {
  float pm0 = p0[0]; for (int r = 1; r < 16; ++r) pm0 = fmaxf(pm0, p0[r]);
  float pm1 = p1[0]; for (int r = 1; r < 16; ++r) pm1 = fmaxf(pm1, p1[r]);
  float pmax = fmaxf(pm0, pm1 + c32) + base;
  { auto rr = __builtin_amdgcn_permlane32_swap(__float_as_uint(pmax), __float_as_uint(pmax), false, false);
    pmax = fmaxf(__uint_as_float(rr[0]), __uint_as_float(rr[1])); }
  if (__builtin_expect(__all(pmax - m_reg <= THR), 1)) { mn = m_reg; alpha = 1.f; }
  else { mn = fmaxf(m_reg, pmax); alpha = __builtin_amdgcn_exp2f(m_reg - mn); m_reg = mn; }
  const float off0 = base - mn, off1 = off0 + c32;
  for (int r = 0; r < 16; ++r) p0[r] = __builtin_amdgcn_exp2f(p0[r] + off0);
  for (int r = 0; r < 16; ++r) p1[r] = p1[r] + off1;
}
__device__ __forceinline__ void finishSM(f32x16& p0, f32x16& p1, float alpha, float& l_reg, bf16x8& pa0, bf16x8& pa1, bf16x8& pa2, bf16x8& pa3) {
  for (int r = 0; r < 16; ++r) p1[r] = __builtin_amdgcn_exp2f(p1[r]);
  float ps = 0; for (int r = 0; r < 16; ++r) ps += p0[r]; for (int r = 0; r < 16; ++r) ps += p1[r];
  { auto rr = __builtin_amdgcn_permlane32_swap(__float_as_uint(ps), __float_as_uint(ps), false, false);
    ps = __uint_as_float(rr[0]) + __uint_as_float(rr[1]); }
  l_reg = l_reg * alpha + ps;
#define PK4(P, BASE, OUT) do { unsigned a0 = cvtpk(P[BASE + 0], P[BASE + 1]), a1 = cvtpk(P[BASE + 2], P[BASE + 3]);   \
    unsigned b0 = cvtpk(P[BASE + 4], P[BASE + 5]), b1 = cvtpk(P[BASE + 6], P[BASE + 7]);                              \
    auto r0 = __builtin_amdgcn_permlane32_swap(a0, b0, false, false); auto r1 = __builtin_amdgcn_permlane32_swap(a1, b1, false, false); \
    v4u w = {r0[0], r1[0], r0[1], r1[1]}; OUT = __builtin_bit_cast(bf16x8, w); } while (0)
  PK4(p0, 0, pa0); PK4(p0, 8, pa1); PK4(p1, 0, pa2); PK4(p1, 8, pa3);
#undef PK4
}
__device__ __forceinline__ void qkt(f32x16& p0, f32x16& p1, const char* Ks, const bf16x8* qr, const float* kc, int r32, int hi, int mapoff) {
  { const f32x4 k0 = *(const f32x4*)kc, k1 = *(const f32x4*)(kc + 4), k2 = *(const f32x4*)(kc + 8), k3 = *(const f32x4*)(kc + 12);
    p0 = (f32x16){k0[0], k0[1], k0[2], k0[3], k1[0], k1[1], k1[2], k1[3], k2[0], k2[1], k2[2], k2[3], k3[0], k3[1], k3[2], k3[3]}; p1 = p0; }
  bf16x8 bk[8];
#pragma unroll
  for (int d0 = 0; d0 < 4; ++d0) { const int cb = (mapoff + d0 * 16 + hi * 8) * 2;
    bk[2 * d0] = *reinterpret_cast<const bf16x8*>(Ks + KSWZ(r32, cb));
    bk[2 * d0 + 1] = *reinterpret_cast<const bf16x8*>(Ks + KSWZ(32 + r32, cb)); }
  asm volatile("s_waitcnt lgkmcnt(0)" ::: "memory"); SBAR();
#pragma unroll
  for (int d0 = 0; d0 < 4; ++d0) {
    p0 = __builtin_amdgcn_mfma_f32_32x32x16_bf16(bk[2 * d0], qr[d0], p0, 0, 0, 0);
    p1 = __builtin_amdgcn_mfma_f32_32x32x16_bf16(bk[2 * d0 + 1], qr[d0], p1, 0, 0, 0); }
}
__device__ __forceinline__ int v_st(int k, int c) { const int kk = (k & ~0xC) | ((k & 4) << 1) | ((k & 8) >> 1); return ((kk >> 3) * 4 + (c >> 5)) * 512 + ((kk & 7) * 32 + (c & 31)) * 2; }
__device__ __forceinline__ int v_rd_base(int lane) { return ((lane & 3) << 3) | (((lane >> 2) & 3) << 6) | (((lane >> 4) & 1) << 5) | (((lane >> 5) & 1) << 8); }
constexpr int v_rd_off(int d0, int ks, int half) { return d0 * 512 + ks * 4096 + half * 2048; }
template <int OFF> __device__ __forceinline__ s16x4 tr_read(int vb) {
  s16x4 r; asm volatile("ds_read_b64_tr_b16 %0, %1 offset:%2" : "=&v"(r) : "v"(vb), "i"(OFF) : "memory"); return r;
}
template <int D0> __device__ __forceinline__ void pv_one(f32x16& od, int vb, bf16x8 pa0, bf16x8 pa1, bf16x8 pa2, bf16x8 pa3) {
  const s16x4 l0 = tr_read<v_rd_off(D0, 0, 0)>(vb), h0 = tr_read<v_rd_off(D0, 0, 1)>(vb), l1 = tr_read<v_rd_off(D0, 1, 0)>(vb), h1 = tr_read<v_rd_off(D0, 1, 1)>(vb);
  const s16x4 l2 = tr_read<v_rd_off(D0, 2, 0)>(vb), h2 = tr_read<v_rd_off(D0, 2, 1)>(vb), l3 = tr_read<v_rd_off(D0, 3, 0)>(vb), h3 = tr_read<v_rd_off(D0, 3, 1)>(vb);
  asm volatile("s_waitcnt lgkmcnt(0)" ::: "memory"); SBAR();
#define PK(L, H) (bf16x8){L[0], L[1], L[2], L[3], H[0], H[1], H[2], H[3]}
  od = __builtin_amdgcn_mfma_f32_32x32x16_bf16(pa0, PK(l0, h0), od, 0, 0, 0);
  od = __builtin_amdgcn_mfma_f32_32x32x16_bf16(pa1, PK(l1, h1), od, 0, 0, 0);
  od = __builtin_amdgcn_mfma_f32_32x32x16_bf16(pa2, PK(l2, h2), od, 0, 0, 0);
  od = __builtin_amdgcn_mfma_f32_32x32x16_bf16(pa3, PK(l3, h3), od, 0, 0, 0);
#undef PK
}
__device__ __forceinline__ void pv_d0(f32x16* o, int vb, bf16x8 pa0, bf16x8 pa1, bf16x8 pa2, bf16x8 pa3) {
  pv_one<0>(o[0], vb, pa0, pa1, pa2, pa3); pv_one<1>(o[1], vb, pa0, pa1, pa2, pa3); pv_one<2>(o[2], vb, pa0, pa1, pa2, pa3); pv_one<3>(o[3], vb, pa0, pa1, pa2, pa3);
}

struct SrcPrompt {
  const bf16* Kh; const bf16* Vh;
  __device__ __forceinline__ const bf16* kp(int t) const { return Kh + (size_t)t * 64 * 1024; }
  __device__ __forceinline__ const bf16* vp(int t) const { return Vh + (size_t)t * 64 * 1024; }
  __device__ __forceinline__ int nvalid(int) const { return 64; }
};
struct SrcSample {
  const float* Kc; const float* Vc; const float* Kn; const float* Vn;
  __device__ __forceinline__ const float* kp(int t) const { return t < 16 ? Kc + (size_t)t * 64 * 1024 : Kn; }
  __device__ __forceinline__ const float* vp(int t) const { return t < 16 ? Vc + (size_t)t * 64 * 1024 : Vn; }
  __device__ __forceinline__ int nvalid(int t) const { return t < 16 ? 64 : 16; }
};

template <typename TKV, int SD, int nvd, bool FIX, class Src>
__device__ __forceinline__ void attn_core(f32x16 (&o)[4], const bf16* qrow, float qposf, float c, int cq, int t0, int NT, const Src& src, char* lds, LAS unsigned char* lds3, int mapoff, float kmaxn, bool cw) {
  using St = Stage<TKV>;
  int tid_ = threadIdx.x; asm volatile("" : "+v"(tid_));
  const int tid = tid_, wid = tid >> 6, lane = tid & 63, r32 = lane & 31, hi = lane >> 5;
  char* V_lds = lds + L_V; char* K_lds = lds + L_K;
  float* wsf = (float*)(lds + L_WS) + wid * 128; float* li_l = wsf; float* al_l = wsf + 32; float* kc = wsf + 64;
  float m_reg = -1e30f, l_reg = 0; bf16x8 qr[4];
#pragma unroll
  for (int d = 0; d < 4; ++d) o[d] = f32x16{};
#pragma unroll
  for (int d0 = 0; d0 < 4; ++d0) qr[d0] = *reinterpret_cast<const bf16x8*>(qrow + d0 * 16);
  if (lane < 16) kc[lane] = c * (float)((lane & 3) + 8 * (lane >> 2));
  asm volatile("s_waitcnt lgkmcnt(0)" ::: "memory");
  const float c32 = 32.f * c, c2 = 2.f * c;
  const float qrel = (float)(4 * hi) - qposf;
  const int sr = tid >> 4, sc = (tid & 15) * 8, vst0 = v_st(sr, sc), kst0 = KSWZ(sr, sc * 2);
  const int vb0 = (int)(uintptr_t)V_lds + v_rd_base(lane);
  struct { typename St::T vs0, vs1, ks0, ks1; } sr_[SD];
#define SLOAD(i, t) do { const int nv_ = src.nvalid(t); const int r0_ = sr < nv_ ? sr : nv_ - 1, r1_ = 32 + sr < nv_ ? 32 + sr : nv_ - 1; \
    const TKV* kp_ = src.kp(t); const TKV* vp_ = src.vp(t); \
    sr_[i].vs0 = St::ld8(vp_ + (size_t)r0_ * 1024 + sc); sr_[i].vs1 = St::ld8(vp_ + (size_t)r1_ * 1024 + sc); \
    sr_[i].ks0 = St::ld8(kp_ + (size_t)r0_ * 1024 + sc); sr_[i].ks1 = St::ld8(kp_ + (size_t)r1_ * 1024 + sc); } while (0)
#define SWRITE(b, i) do { *(bf16x8*)(V_lds + (b) * SHM_V + vst0) = St::tobf(sr_[i].vs0);          \
    *(bf16x8*)(V_lds + (b) * SHM_V + vst0 + 8192) = St::tobf(sr_[i].vs1);               \
    *(bf16x8*)(K_lds + (b) * SHM_K + kst0) = St::tobf(sr_[i].ks0);                       \
    *(bf16x8*)(K_lds + (b) * SHM_K + kst0 + 8192) = St::tobf(sr_[i].ks1); } while (0)
#define SWRITE3(off, i) do { *(bf16x8*)(V_lds + (off) + vst0) = St::tobf(sr_[i].vs0);          \
    *(bf16x8*)(V_lds + (off) + vst0 + 8192) = St::tobf(sr_[i].vs1);               \
    *(bf16x8*)(K_lds + (off) + kst0) = St::tobf(sr_[i].ks0);                       \
    *(bf16x8*)(K_lds + (off) + kst0 + 8192) = St::tobf(sr_[i].ks1); } while (0)
#define SWAIT() do { if constexpr (SD == 2) asm volatile("s_waitcnt vmcnt(4)" ::: "memory"); else asm volatile("s_waitcnt vmcnt(0)" ::: "memory"); } while (0)
#define RESC(a) do { if (__any((a) < 1.f)) { int tl_ = threadIdx.x; asm volatile("" : "+v"(tl_)); const int hi_ = (tl_ >> 5) & 1; if (hi_ == 0) al_l[tl_ & 31] = (a); asm volatile("s_waitcnt lgkmcnt(0)" ::: "memory"); \
    for (int d = 0; d < 4; ++d) for (int r = 0; r < 16; ++r) o[d][r] *= al_l[crow(r, hi_)]; } } while (0)
#define POST(P0, P1, t) do { if ((t) == cq) { const float d0_ = (float)(64 * (t)) + qrel; \
      for (int r = 0; r < 16; ++r) { const float d_ = d0_ + (float)((r & 3) + 8 * (r >> 2)); P0[r] -= c2 * fmaxf(d_, 0.f); P1[r] -= c2 * fmaxf(d_ + 32.f, 0.f); } \
      if (nvd < 64) { for (int r = 0; r < 16; ++r) { const int kk_ = crow(r, hi); if (kk_ >= nvd) P0[r] = -1e30f; if (kk_ + 32 >= nvd) P1[r] = -1e30f; } } } } while (0)
#define BASE(t) ((t) > cq ? -1e30f : c * ((float)(64 * (t)) + qrel))
  if constexpr (SD == 2) {
  f32x16 p0, p1; float mn, al; bf16x8 pa0, pa1, pa2, pa3;
  SLOAD(0, t0); SLOAD(1, t0 + 1); SWRITE(0, 0); __syncthreads();
#define STEP1(t, bsel, nset, cset, havenext, haveload) do { \
    { const int tl2_ = (t) + 2 < NT ? (t) + 2 : NT - 1; (void)(haveload); SLOAD(cset, tl2_); }        \
    SBAR(); if (cw) { qkt(p0, p1, K_lds + (bsel) * SHM_K, qr, kc, r32, hi, mapoff); POST(p0, p1, t); \
    partialSM(p0, p1, m_reg, mn, al, BASE(t), c32); RESC(al); \
    finishSM(p0, p1, al, l_reg, pa0, pa1, pa2, pa3); SBAR(); \
    pv_d0(o, vb0 + (bsel) * SHM_V, pa0, pa1, pa2, pa3); } \
    if (havenext) { SWRITE((bsel) ^ 1, nset); } \
    __syncthreads(); } while (0)
  for (int t = t0; t < NT; t += 2) {
    STEP1(t, 0, 1, 0, true, t + 2 < NT);
    STEP1(t + 1, 1, 0, 1, t + 2 < NT, t + 3 < NT);
  }
#undef STEP1
  } else {
  f32x16 C0, C1; float mn = 0.f, al = 1.f; bf16x8 pa0, pa1, pa2, pa3;
  const int n_ = NT - t0;
  unsigned ksrc0, vsrc0;
  { const int L = tid * 16;
    { const int row = L >> 8, csw = (L >> 4) & 15; ksrc0 = (unsigned)(row * 1024 + ((csw ^ (row & 15)) * 8)) * 2u; }
    { const int st = L >> 9, within = (L & 511) >> 1, kk = (st >> 2) * 8 + (within >> 5), cc = (st & 3) * 32 + (within & 31), k = (kk & ~0xC) | ((kk & 4) << 1) | ((kk & 8) >> 1); vsrc0 = (unsigned)(k * 1024 + cc) * 2u; } }
  const unsigned ldsb = (unsigned)__builtin_amdgcn_readfirstlane((int)((unsigned)(uintptr_t)lds3 + (unsigned)wid * 1024u));
#define GLDS16(gp, la) do { unsigned sv_; asm volatile("s_mov_b32 %0, m0\n\ts_mov_b32 m0, %2\n\ts_nop 0\n\tglobal_load_lds_dwordx4 %1, off\n\ts_mov_b32 m0, %0" : "=&s"(sv_) : "v"(gp), "s"(la) : "memory"); } while (0)
#define DMA_K(off, t) do { const char* kp_ = (const char*)src.kp(t) + ksrc0; GLDS16(kp_, ldsb + (unsigned)(L_K + (off))); GLDS16(kp_ + 65536, ldsb + (unsigned)(L_K + 8192 + (off))); } while (0)
#define DMA_V(off, t) do { const char* vp_ = (const char*)src.vp(t) + vsrc0; GLDS16(vp_, ldsb + (unsigned)(L_V + (off))); GLDS16(vp_ + 65536, ldsb + (unsigned)(L_V + 8192 + (off))); } while (0)
#define WAIT_BAR(N) asm volatile("s_waitcnt vmcnt(" #N ") lgkmcnt(0)\n\ts_barrier" ::: "memory")
  float mref = 0.f;
  if constexpr (FIX) {
    float q2 = 0.f;
#pragma unroll
    for (int d0 = 0; d0 < 4; ++d0) { const v4u w = __builtin_bit_cast(v4u, qr[d0]);
      q2 += bflo(w.x) * bflo(w.x) + bfhi(w.x) * bfhi(w.x) + bflo(w.y) * bflo(w.y) + bfhi(w.y) * bfhi(w.y) + bflo(w.z) * bflo(w.z) + bfhi(w.z) * bfhi(w.z) + bflo(w.w) * bflo(w.w) + bfhi(w.w) * bfhi(w.w); }
    { auto rr = __builtin_amdgcn_permlane32_swap(__float_as_uint(q2), __float_as_uint(q2), false, false); q2 = __uint_as_float(rr[0]) + __uint_as_float(rr[1]); }
    mref = 1.02f * sqrtf(q2) * kmaxn + 0.5f;
  }
#define SOFTMAX(t_) do { POST(C0, C1, t_); \
    if constexpr (FIX) { const float off0_ = BASE(t_) - mref, off1_ = off0_ + c32; \
      for (int r = 0; r < 16; ++r) C0[r] = __builtin_amdgcn_exp2f(C0[r] + off0_); for (int r = 0; r < 16; ++r) C1[r] = C1[r] + off1_; } \
    else { partialSM(C0, C1, m_reg, mn, al, BASE(t_), c32); RESC(al); } \
    finishSM(C0, C1, al, l_reg, pa0, pa1, pa2, pa3); } while (0)
  int s_prev = 32768, s_cur = 0, s_next = 16384;
#define ROT3() do { s_prev = s_cur; s_cur = s_next; s_next = s_next == 32768 ? 0 : s_next + 16384; asm volatile("" : "+s"(s_prev), "+s"(s_cur), "+s"(s_next)); } while (0)
#define ISSUE(i_) do { if ((i_) + 2 < n_) { DMA_K(s_prev, t0 + (i_) + 2); } if ((i_) + 1 < n_) { DMA_V(s_next, t0 + (i_) + 1); } } while (0)
#define ENDW(i_) do { if ((i_) + 2 < n_) { WAIT_BAR(4); } else if ((i_) + 1 < n_) { WAIT_BAR(2); } else { WAIT_BAR(0); } } while (0)
  DMA_K(0, t0); DMA_K(16384, t0 + 1); DMA_V(0, t0); ISSUE(0);
  if (2 < n_) { WAIT_BAR(8); } else { WAIT_BAR(6); }
  if (wid < 4) {
    qkt(C0, C1, K_lds, qr, kc, r32, hi, mapoff); SOFTMAX(t0); SBAR();
    ENDW(0); ROT3();
    for (int i = 1; i < n_; ++i) { const int t_ = t0 + i;
      ISSUE(i);
      SBAR(); qkt(C0, C1, K_lds + s_cur, qr, kc, r32, hi, mapoff);
      pv_d0(o, vb0 + s_prev, pa0, pa1, pa2, pa3); SBAR();
      SOFTMAX(t_); SBAR();
      ENDW(i); ROT3(); }
    pv_d0(o, vb0 + s_prev, pa0, pa1, pa2, pa3);
  } else {
    qkt(C0, C1, K_lds, qr, kc, r32, hi, mapoff); SBAR();
    ENDW(0); ROT3();
    for (int i = 1; i < n_; ++i) { const int t_ = t0 + i;
      ISSUE(i);
      SBAR(); SOFTMAX(t_ - 1); SBAR();
      pv_d0(o, vb0 + s_prev, pa0, pa1, pa2, pa3);
      qkt(C0, C1, K_lds + s_cur, qr, kc, r32, hi, mapoff); SBAR();
      ENDW(i); ROT3(); }
    SOFTMAX(t0 + n_ - 1); SBAR();
    pv_d0(o, vb0 + s_prev, pa0, pa1, pa2, pa3);
  }
#undef ISSUE
#undef ENDW
#undef SOFTMAX
#undef ROT3
#undef GLDS16
#undef DMA_K
#undef DMA_V
#undef WAIT_BAR
  }
  { int tl_ = threadIdx.x; asm volatile("" : "+v"(tl_)); const int hi_ = (tl_ >> 5) & 1;
  if (hi_ == 0) li_l[tl_ & 31] = l_reg; asm volatile("s_waitcnt lgkmcnt(0)" ::: "memory");
#pragma unroll
  for (int r = 0; r < 16; ++r) { const float rl = __builtin_amdgcn_rcpf(li_l[crow(r, hi_)]);
#pragma unroll
    for (int d = 0; d < 4; ++d) o[d][r] *= rl; } }
#undef SLOAD
#undef SWRITE
#undef SWRITE3
#undef SWAIT
#undef RESC
#undef POST
#undef BASE
}

__device__ __forceinline__ void attn_finish(f32x16 (&o)[4], float lam, const float* gsub, bf16* A2h, int rowbase, int nrows, bool store, char* lds, int exslot, bool act) {
  int tid_ = threadIdx.x; asm volatile("" : "+v"(tid_));
  const int tid = tid_, wid = tid >> 6, lane = tid & 63, r32 = lane & 31, hi = lane >> 5;
  float* ex = (float*)(lds + L_EX) + (exslot < 0 ? (wid & 3) : exslot) * 4096 + lane;
  __syncthreads();
  if (wid >= 4 && act) {
#pragma unroll
    for (int d = 0; d < 4; ++d)
#pragma unroll
      for (int r = 0; r < 16; ++r) ex[(d * 16 + r) * 64] = lam * o[d][r];
  }
  __syncthreads();
  if (wid < 4 && act) {
    float g[4];
#pragma unroll
    for (int d = 0; d < 4; ++d) g[d] = gsub[32 * d + r32] * (1.0f - LAM_INIT);
#pragma unroll
    for (int r = 0; r < 16; ++r) {
      float ss = 0.f;
#pragma unroll
      for (int d = 0; d < 4; ++d) { const float a = o[d][r] - ex[(d * 16 + r) * 64]; o[d][r] = a; ss += a * a; }
      ss += __shfl_xor(ss, 1); ss += __shfl_xor(ss, 2); ss += __shfl_xor(ss, 4); ss += __shfl_xor(ss, 8); ss += __shfl_xor(ss, 16);
      const float rstd = 1.0f / sqrtf(ss * (1.0f / 128.f) + EPS);
#pragma unroll
      for (int d = 0; d < 4; ++d) o[d][r] *= rstd * g[d];
    }
    unsigned short* stg = (unsigned short*)(lds + L_EX) + (wid & 3) * 8192;
#pragma unroll
    for (int r = 0; r < 16; ++r) {
      const int row = crow(r, hi);
#pragma unroll
      for (int d = 0; d < 4; ++d) stg[row * 136 + 32 * d + r32] = (unsigned short)f2bf(o[d][r]);
    }
    asm volatile("s_waitcnt lgkmcnt(0)" ::: "memory");
    if (store) {
#pragma unroll
      for (int i = 0; i < 8; ++i) {
        const int id = lane + 64 * i, row = id >> 4, c16 = id & 15;
        if (row < nrows) *(v4u*)(A2h + (size_t)(rowbase + row) * 2048 + c16 * 8) = *(const v4u*)(stg + row * 136 + c16 * 8);
      }
    }
  }
  __syncthreads();
}
#undef SBAR
}

constexpr int N_PHASES = 8;
constexpr int NSL5 = 8, NSL9 = 11;
constexpr int N_LAUNCHES = MK_N_LAUNCHES;

__global__ void __launch_bounds__(NWAVES * 64, 2) hymba_fwd(Args args) {
    extern __shared__ __attribute__((aligned(16))) unsigned char lds_raw[];
    LAS unsigned char* lds = (LAS unsigned char*)lds_raw;
    volatile LAS unsigned* MISC = (volatile LAS unsigned*)(lds + LDSCTL_OFF);
    const int tid = threadIdx.x, lane = tid & 63, wave = __builtin_amdgcn_readfirstlane(tid >> 6);
    const int G = gridDim.x; const int bx = blockIdx.x;
    const int vcu = (G % 8 == 0) ? (bx % 8) * (G / 8) + bx / 8 : bx;
    unsigned char* ws = args.ws;
    gu32* ctl = (gu32*)(ws + WS_CTL);
    for (int u = tid; u < (LDS_BYTES - LDSCTL_OFF) / 4; u += NWAVES * 64) ((LAS unsigned*)(lds + LDSCTL_OFF))[u] = 0u;
    __syncthreads();
    XcdBarrier bar; bar.bar = (unsigned*)(ctl + CW_BAR); bar.x = 0; bar.st = nullptr;
    if (N_LAUNCHES == 1) bar = xcd_barrier_post((unsigned*)(ctl + CW_BAR), MISC + 8);
    const int lo = args.ph_lo, hi_ph = args.ph_hi;
#ifndef PHASE_MASK
#define PHASE_MASK 0xff
#endif
#define IN(k) (((PHASE_MASK >> (k)) & 1) && lo <= (k) && (k) < hi_ph)
#ifdef PROBE_PHASE
    unsigned long long pr_a = 0, pr_b = 0;
#define PSTART(k) do { if ((k) == PROBE_PHASE) pr_a = __builtin_amdgcn_s_memrealtime(); } while (0)
#define PEND(k) do { if ((k) == PROBE_PHASE) pr_b = __builtin_amdgcn_s_memrealtime(); } while (0)
#else
#define PSTART(k) do {} while (0)
#define PEND(k) do {} while (0)
#endif
#define SEAM(k) do { if (IN(k) && IN((k) + 1)) xcd_barrier(bar); PEND(k); PSTART((k) + 1); } while (0)

    bf16* WIN = (bf16*)(ws + WS_WIN); bf16* WOUT = (bf16*)(ws + WS_WOUT); bf16* WGU = (bf16*)(ws + WS_WGU); bf16* WDN = (bf16*)(ws + WS_WDN);
    bf16* XN = (bf16*)(ws + WS_XN);

    PSTART(0);
    if (IN(0)) {
        {
            LAS float* scr = (LAS float*)(lds + wave * 16896);
            const int gw = vcu * NWAVES + wave, NGW = G * NWAVES;
            constexpr int NITEM = 32 * 88;
            f32x4 v[16];
            int itn = gw;
            P0Item cur{};
            if (itn < NITEM) { cur = p0_item(args, ws, itn); p0_load(cur, v, lane); }
            while (itn < NITEM) {
                p0_to_lds(cur, v, scr, lane);
                const P0Item done = cur;
                itn += NGW;
                if (itn < NITEM) { cur = p0_item(args, ws, itn); p0_load(cur, v, lane); }
                p0_store(done, scr, lane);
            }
        }
        __syncthreads();
        {
            LAS float* wT = (LAS float*)lds;
            for (int k = tid; k < DM; k += NWAVES * 64) {
                const float* src = args.in[I_WIN] + (size_t)k * DIN + NPROJ;
#pragma unroll
                for (int q = 0; q < 4; ++q) { const f32x4 v = *(const f32x4*)(src + 4 * q); wT[(4 * q + 0) * DM + k] = v[0]; wT[(4 * q + 1) * DM + k] = v[1]; wT[(4 * q + 2) * DM + k] = v[2]; wT[(4 * q + 3) * DM + k] = v[3]; }
            }
            __syncthreads();
            const int gw = vcu * NWAVES + wave, NGW = G * NWAVES;
            const float* gmix = args.in[I_GMIX];
            float* DT = (float*)(ws + WS_DT);
            f32x4 gm[8];
#pragma unroll
            for (int j = 0; j < 8; ++j) gm[j] = *(const f32x4*)(gmix + 4 * lane + 256 * j);
            f32x4 nx[8];
            { const int m = gw; if (m < MT) { const float* xrow = m < MP ? args.in[I_XP] + (size_t)m * DM : args.in[I_XS] + (size_t)(m - MP) * DM;
#pragma unroll
                for (int j = 0; j < 8; ++j) nx[j] = *(const f32x4*)(xrow + 4 * lane + 256 * j); } }
            for (int m = gw; m < MT; m += NGW) {
                f32x4 v[8]; float s = 0.f;
#pragma unroll
                for (int j = 0; j < 8; ++j) { v[j] = nx[j]; s += (v[j][0] * v[j][0] + v[j][1] * v[j][1]) + (v[j][2] * v[j][2] + v[j][3] * v[j][3]); }
                { const int m2 = m + NGW; if (m2 < MT) { const float* xrow = m2 < MP ? args.in[I_XP] + (size_t)m2 * DM : args.in[I_XS] + (size_t)(m2 - MP) * DM;
#pragma unroll
                    for (int j = 0; j < 8; ++j) nx[j] = *(const f32x4*)(xrow + 4 * lane + 256 * j); } }
                const float rstd = 1.0f / sqrtf(wave_sum(s) * (1.0f / DM) + EPS);
#pragma unroll
                for (int j = 0; j < 8; ++j) { v[j] = v[j] * rstd * gm[j];
                    v2u w; w.x = pk2(v[j][0], v[j][1]); w.y = pk2(v[j][2], v[j][3]); *(v2u*)(XN + (size_t)m * DM + 4 * lane + 256 * j) = w; }
                float a[16];
#pragma unroll
                for (int jj = 0; jj < 16; ++jj) {
                    float t = 0.f;
#pragma unroll
                    for (int j = 0; j < 8; ++j) { const f32x4 w = *(const LAS f32x4*)(wT + jj * DM + 4 * lane + 256 * j); t += (v[j][0] * w[0] + v[j][1] * w[1]) + (v[j][2] * w[2] + v[j][3] * w[3]); }
                    a[jj] = t;
                    if ((jj & 1) == 1) __builtin_amdgcn_sched_barrier(0);
                }
                float b8[8], c4[4], d2[2], e1;
                { const bool up = lane & 32;
#pragma unroll
                  for (int q = 0; q < 8; ++q) { const float snd = up ? a[q] : a[q + 8], kp = up ? a[q + 8] : a[q]; b8[q] = kp + __shfl_xor(snd, 32); } }
                { const bool up = lane & 16;
#pragma unroll
                  for (int q = 0; q < 4; ++q) { const float snd = up ? b8[q] : b8[q + 4], kp = up ? b8[q + 4] : b8[q]; c4[q] = kp + __shfl_xor(snd, 16); } }
                { const bool up = lane & 8;
#pragma unroll
                  for (int q = 0; q < 2; ++q) { const float snd = up ? c4[q] : c4[q + 2], kp = up ? c4[q + 2] : c4[q]; d2[q] = kp + __shfl_xor(snd, 8); } }
                { const bool up = lane & 4; const float snd = up ? d2[0] : d2[1], kp = up ? d2[1] : d2[0]; e1 = kp + __shfl_xor(snd, 4); }
                e1 += __shfl_xor(e1, 2); e1 += __shfl_xor(e1, 1);
                if ((lane & 3) == 0) { const int jj = ((lane >> 5) & 1) * 8 + ((lane >> 4) & 1) * 4 + ((lane >> 3) & 1) * 2 + ((lane >> 2) & 1);
                    const float xx = e1 + args.in[I_DTB][jj]; DT[(size_t)m * 16 + jj] = fmaxf(xx, 0.f) + log1pf(__expf(-fabsf(xx))); }
            }
        }
        __syncthreads();
    }
    SEAM(0);

    if (IN(1)) {
        pg8::Gemm g{XN, WIN, MT, NPROJ, DM}; pg8::StaticOrder S; S.init(MT, NPROJ, DM, G, bx);
        EpiInProj E{(bf16*)(ws + WS_Q), (bf16*)(ws + WS_K), (bf16*)(ws + WS_V), (bf16*)(ws + WS_Z), (bf16*)(ws + WS_XBC), args.out, (unsigned*)(ctl + CW_QK)};
        pg8::gemm_phase<EpiInProj, pg8::StaticOrder, false, true>(lds, g, S, E);
    }
    SEAM(1);

    if (IN(2)) {
        const bf16* Qb = (const bf16*)(ws + WS_Q); const bf16* Kb = (const bf16*)(ws + WS_K); const bf16* Vb = (const bf16*)(ws + WS_V);
        bf16* A2 = (bf16*)(ws + WS_A2);
        volatile LAS int* qslot = (volatile LAS int*)(lds + LDSCTL_OFF + 64);
        volatile LAS float* blkc = (volatile LAS float*)(lds + LDSCTL_OFF + 128);
        if (wave == 0) {
            const int l6 = tid & 63;
            const float a = args.in[I_LQ1][l6] * args.in[I_LK1][l6], b = args.in[I_LQ2][l6] * args.in[I_LK2][l6];
            const float lamv = __expf(wave_sum(a)) - __expf(wave_sum(b)) + LAM_INIT;
            if (l6 == 0) blkc[0] = lamv;
            if (l6 < 8) {
                float qkb = 0.f;
#pragma unroll
                for (int m = 0; m < 2; ++m) { const unsigned* w = (const unsigned*)(ctl + CW_QK) + 2 * (2 * l6 + m);
                    const float q2 = __uint_as_float(__hip_atomic_load(w, __ATOMIC_RELAXED, __HIP_MEMORY_SCOPE_AGENT)) + __uint_as_float(__hip_atomic_load(w + 1, __ATOMIC_RELAXED, __HIP_MEMORY_SCOPE_AGENT));
                    const float k2 = __uint_as_float(__hip_atomic_load(w + 32, __ATOMIC_RELAXED, __HIP_MEMORY_SCOPE_AGENT)) + __uint_as_float(__hip_atomic_load(w + 33, __ATOMIC_RELAXED, __HIP_MEMORY_SCOPE_AGENT));
                    qkb = fmaxf(qkb, sqrtf(q2 * k2)); blkc[16 + 2 * l6 + m] = sqrtf(k2); }
                blkc[8 + l6] = (2.f * 1.02f * qkb + att::THR + 180.f) / (exp2f(-(float)(l6 + 1)) * LOG2E);
                blkc[32 + l6] = (2.f * 1.02f * qkb + 1.f <= 90.f) ? 1.f : 0.f;
            }
        }
        __syncthreads();
        constexpr int NA1 = 256, NA2 = 128, NA3 = 128;
        constexpr int Q_A0 = 256, Q_LOC = Q_A0 + 320, Q_ATT1 = Q_LOC + NA1, Q_SCAN = Q_ATT1 + 64, Q_ATT2 = Q_SCAN + NA2, Q_OUT = Q_ATT2 + 320, Q_CONV = Q_OUT + (512 - NA1 - NA2), Q_END = Q_CONV + 592;
#define ITEM_DONE(word) do { asm volatile("s_waitcnt vmcnt(0)" ::: "memory"); __syncthreads(); \
            if (tid == 0) { __builtin_amdgcn_fence(__ATOMIC_RELEASE, "agent"); asm volatile("s_waitcnt vmcnt(0)" ::: "memory"); (void)atomicAdd((unsigned*)(ctl + (word)), 1u); } } while (0)
#define ITEM_WAIT(word, need) do { if (tid == 0) { unsigned sp_ = 0; while (__hip_atomic_load((unsigned*)(ctl + (word)), __ATOMIC_RELAXED, __HIP_MEMORY_SCOPE_AGENT) < (unsigned)(need)) { __builtin_amdgcn_s_sleep(8); if (++sp_ > (1u << 22)) break; } \
            __builtin_amdgcn_fence(__ATOMIC_ACQUIRE, "agent"); asm volatile("s_waitcnt vmcnt(0)" ::: "memory"); } __syncthreads(); } while (0)
#ifdef PROBE_CAT
        volatile LAS unsigned long long* pcs = (volatile LAS unsigned long long*)(lds + LDSCTL_OFF + 512);
        if (tid == 0) { pcs[0] = __builtin_amdgcn_s_memrealtime(); pcs[1] = 99; pcs[2] = pcs[0]; }
#define PC_MARK(nc) do { if (tid == 0) { const unsigned long long n_ = __builtin_amdgcn_s_memrealtime(); const unsigned long long c_ = pcs[1]; if (c_ < 8) (void)atomicAdd((unsigned long long*)(ctl + 8576) + c_, n_ - pcs[0]); pcs[0] = n_; pcs[1] = (unsigned long long)(nc); } } while (0)
#else
#define PC_MARK(nc) do {} while (0)
#endif
        for (;;) {
            __syncthreads();
            if (tid == 0) *qslot = (int)atomicAdd((unsigned*)(ctl + CW_QUEUE), 1u);
            __syncthreads();
            const int p = *qslot;
            PC_MARK(p >= Q_END ? 6 : p >= Q_CONV ? 5 : (p >= Q_A0 && p < Q_LOC) ? 2 : (p >= Q_ATT1 && p < Q_SCAN) ? 3 : (p >= Q_ATT2 && p < Q_OUT) ? 4 : ((p < Q_A0 ? p : (p < Q_ATT1 ? p - Q_LOC + 256 : (p < Q_ATT2 ? p - Q_SCAN + 256 + NA1 : p - Q_OUT + 256 + NA1 + NA2))) % 3 == 1) ? 1 : 0);
#ifdef PROBE_CAT
            if (p >= Q_END && tid == 0) (void)atomicAdd((unsigned long long*)(ctl + 8576) + 7, __builtin_amdgcn_s_memrealtime() - pcs[2]);
#endif
            if (p >= Q_END) break;
            if (p >= Q_CONV) {
                int tw_ = threadIdx.x; asm volatile("" : "+v"(tw_));
                const int wv2 = __builtin_amdgcn_readfirstlane(tw_ >> 6), ln2 = tw_ & 63;
                LAS float* scr = (LAS float*)(lds + wv2 * 16896);
                const int it0 = 32 * 88 + (p - Q_CONV) * 16 + wv2 * 2;
                f32x4 v[16];
                const P0Item a = p0_item(args, ws, it0); p0_load(a, v, ln2); p0_to_lds(a, v, scr, ln2);
                const P0Item b = p0_item(args, ws, it0 + 1); p0_load(b, v, ln2);
                p0_store(a, scr, ln2); p0_to_lds(b, v, scr, ln2); p0_store(b, scr, ln2);
                continue;
            }
            if (p >= Q_A0 && p < Q_LOC) { ssd_local(args, lds, p - Q_A0); ITEM_DONE(CW_LDONE); continue; }
            if (p >= Q_ATT1 && p < Q_SCAN) { ITEM_WAIT(CW_LDONE, 320); { int te_ = tid; asm volatile("" : "+v"(te_)); ssd_scan(args, p - Q_ATT1, te_); } ITEM_DONE(CW_SDONE); continue; }
            if (p >= Q_ATT2 && p < Q_OUT) { ITEM_WAIT(CW_SDONE, 64); ssd_out(args, lds, p - Q_ATT2); continue; }
            const int ap = p < Q_A0 ? p : (p < Q_ATT1 ? p - Q_LOC + 256 : (p < Q_ATT2 ? p - Q_SCAN + 256 + NA1 : p - Q_OUT + 256 + NA1 + NA2));
            const int grp = ap / 3, rr = ap - 3 * grp;
            int tl_ = threadIdx.x; asm volatile("" : "+v"(tl_));
            const int r32 = tl_ & 31, hi = (tl_ >> 5) & 1, wv_ = __builtin_amdgcn_readfirstlane(tl_ >> 6), map = wv_ >> 2, w4 = wv_ & 3;
            const float lam = blkc[0];
            f32x16 o[4];
            if (rr == 1) {
                const int b = grp & 31, h = grp >> 5;
                const float cs = exp2f(-(float)(h + 1)) * LOG2E;
                const int qi = r32 < 16 ? r32 : 15;
                const bf16* qrow = Qb + (size_t)(MP + 16 * b + qi) * 1024 + h * 128 + map * 64 + hi * 8;
                att::SrcSample src{args.in[I_CK] + ((size_t)b * 1024 * 8 + h) * 128, args.in[I_CV] + ((size_t)b * 1024 * 8 + h) * 128,
                                   args.out + O_KS + (size_t)(16 * b) * 1024 + h * 128, args.out + O_VS + (size_t)(16 * b) * 1024 + h * 128};
                att::attn_core<float, 2, 16, false, att::SrcSample>(o, qrow, (float)(1024 + qi), cs, 16, 0, 18, src, (char*)lds_raw, lds, map * 64, 0.f, wv_ == 0 || wv_ == 5);
                att::attn_finish(o, lam, args.in[I_GSUB], A2 + h * 128, MP + 16 * b, 16, w4 == 0, (char*)lds_raw, 1, wv_ == 0 || wv_ == 5);
            } else {
                const int q = 2 * grp + (rr == 2 ? 1 : 0), j = 63 - (q >> 3), h = 7 - (q & 7);
                const float cs = exp2f(-(float)(h + 1)) * LOG2E;
                const float wv = blkc[8 + h];
                int t0 = (int)ceilf(((float)(128 * j - 63) - wv) * (1.0f / 64.f)); t0 = t0 < 0 ? 0 : (t0 & ~1);
                const int row = 128 * j + 32 * w4 + r32;
                const bf16* qrow = Qb + (size_t)row * 1024 + h * 128 + map * 64 + hi * 8;
                att::SrcPrompt src{Kb + h * 128, Vb + h * 128};
                const float kmx = blkc[16 + 2 * h + map];
                if (blkc[32 + h] != 0.f) att::attn_core<bf16, 1, 64, true, att::SrcPrompt>(o, qrow, (float)row, cs, 2 * j + (w4 >> 1), t0, 2 * j + 2, src, (char*)lds_raw, lds, map * 64, kmx, true);
                else att::attn_core<bf16, 1, 64, false, att::SrcPrompt>(o, qrow, (float)row, cs, 2 * j + (w4 >> 1), t0, 2 * j + 2, src, (char*)lds_raw, lds, map * 64, kmx, true);
                att::attn_finish(o, lam, args.in[I_GSUB], A2 + h * 128, 128 * j + 32 * w4, 32, true, (char*)lds_raw, -1, true);
            }
        }
#undef ITEM_DONE
#undef ITEM_WAIT
    }
    SEAM(2);
#ifdef PROBE_CAT
    if (tid == 0) { const unsigned long long n_ = __builtin_amdgcn_s_memrealtime(); (void)atomicAdd((unsigned long long*)(ctl + 8576) + 6, n_ - *(volatile LAS unsigned long long*)(lds + LDSCTL_OFF + 512)); }
#endif

    if (IN(3)) {
        pg8::Gemm g{(const bf16*)(ws + WS_A2), WOUT, MT, DM, DM}; pg8::SplitOrder S; S.init(MP, MT, DM, DM, G, bx, NSL5);
        EpiOutProj E{args.in[I_XP], args.in[I_XS], args.out + O_Y, XN, (float*)(ws + WS_RS1), (float*)(ws + WS_SLAB5)};
        pg8::gemm_phase<EpiOutProj, pg8::SplitOrder, true, true>(lds, g, S, E);
    }
    SEAM(3);

    if (IN(4)) {
        int tq_ = threadIdx.x; asm volatile("" : "+v"(tq_)); const int lane = tq_ & 63;
        const int gw = vcu * NWAVES + wave, NGW = G * NWAVES;
        const float* slabs = (const float*)(ws + WS_SLAB5); const float* rs = (const float*)(ws + WS_RS1); float* rstd1 = (float*)(ws + WS_RSTD1);
        for (int rr = (gw & 3) == 0 ? (gw >> 2) : MS; rr < MS; rr += NGW / 4) {
            const int row = MP + rr, pms = rr >> 8, rl = rr & 255;
            const float* xr = args.in[I_XS] + (size_t)rr * DM; float ss = 0.f;
            f32x4 vv[8];
#pragma unroll
            for (int jh = 0; jh < 8; jh += 4) {
                f32x4 ld[4][NSL5 + 1];
#pragma unroll
                for (int jj = 0; jj < 4; ++jj) { const int j = jh + jj; ld[jj][NSL5] = *(const f32x4*)(xr + 4 * lane + 256 * j);
                    const float* sp = slabs + ((size_t)(pms * 8 + j) * NSL5) * 65536 + (size_t)rl * 256 + 4 * lane;
#pragma unroll
                    for (int q = 0; q < NSL5; ++q) ld[jj][q] = *(const f32x4*)(sp + (size_t)q * 65536); }
                asm volatile("" ::: "memory");
#pragma unroll
                for (int jj = 0; jj < 4; ++jj) { f32x4 a = ld[jj][NSL5];
#pragma unroll
                    for (int q = 0; q < NSL5; ++q) a = a + ld[jj][q];
                    vv[jh + jj] = a; }
            }
#pragma unroll
            for (int j = 0; j < 8; ++j) {
                const f32x4 v = vv[j];
                *(f32x4*)(args.out + O_Y + (size_t)row * DM + 4 * lane + 256 * j) = v;
                v2u w; w.x = pk2(v[0], v[1]); w.y = pk2(v[2], v[3]); *(v2u*)(XN + (size_t)row * DM + 4 * lane + 256 * j) = w;
                ss += (v[0] * v[0] + v[1] * v[1]) + (v[2] * v[2] + v[3] * v[3]);
            }
            ss = wave_sum(ss);
            if (lane == 0) rstd1[row] = 1.0f / sqrtf(ss * (1.0f / DM) + EPS);
        }
        for (int row = bx * (NWAVES * 64) + tid; row < MP; row += G * NWAVES * 64) {
            const float* p = rs + (size_t)row * 32; float t = 0.f;
#pragma unroll
            for (int q = 0; q < 8; ++q) { const f32x4 a = *(const f32x4*)(p + 4 * q); t += (a[0] + a[1]) + (a[2] + a[3]); }
            rstd1[row] = 1.0f / sqrtf(t * (1.0f / DM) + EPS);
        }
    }
    SEAM(4);

    if (IN(5)) {
        pg8::Gemm g{XN, WGU, MT, 2 * DFF, DM}; pg8::StaticOrder S; S.init(MT, 2 * DFF, DM, G, bx);
        EpiGateUp E{(bf16*)(ws + WS_HID), (const float*)(ws + WS_RSTD1), args.out, args.in[I_FCW], args.in[I_FCB], args.in[I_SFFN], (float*)(ws + WS_FRG), (float*)(ws + WS_FRU), (float*)(ws + WS_LRG), lds};
        pg8::gemm_phase<EpiGateUp, pg8::StaticOrder, true, true>(lds, g, S, E);
    }
    SEAM(5);

    if (IN(6)) {
        pg8::Gemm g{(const bf16*)(ws + WS_HID), WDN, MT, DM, DFF}; pg8::SplitOrder S; S.init(MP, MT, DM, DFF, G, bx, NSL9);
        {
            pg8::Unit u0;
            if (S.next(0, u0) && u0.slab < 0 && u0.pm > 0) {
                const float* frg = (const float*)(ws + WS_FRG) + (size_t)u0.pm * 2 * DFF; const float* fru = (const float*)(ws + WS_FRU) + (size_t)u0.pm * 2 * DFF;
                const float* lrg = (const float*)(ws + WS_LRG) + (size_t)(u0.pm - 1) * 2 * DFF; bf16* HID = (bf16*)(ws + WS_HID);
                const float* fw = args.in[I_FCW]; const float* fb = args.in[I_FCB];
                for (int task = tid; task < 2 * (DFF / 8); task += NWAVES * 64) {
                    const int r = task / (DFF / 8), col = 8 * (task % (DFF / 8));
                    const float* p2 = r == 0 ? lrg + col : lrg + DFF + col; const float* p1 = r == 0 ? lrg + DFF + col : frg + col; const float* p0 = frg + (size_t)r * DFF + col; const float* pu = fru + (size_t)r * DFF + col;
                    float o[8];
#pragma unroll
                    for (int e = 0; e < 8; ++e) { const float y = fb[col + e] + fw[col + e] * p2[e] + fw[DFF + col + e] * p1[e] + fw[2 * DFF + col + e] * p0[e]; o[e] = siluf(y) * pu[e]; }
                    v4u w; w.x = pk2(o[0], o[1]); w.y = pk2(o[2], o[3]); w.z = pk2(o[4], o[5]); w.w = pk2(o[6], o[7]);
                    *(v4u*)(HID + (size_t)(256 * u0.pm + r) * DFF + col) = w;
                }
                asm volatile("s_waitcnt vmcnt(0)" ::: "memory");
            }
            __syncthreads();
        }
        EpiDown E{args.out + O_Y, (float*)(ws + WS_RS2), (float*)(ws + WS_SLAB9), XN  };
        pg8::gemm_phase<EpiDown, pg8::SplitOrder, true, true>(lds, g, S, E);
    }
    SEAM(6);

    if (IN(7)) {
        int tq_ = threadIdx.x; asm volatile("" : "+v"(tq_)); const int lane = tq_ & 63;
        const int gw = vcu * NWAVES + wave, NGW = G * NWAVES;
        const float* rs = (const float*)(ws + WS_RS2); const float* gf = args.in[I_GFIN]; const float* slabs = (const float*)(ws + WS_SLAB9);
        f32x4 gfv[8];
#pragma unroll
        for (int j = 0; j < 8; ++j) gfv[j] = *(const f32x4*)(gf + 4 * lane + 256 * j);
        const int nprompt = (MP - gw + NGW - 1) / NGW, nsample = (gw & 3) == 0 ? (MS - (gw >> 2) + NGW / 4 - 1) / (NGW / 4) : 0;
        for (int st = 0; st < nprompt + nsample; ++st) {
            const int m = st < nprompt ? gw + st * NGW : MP + (gw >> 2) + (st - nprompt) * (NGW / 4);
            float* row = args.out + O_Y + (size_t)m * DM;
            f32x4 v[8]; float t;
            if (m < MP) {
                t = lane < 32 ? rs[(size_t)m * 32 + lane] : 0.f;
#pragma unroll
                for (int j = 0; j < 8; ++j) { const v2u w = *(const v2u*)(XN + (size_t)m * DM + 4 * lane + 256 * j); v[j] = (f32x4){bflo(w.x), bfhi(w.x), bflo(w.y), bfhi(w.y)}; }
            } else {
                const int rr = m - MP, pms = rr >> 8, rl = rr & 255; t = 0.f;
#pragma unroll
                for (int jh = 0; jh < 8; jh += 2) {
                    f32x4 ld[2][NSL9 + 1];
#pragma unroll
                    for (int jj = 0; jj < 2; ++jj) { const int j = jh + jj; ld[jj][NSL9] = *(const f32x4*)(row + 4 * lane + 256 * j);
                        const float* sp = slabs + ((size_t)(pms * 8 + j) * NSL9) * 65536 + (size_t)rl * 256 + 4 * lane;
#pragma unroll
                        for (int q = 0; q < NSL9; ++q) ld[jj][q] = *(const f32x4*)(sp + (size_t)q * 65536); }
                    asm volatile("" ::: "memory");
#pragma unroll
                    for (int jj = 0; jj < 2; ++jj) { f32x4 a = ld[jj][NSL9];
#pragma unroll
                        for (int q = 0; q < NSL9; ++q) a = a + ld[jj][q];
                        v[jh + jj] = a; t += (a[0] * a[0] + a[1] * a[1]) + (a[2] * a[2] + a[3] * a[3]); }
                }
            }
            t = wave_sum(t);
            const float rstd = 1.0f / sqrtf(t * (1.0f / DM) + EPS);
#pragma unroll
            for (int j = 0; j < 8; ++j) *(f32x4*)(row + 4 * lane + 256 * j) = v[j] * rstd * gfv[j];
        }
    }
    PEND(N_PHASES - 1);
#ifdef PROBE_CAT
    if (blockIdx.x == 0 && tid == 0) { const unsigned long long d = __hip_atomic_load((unsigned long long*)(ctl + 8576) + PROBE_CAT, __ATOMIC_RELAXED, __HIP_MEMORY_SCOPE_AGENT) * PROBE_SCALE / G, t0 = __builtin_amdgcn_s_memrealtime(); while (__builtin_amdgcn_s_memrealtime() - t0 < d) __builtin_amdgcn_s_sleep(16); }
#endif
#ifdef PROBE_PHASE
    if (blockIdx.x == 0 && tid == 0) { const unsigned long long d = (pr_b - pr_a) * PROBE_SCALE, t0 = __builtin_amdgcn_s_memrealtime(); while (__builtin_amdgcn_s_memrealtime() - t0 < d) __builtin_amdgcn_s_sleep(16); }
#endif
#undef IN
#undef SEAM
}

extern "C" void kernel_launch(void* const* d_in, const int* in_sizes, int n_in, void* d_out, int out_size, void* d_ws, size_t ws_size, hipStream_t stream) {
    static int grid = 0;
    if (grid == 0) {
        if (n_in != 28 || out_size != (int)O_END || ws_size < WS_END) { fprintf(stderr, "kernel_launch: unexpected shapes: n_in %d out %d ws %zu (need %zu)\n", n_in, out_size, ws_size, (size_t)WS_END); grid = -1; return; }
        int dev = 0, cus = 0;
        if (hipGetDevice(&dev) != hipSuccess || hipDeviceGetAttribute(&cus, hipDeviceAttributeMultiprocessorCount, dev) != hipSuccess) { grid = -1; return; }
        if (hipFuncSetAttribute((const void*)hymba_fwd, hipFuncAttributeMaxDynamicSharedMemorySize, LDS_BYTES) != hipSuccess) { fprintf(stderr, "kernel_launch: hipFuncSetAttribute failed\n"); grid = -1; return; }
        (void)hipGetLastError();
        grid = cus;
    }
    if (grid < 0) return;
    (void)hipMemsetAsync((char*)d_ws + WS_CTL, 0, CTL_ZERO_BYTES, stream);
    Args a{};
    for (int i = 0; i < 28; ++i) a.in[i] = (const float*)d_in[i];
    a.out = (float*)d_out; a.ws = (unsigned char*)d_ws;
    if (N_LAUNCHES == 1) {
        a.ph_lo = 0; a.ph_hi = N_PHASES; a.li = 0;
        hipLaunchKernelGGL(hymba_fwd, dim3(grid), dim3(NWAVES * 64), LDS_BYTES, stream, a);
    } else {
        for (int li = 0; li < N_PHASES; ++li) { a.ph_lo = li; a.ph_hi = li + 1; a.li = li; hipLaunchKernelGGL(hymba_fwd, dim3(grid), dim3(NWAVES * 64), LDS_BYTES, stream, a); }
    }
    const hipError_t le = hipPeekAtLastError();
    if (le != hipSuccess) fprintf(stderr, "kernel_launch: launch failed: %s\n", hipGetErrorName(le));
}
```

```cpp
#include <hip/hip_runtime.h>
#include <hip/hip_bf16.h>
#include <cstdio>
#include <cstdint>

#ifndef MK_N_LAUNCHES
#define MK_N_LAUNCHES 1
#endif

namespace pg8 {
#define PG8_LAS __attribute__((address_space(3)))
typedef unsigned short bf16_t;
typedef short bf16x8 __attribute__((ext_vector_type(8)));
typedef float f32x4 __attribute__((ext_vector_type(4)));
typedef unsigned u32x4 __attribute__((ext_vector_type(4)));
constexpr int BM = 256, BK = 64, HALF = 128, HTB = HALF * BK * 2, STAGE_BYTES = 8 * HTB, NXCD = 8, WGM = 8;

__host__ __device__ __forceinline__ int lds_byte(int r, int c) { const int st = (r >> 4) * 2 + (c >> 5), rr = r & 15, cc = c & 31, ob = rr * 64 + cc * 2; return st * 1024 + (ob ^ (((ob >> 9) & 1) << 5)); }
__host__ __device__ __forceinline__ void stage_rc(int b, int& R, int& C) { const int st = b / 1024, sb = b % 1024, swz = sb ^ (((sb >> 9) & 1) << 5); R = (st >> 1) * 16 + swz / 64; C = (st & 1) * 32 + (swz % 64) / 2; }
__host__ __device__ __forceinline__ int perm32(int rho) { const int n = rho >> 4, i = rho & 15; return 8 * (i >> 2) + 4 * n + (i & 3); }

struct Unit { int pm, pn, k0, nk, slab; };
struct Gemm { const bf16_t* A; const bf16_t* Bt; int M, N, K; };

struct StaticOrder {
    int nM, nN, nwg, G, c, nkt, wgm;
    __host__ __device__ void init(int M, int N, int K, int G_, int c_, int wgm_ = WGM) { nM = M / BM; nN = N / BM; nwg = nM * nN; G = G_; c = c_; nkt = K / BK; wgm = wgm_; }
    __host__ __device__ __forceinline__ bool next(int i, Unit& u) const { return at((long)i * G + c, u); }
    __host__ __device__ __forceinline__ bool at(long L, Unit& u) const {
        if (L >= nwg) return false; u.k0 = 0; u.nk = nkt; u.slab = -1;
        int wgid = (int)L; { const int q = nwg / NXCD, r = nwg % NXCD, xcd = wgid % NXCD, off = wgid / NXCD; wgid = (xcd < r ? xcd * (q + 1) : r * (q + 1) + (xcd - r) * q) + off; }
        const int nig = wgm * nN, gid = wgid / nig, fm = gid * wgm, gsz = (nM - fm) < wgm ? (nM - fm) : wgm;
        u.pm = fm + ((wgid % nig) % gsz); u.pn = (wgid % nig) / gsz; return true;
    }
    __device__ __forceinline__ void a_ready(const Unit&) const {}
    __device__ __forceinline__ void done(const Unit&) const {}
};

struct SplitOrder {
    StaticOrder P; int nN, nsl, nks, ntail;
    __host__ __device__ void init(int MPR, int M, int N, int K, int G_, int c_, int nsl_, int wgm_ = WGM) { P.init(MPR, N, K, G_, c_, wgm_); nN = N / BM; nsl = nsl_; nks = (K / BK) / nsl_; ntail = ((M - MPR) / BM) * nN; }
    __host__ __device__ __forceinline__ bool next(int i, Unit& u) const {
        const long L = (long)i * P.G + P.c;
        const int sidx = (int)(L - P.nwg);
        if (sidx >= ntail * nsl) return false;
        int pm, pn, k0, nk, slab;
        if (sidx < 0) {
            int wgid = (int)L; { const int q = P.nwg / NXCD, r = P.nwg % NXCD, xcd = wgid % NXCD, off = wgid / NXCD; wgid = (xcd < r ? xcd * (q + 1) : r * (q + 1) + (xcd - r) * q) + off; }
            const int nig = P.wgm * P.nN, gid = wgid / nig, fm = gid * P.wgm, gsz = (P.nM - fm) < P.wgm ? (P.nM - fm) : P.wgm;
            pm = fm + ((wgid % nig) % gsz); pn = (wgid % nig) / gsz; k0 = 0; nk = P.nkt; slab = -1;
        } else {
            const int tile = sidx / nsl, sl = sidx % nsl; pm = P.nM + tile / nN; pn = tile % nN; k0 = sl * nks; nk = nks; slab = sidx;
        }
        u.pm = pm; u.pn = pn; u.k0 = k0; u.nk = nk; u.slab = slab; return true;
    }
    __device__ __forceinline__ void a_ready(const Unit&) const {}
    __device__ __forceinline__ void done(const Unit&) const {}
};

typedef float f32x2_t __attribute__((ext_vector_type(2))); typedef __bf16 bf16x2_t __attribute__((ext_vector_type(2)));
__device__ __forceinline__ unsigned cvt_pk_bf16(float lo, float hi) { f32x2_t v = {lo, hi}; bf16x2_t b = __builtin_convertvector(v, bf16x2_t); return __builtin_bit_cast(unsigned, b); }

template <class Epi, class Sched, bool ALIGN_EPI = false, bool SP2 = false>
__device__ __forceinline__ void gemm_phase(PG8_LAS unsigned char* lds, const Gemm g, const Sched& S, const Epi& E) {
    const int tid = threadIdx.x, wid = __builtin_amdgcn_readfirstlane(tid >> 6), lane = tid & 63, wr = wid >> 2, wc = wid & 3, fr = lane & 15, fq = lane >> 4;
    const int K = g.K;
    unsigned voffA[2], voffB[2];
#pragma unroll
    for (int i = 0; i < 2; ++i) { int R, C; stage_rc(tid * 16 + i * 8192, R, C); const int Rb = Epi::PERM ? ((R & ~31) + perm32(R & 31)) : R;
        voffA[i] = (unsigned)(R * K + C) * 2u; voffB[i] = (unsigned)(Rb * K + C) * 2u; }
    const size_t kstep = (size_t)(BK * 2);
    const size_t hstep = (size_t)HALF * K * 2;
    const size_t tstep = 2 * hstep;
    const unsigned ldsw = (unsigned)wid * 1024u;
    const int aoff = lds_byte(wr * 64 + fr, fq * 8), boff = lds_byte(wc * 32 + fr, fq * 8);
#define PG8_SA(b, h) (((b) * 2 + (h)) * HTB)
#define PG8_SB(b, h) ((4 + (b) * 2 + (h)) * HTB)
#define PG8_STAGE(bufoff, gbase, voff) do { _Pragma("unroll") for (int _i = 0; _i < 2; ++_i) \
        __builtin_amdgcn_global_load_lds((const unsigned*)((const char*)(gbase) + (voff)[_i]), (PG8_LAS unsigned*)(lds + (bufoff) + ldsw + _i * 8192), 16, 0, 0); } while (0)
#define PG8_LDA(dst, b, h) do { _Pragma("unroll") for (int m = 0; m < 4; ++m) _Pragma("unroll") for (int k = 0; k < 2; ++k) dst[m][k] = *(const PG8_LAS bf16x8*)(lds + PG8_SA(b, h) + aoff + m * 2048 + k * 1024); } while (0)
#define PG8_LDB(dst, b, h) do { _Pragma("unroll") for (int n = 0; n < 2; ++n) _Pragma("unroll") for (int k = 0; k < 2; ++k) dst[n][k] = *(const PG8_LAS bf16x8*)(lds + PG8_SB(b, h) + boff + n * 2048 + k * 1024); } while (0)
#define PG8_MMA(ai, bj, At, Bt) do { __builtin_amdgcn_s_setprio(1); _Pragma("unroll") for (int m = 0; m < 4; ++m) _Pragma("unroll") for (int n = 0; n < 2; ++n) _Pragma("unroll") for (int k = 0; k < 2; ++k) \
        acc[ai][bj][m][n] = __builtin_amdgcn_mfma_f32_16x16x32_bf16(Bt[n][k], At[m][k], acc[ai][bj][m][n], 0, 0, 0); __builtin_amdgcn_s_setprio(0); } while (0)
#define PG8_WAIT_V(n) asm volatile("s_waitcnt vmcnt(" #n ")" ::: "memory")
#define PG8_WAIT_L(n) asm volatile("s_waitcnt lgkmcnt(" #n ")" ::: "memory")
#define PG8_BAR __builtin_amdgcn_s_barrier()
#define PG8_SCHED __builtin_amdgcn_sched_barrier(0)
    Unit cur, nxt; int ui = 0;
    if (!S.next(0, cur)) return;
    f32x4 acc[2][2][4][2];
#pragma unroll
    for (int a = 0; a < 2; ++a)
#pragma unroll
        for (int b = 0; b < 2; ++b)
#pragma unroll
            for (int m = 0; m < 4; ++m)
#pragma unroll
                for (int n = 0; n < 2; ++n) acc[a][b][m][n] = (f32x4){0.f, 0.f, 0.f, 0.f};
    bf16x8 At[4][2], B0[2][2], B1[2][2];
    const char* cA = (const char*)g.A + (size_t)cur.pm * tstep + (size_t)cur.k0 * kstep; const char* cB = (const char*)g.Bt + (size_t)cur.pn * tstep + (size_t)cur.k0 * kstep;
    S.a_ready(cur);
    if constexpr (SP2) {
        PG8_STAGE(PG8_SB(0, 0), cB, voffB); PG8_STAGE(PG8_SB(0, 1), cB + hstep, voffB); PG8_STAGE(PG8_SA(0, 0), cA, voffA); PG8_STAGE(PG8_SA(0, 1), cA + hstep, voffA);
        if (wr == 1) PG8_BAR;
        PG8_WAIT_V(2); PG8_BAR;
        PG8_STAGE(PG8_SB(1, 0), cB + kstep, voffB); PG8_STAGE(PG8_SA(1, 0), cA + kstep, voffA); PG8_STAGE(PG8_SB(1, 1), cB + hstep + kstep, voffB);
        PG8_WAIT_V(6); PG8_BAR;
    } else {
        PG8_STAGE(PG8_SB(0, 0), cB, voffB); PG8_STAGE(PG8_SA(0, 0), cA, voffA); PG8_STAGE(PG8_SB(0, 1), cB + hstep, voffB); PG8_STAGE(PG8_SA(0, 1), cA + hstep, voffA);
        if (wr == 1) PG8_BAR;
        PG8_WAIT_V(4); PG8_BAR;
        PG8_STAGE(PG8_SB(1, 0), cB + kstep, voffB); PG8_STAGE(PG8_SA(1, 0), cA + kstep, voffA); PG8_STAGE(PG8_SB(1, 1), cB + hstep + kstep, voffB);
        PG8_WAIT_V(6); PG8_BAR;
    }
    for (;;) {
        const bool has_next = S.next(ui + 1, nxt);
        const char* nA = has_next ? (const char*)g.A + (size_t)nxt.pm * tstep + (size_t)nxt.k0 * kstep : cA; const char* nB = has_next ? (const char*)g.Bt + (size_t)nxt.pn * tstep + (size_t)nxt.k0 * kstep : cB;
        const int nt = cur.nk;
        for (int t = 0; t < nt; t += 2) {
            const bool last = (t == nt - 2);
            const char* a1 = cA + (size_t)(t + 1) * kstep;
            const char* a2 = last ? nA : cA + (size_t)(t + 2) * kstep; const char* b2 = last ? nB : cB + (size_t)(t + 2) * kstep;
            const char* a3 = a2 + kstep; const char* b3 = b2 + kstep;
            if (last && has_next) S.a_ready(nxt);
            if constexpr (SP2) {
            PG8_LDB(B0, 0, 0); PG8_LDB(B1, 0, 1); PG8_SCHED; PG8_LDA(At, 0, 0); PG8_STAGE(PG8_SA(1, 1), a1 + hstep, voffA);
            PG8_WAIT_V(8); PG8_WAIT_L(0); PG8_BAR; PG8_MMA(0, 0, At, B0); PG8_MMA(0, 1, At, B1); PG8_BAR; PG8_SCHED;
            PG8_LDA(At, 0, 1); PG8_STAGE(PG8_SB(0, 0), b2, voffB); PG8_STAGE(PG8_SB(0, 1), b2 + hstep, voffB); PG8_STAGE(PG8_SA(0, 0), a2, voffA);
            PG8_WAIT_V(8); PG8_WAIT_L(0); PG8_BAR; PG8_MMA(1, 0, At, B0); PG8_MMA(1, 1, At, B1); PG8_BAR; PG8_SCHED;
            PG8_LDB(B0, 1, 0); PG8_LDB(B1, 1, 1); PG8_SCHED; PG8_LDA(At, 1, 0); PG8_STAGE(PG8_SA(0, 1), a2 + hstep, voffA);
            PG8_WAIT_V(8); PG8_WAIT_L(0); PG8_BAR; PG8_MMA(0, 0, At, B0); PG8_MMA(0, 1, At, B1); PG8_BAR; PG8_SCHED;
            PG8_LDA(At, 1, 1); PG8_STAGE(PG8_SB(1, 0), b3, voffB); PG8_STAGE(PG8_SB(1, 1), b3 + hstep, voffB); PG8_STAGE(PG8_SA(1, 0), a3, voffA);
            PG8_WAIT_V(8); PG8_WAIT_L(0); PG8_BAR; PG8_MMA(1, 0, At, B0); PG8_MMA(1, 1, At, B1); PG8_BAR; PG8_SCHED;
            } else {
            PG8_LDB(B0, 0, 0); PG8_SCHED; PG8_LDA(At, 0, 0); PG8_STAGE(PG8_SA(1, 1), a1 + hstep, voffA);
            PG8_WAIT_L(8); PG8_BAR; PG8_WAIT_L(0); PG8_MMA(0, 0, At, B0); PG8_BAR; PG8_SCHED;
            PG8_LDB(B1, 0, 1); PG8_STAGE(PG8_SB(0, 0), b2, voffB);
            PG8_BAR; PG8_WAIT_L(0); PG8_MMA(0, 1, At, B1); PG8_BAR;
            PG8_LDA(At, 0, 1); PG8_STAGE(PG8_SA(0, 0), a2, voffA);
            PG8_BAR; PG8_WAIT_L(0); PG8_MMA(1, 0, At, B0); PG8_BAR; PG8_SCHED;
            PG8_STAGE(PG8_SB(0, 1), b2 + hstep, voffB);
            PG8_WAIT_V(6); PG8_BAR; PG8_MMA(1, 1, At, B1); PG8_BAR;
            PG8_LDB(B0, 1, 0); PG8_SCHED; PG8_LDA(At, 1, 0); PG8_STAGE(PG8_SA(0, 1), a2 + hstep, voffA);
            PG8_WAIT_L(8); PG8_BAR; PG8_WAIT_L(0); PG8_MMA(0, 0, At, B0); PG8_BAR; PG8_SCHED;
            PG8_LDB(B1, 1, 1); PG8_STAGE(PG8_SB(1, 0), b3, voffB);
            PG8_BAR; PG8_WAIT_L(0); PG8_MMA(0, 1, At, B1); PG8_BAR;
            PG8_LDA(At, 1, 1); PG8_STAGE(PG8_SA(1, 0), a3, voffA);
            PG8_BAR; PG8_WAIT_L(0); PG8_MMA(1, 0, At, B0); PG8_BAR; PG8_SCHED;
            PG8_STAGE(PG8_SB(1, 1), b3 + hstep, voffB);
            PG8_WAIT_V(6); PG8_BAR; PG8_MMA(1, 1, At, B1); PG8_BAR;
            }
        }
        if constexpr (ALIGN_EPI) { if (wr == 0) PG8_BAR; }
        if constexpr (!Epi::AFTER_DRAIN) { E(acc, cur, wr, wc, fr, fq); S.done(cur); }
        if (!has_next) break;
#pragma unroll
        for (int a = 0; a < 2; ++a)
#pragma unroll
            for (int b = 0; b < 2; ++b)
#pragma unroll
                for (int m = 0; m < 4; ++m)
#pragma unroll
                    for (int n = 0; n < 2; ++n) acc[a][b][m][n] = (f32x4){0.f, 0.f, 0.f, 0.f};
        cur = nxt; cA = nA; cB = nB; ++ui;
        if constexpr (ALIGN_EPI) { if (wr == 1) PG8_BAR; }
    }
    PG8_WAIT_V(0);
    if constexpr (!ALIGN_EPI) { if (wr == 0) PG8_BAR; }
    PG8_BAR;
#undef PG8_SA
#undef PG8_SB
#undef PG8_STAGE
#undef PG8_LDA
#undef PG8_LDB
#undef PG8_MMA
#undef PG8_WAIT_V
#undef PG8_WAIT_L
#undef PG8_BAR
#undef PG8_SCHED
}
}

constexpr int NWAVES = 8;
constexpr int MP = 8192, MS = 512, MT = MP + MS;
constexpr int DM = 2048, NPROJ = 5632, DIN = 5648, DFF = 5632, NH = 8, NSH = 16;
constexpr int NCHUNK = 128 + 32;
constexpr float EPS = 1e-6f;
constexpr float LOG2E = 1.4426950408889634f;
constexpr float QSCALE = 0.125f * LOG2E;
constexpr float LAM_INIT = 0.2f;

constexpr size_t O_Y = 0, O_KP = 17825792, O_VP = 26214400, O_CP = 34603008, O_SP = 34607616, O_FP = 34738688,
                 O_KS = 34749952, O_VS = 35274240, O_CS = 35798528, O_SS = 35945984, O_FS = 40140288, O_END = 40500736;

constexpr size_t MiB = 1u << 20;
constexpr size_t WS_CTL = 0, CTL_ZERO_BYTES = 64 * 1024;
constexpr size_t WS_WIN = 2 * MiB, WS_WOUT = 24 * MiB, WS_WGU = 32 * MiB, WS_WDN = 76 * MiB, WS_XN = 98 * MiB;
constexpr size_t WS_Q = 132 * MiB, WS_K = 150 * MiB, WS_V = 168 * MiB, WS_Z = 186 * MiB, WS_XBC = 204 * MiB, WS_DT = 230 * MiB;
constexpr size_t WS_ACUM = 235 * MiB, WS_CD = 236 * MiB, WS_CB = 237 * MiB, WS_A2 = 243 * MiB, WS_SCH = 277 * MiB, WS_HPREV = 357 * MiB, WS_YP = 397 * MiB;
constexpr size_t WS_RS1 = 437 * MiB, WS_RS2 = 439 * MiB, WS_FRG = 441 * MiB, WS_FRU = 443 * MiB, WS_LRG = 445 * MiB, WS_RSTD1 = 447 * MiB, WS_END = 448 * MiB;
constexpr size_t WS_HID = 132 * MiB, WS_G = 226 * MiB, WS_U = 320 * MiB;
constexpr size_t WS_SLAB5 = WS_Q, WS_SLAB9 = WS_G;
static_assert(WS_U + (size_t)MT * DFF * 2 <= WS_RS1, "ffn overlay");
constexpr int CW_BAR = 4096, CW_QK = 8192, CW_QUEUE = 8320, CW_LDONE = 8384, CW_SDONE = 8448;

constexpr int LDS_BYTES = 147456, LDSCTL_OFF = 146432;

#define GAS __attribute__((address_space(1)))
#define LAS __attribute__((address_space(3)))
typedef unsigned short bf16;
typedef unsigned v4u __attribute__((ext_vector_type(4)));
typedef unsigned v2u __attribute__((ext_vector_type(2)));
typedef float f32x2 __attribute__((ext_vector_type(2)));
typedef float f32x4 __attribute__((ext_vector_type(4)));
typedef float f32x8 __attribute__((ext_vector_type(8)));
typedef float f32x16 __attribute__((ext_vector_type(16)));
typedef short bf16x8 __attribute__((ext_vector_type(8)));
typedef short s16x4 __attribute__((ext_vector_type(4)));
typedef GAS unsigned gu32;

__device__ __forceinline__ unsigned f2bf(float f) { unsigned u = __builtin_bit_cast(unsigned, f); return (u + 0x7fffu + ((u >> 16) & 1u)) >> 16; }
__device__ __forceinline__ unsigned pk2(float lo, float hi) { return pg8::cvt_pk_bf16(lo, hi); }
__device__ __forceinline__ float bf2f(unsigned short b) { return __builtin_bit_cast(float, (unsigned)b << 16); }
__device__ __forceinline__ float bflo(unsigned w) { return __builtin_bit_cast(float, w << 16); }
__device__ __forceinline__ float bfhi(unsigned w) { return __builtin_bit_cast(float, w & 0xffff0000u); }
__device__ __forceinline__ float wave_sum(float v) {
#pragma unroll
    for (int o = 1; o < 64; o <<= 1) v += __shfl_xor(v, o);
    return v;
}
__device__ __forceinline__ float siluf(float x) { return x * __builtin_amdgcn_rcpf(1.f + __builtin_amdgcn_exp2f(-LOG2E * x)); }

#define XB_TMO      128
#define XB_XCNT(j)  (256  + 64 * (j))
#define XB_XSUB(j)  (1280 + 64 * (j))
#define XB_XGEN(j)  (2304 + 64 * (j))
#define XB_TOP      3328
#define XB_TOPGEN   3392
#define XCD_BAR_WORDS 3456
#define XB_SPIN_CAP (1u << 18)
__device__ __forceinline__ unsigned xb_ld(unsigned* p)              { return __hip_atomic_load(p, __ATOMIC_RELAXED, __HIP_MEMORY_SCOPE_AGENT); }
__device__ __forceinline__ unsigned xb_add(unsigned* p, unsigned v) { return __hip_atomic_fetch_add(p, v, __ATOMIC_RELAXED, __HIP_MEMORY_SCOPE_AGENT); }
__device__ __forceinline__ unsigned xb_xcc_id() { return (unsigned)__builtin_amdgcn_s_getreg((3 << 11) | 20) & 0xFu; }
#define XB_SPIN(cond, bar) do { unsigned _sp = 0; while (cond) { __builtin_amdgcn_s_sleep(1); \
    if ((++_sp & 255u) == 0u) { if (xb_ld(&(bar)[XB_TMO])) break; if (_sp > XB_SPIN_CAP) { atomicAdd(&(bar)[XB_TMO], 1u); break; } } } } while (0)
struct XcdBarrier { unsigned* bar; unsigned x; volatile LAS unsigned* st; };
__device__ __forceinline__ XcdBarrier xcd_barrier_post(unsigned* bar, volatile LAS unsigned* st) {
    XcdBarrier b; b.bar = bar; b.x = xb_xcc_id(); b.st = st;
    if (threadIdx.x == 0) (void)xb_add(&bar[XB_XCNT(b.x)], 1u);
    return b;
}
__device__ __forceinline__ void xcd_barrier_complete(unsigned* bar, unsigned x, unsigned& nloc, unsigned& nx) {
    const unsigned G = gridDim.x * gridDim.y * gridDim.z;
    unsigned sum, cnt, mine, sp = 0u;
    for (;;) {
        sum = 0u; cnt = 0u; mine = 0u;
#pragma unroll
        for (unsigned j = 0; j < 16; ++j) { const unsigned c = xb_ld(&bar[XB_XCNT(j)]); sum += c; cnt += (c > 0u) ? 1u : 0u; mine = (j == x) ? c : mine; }
        if (sum == G) break;
        __builtin_amdgcn_s_sleep(1);
        if ((++sp & 255u) == 0u) { if (xb_ld(&bar[XB_TMO])) break; if (sp > XB_SPIN_CAP) { atomicAdd(&bar[XB_TMO], 1u); break; } }
    }
    nloc = mine > 0u ? mine : 1u; nx = cnt > 0u ? cnt : 1u;
}
__device__ __forceinline__ void xcd_barrier(const XcdBarrier& b) {
    asm volatile("s_waitcnt vmcnt(0)" ::: "memory");
    __syncthreads();
    if (threadIdx.x == 0) {
        unsigned* bar = b.bar;
        __builtin_amdgcn_s_waitcnt(0);
        unsigned nloc = b.st[0], nx = b.st[1];
        if (nloc == 0u) { xcd_barrier_complete(bar, b.x, nloc, nx); b.st[0] = nloc; b.st[1] = nx; }
        const unsigned old = xb_add(&bar[XB_XSUB(b.x)], 1u);
        const unsigned gen = old / nloc;
        if (old + 1u == (gen + 1u) * nloc) {
            __builtin_amdgcn_fence(__ATOMIC_RELEASE, "agent");
            asm volatile("s_waitcnt vmcnt(0)" ::: "memory");
            const unsigned og = xb_add(&bar[XB_TOP], 1u);
            const unsigned tg = og / nx;
            if (og + 1u == (tg + 1u) * nx) xb_add(&bar[XB_TOPGEN], 1u);
            else XB_SPIN(xb_ld(&bar[XB_TOPGEN]) == tg, bar);
            __builtin_amdgcn_fence(__ATOMIC_ACQUIRE, "agent");
            xb_add(&bar[XB_XGEN(b.x)], 1u);
            asm volatile("s_waitcnt vmcnt(0)" ::: "memory");
        } else {
            XB_SPIN(xb_ld(&bar[XB_XGEN(b.x)]) == gen, bar);
            __builtin_amdgcn_fence(__ATOMIC_ACQUIRE, "agent");
            asm volatile("s_waitcnt vmcnt(0)" ::: "memory");
        }
    }
    __syncthreads();
}

struct Args {
    const float* in[28];
    float* out; unsigned char* ws;
    int ph_lo, ph_hi, li, pad;
};
enum { I_XP = 0, I_XS, I_CK, I_CV, I_SCONV, I_SSM, I_SFFN, I_GMIX, I_WIN, I_LQ1, I_LK1, I_LQ2, I_LK2, I_GSUB, I_CONVW, I_CONVB, I_DTB, I_ALOG, I_DSKIP,
       I_GSSM, I_WOUT, I_GFFN, I_WGATE, I_WUP, I_FCW, I_FCB, I_WDOWN, I_GFIN };

struct P0Item { const float* W; const float* g; bf16* WT; int ldw, K, k0, n0, rowbase; };
__device__ __forceinline__ void p0_load(const P0Item& it, f32x4 (&v)[16], int lane) {
    const int rsub = lane >> 4, c4 = 4 * (lane & 15);
#pragma unroll
    for (int i = 0; i < 16; ++i) v[i] = __builtin_nontemporal_load((const f32x4*)(it.W + (size_t)(it.k0 + 4 * i + rsub) * it.ldw + it.n0 + c4));
}
__device__ __forceinline__ void p0_to_lds(const P0Item& it, const f32x4 (&v)[16], LAS float* scr, int lane) {
    const int rsub = lane >> 4, c4 = 4 * (lane & 15);
#pragma unroll
    for (int i = 0; i < 16; ++i) { const int r = 4 * i + rsub; f32x4 x = v[i]; if (it.g) x = x * it.g[it.k0 + r];
        LAS float* d = scr + r * 65 + c4; d[0] = x[0]; d[1] = x[1]; d[2] = x[2]; d[3] = x[3]; }
    asm volatile("s_waitcnt lgkmcnt(0)" ::: "memory");
}
__device__ __forceinline__ void p0_store(const P0Item& it, LAS float* scr, int lane) {
    const int c = lane & 7;
#pragma unroll
    for (int j = 0; j < 8; ++j) { const int n = (lane >> 3) + 8 * j; const LAS float* sp = scr + (8 * c) * 65 + n;
        v4u o; o.x = pk2(sp[0 * 65], sp[1 * 65]); o.y = pk2(sp[2 * 65], sp[3 * 65]); o.z = pk2(sp[4 * 65], sp[5 * 65]); o.w = pk2(sp[6 * 65], sp[7 * 65]);
        *(GAS v4u*)(it.WT + (size_t)(it.rowbase + n) * it.K + it.k0 + 8 * c) = o; }
    asm volatile("s_waitcnt lgkmcnt(0)" ::: "memory");
}
__device__ __forceinline__ P0Item p0_item(const Args& A, unsigned char* ws, int r) {
    constexpr int I_A = 32 * 88, I_B = 32 * 32, I_C = 32 * 88, I_D = 32 * 88;
    P0Item it;
    if (r < I_A) { it = P0Item{A.in[I_WIN], nullptr, (bf16*)(ws + WS_WIN), DIN, DM, 64 * (r / 88), 64 * (r % 88), 64 * (r % 88)}; return it; } r -= I_A;
    if (r < I_B) { it = P0Item{A.in[I_WOUT], nullptr, (bf16*)(ws + WS_WOUT), DM, DM, 64 * (r / 32), 64 * (r % 32), 64 * (r % 32)}; return it; } r -= I_B;
    if (r < I_C) { const int n0 = 64 * (r % 88); it = P0Item{A.in[I_WGATE], A.in[I_GFFN], (bf16*)(ws + WS_WGU), DFF, DM, 64 * (r / 88), n0, (n0 >> 7) * 256 + (n0 & 127)}; return it; } r -= I_C;
    if (r < I_D) { const int n0 = 64 * (r % 88); it = P0Item{A.in[I_WUP], A.in[I_GFFN], (bf16*)(ws + WS_WGU), DFF, DM, 64 * (r / 88), n0, (n0 >> 7) * 256 + 128 + (n0 & 127)}; return it; } r -= I_D;
    it = P0Item{A.in[I_WDOWN], nullptr, (bf16*)(ws + WS_WDN), DM, DFF, 64 * (r / 32), 64 * (r % 32), 64 * (r % 32)}; return it;
}

__device__ __forceinline__ void conv_item(const Args& args, unsigned char* ws, LAS unsigned char* lds, int c) {
    int tw_ = threadIdx.x; asm volatile("" : "+v"(tw_));
    const int wv2 = __builtin_amdgcn_readfirstlane(tw_ >> 6), ln2 = tw_ & 63;
    LAS float* scr = (LAS float*)(lds + wv2 * 16896);
    const int it0 = 32 * 88 + c * 16 + wv2 * 2;
    f32x4 va[16], vb[16];
    const P0Item a = p0_item(args, ws, it0); const P0Item b = p0_item(args, ws, it0 + 1);
    p0_load(a, va, ln2); p0_load(b, vb, ln2);
    p0_to_lds(a, va, scr, ln2); p0_store(a, scr, ln2); p0_to_lds(b, vb, scr, ln2); p0_store(b, scr, ln2);
}

struct EpiInProj {
    static constexpr bool PERM = true, AFTER_DRAIN = false;
    bf16 *Q, *K, *V, *Z, *XBC; float* out; unsigned* qk2;
    __device__ __forceinline__ void operator()(const pg8::f32x4 (&acc)[2][2][4][2], const pg8::Unit& u, int wr, int wc, int fr, int fq) const {
        const int region = u.pn >> 2;
        float nmax[2] = {0.f, 0.f};
        const int row0 = u.pm * 256 + wr * 64 + fr;
        const int cl = wc * 32 + 8 * fq;
#pragma unroll
        for (int ai = 0; ai < 2; ++ai)
#pragma unroll
            for (int m = 0; m < 4; ++m) {
                const int row = row0 + ai * 128 + m * 16;
#pragma unroll
                for (int bj = 0; bj < 2; ++bj) {
                    f32x4 v0 = acc[ai][bj][m][0], v1 = acc[ai][bj][m][1];
                    if (region < 4) {
                        const int c = (u.pn & 3) * 256 + bj * 128 + cl;
                        if (region == 0) { v0 = v0 * QSCALE; v1 = v1 * QSCALE; }
                        if (region < 2) { float ss = (v0[0] * v0[0] + v0[1] * v0[1]) + (v0[2] * v0[2] + v0[3] * v0[3]) + (v1[0] * v1[0] + v1[1] * v1[1]) + (v1[2] * v1[2] + v1[3] * v1[3]);
                            ss += __shfl_xor(ss, 16); ss += __shfl_xor(ss, 32); nmax[bj] = fmaxf(nmax[bj], ss); }
                        v4u w; w.x = pk2(v0[0], v0[1]); w.y = pk2(v0[2], v0[3]); w.z = pk2(v1[0], v1[1]); w.w = pk2(v1[2], v1[3]);
                        bf16* dst = region == 0 ? Q : region == 1 ? K : region == 2 ? V : Z;
                        *(v4u*)(dst + (size_t)row * 1024 + c) = w;
                        if (region == 1 || region == 2) {
                            float* o = out + (row < MP ? (region == 1 ? O_KP : O_VP) + (size_t)row * 1024 : (region == 1 ? O_KS : O_VS) + (size_t)(row - MP) * 1024) + c;
                            *(f32x4*)o = v0; *(f32x4*)(o + 4) = v1;
                        }
                    } else {
                        const int c = (u.pn - 16) * 256 + bj * 128 + cl;
                        v4u w; w.x = pk2(v0[0], v0[1]); w.y = pk2(v0[2], v0[3]); w.z = pk2(v1[0], v1[1]); w.w = pk2(v1[2], v1[3]);
                        *(v4u*)(XBC + (size_t)row * 1536 + c) = w;
                        if (row >= MP - 3) {
                            float* o = nullptr;
                            if (row < MP) o = out + O_CP + (size_t)(row - (MP - 3)) * 1536 + c;
                            else { const int rr = row - MP, i = rr & 15; if (i >= 13) o = out + O_CS + (size_t)((rr >> 4) * 3 + (i - 13)) * 1536 + c; }
                            if (o) { *(f32x4*)o = v0; *(f32x4*)(o + 4) = v1; }
                        }
                    }
                }
            }
        if (region < 2 && u.pm < MP / 256) {
#pragma unroll
            for (int bj = 0; bj < 2; ++bj) { float v = nmax[bj]; v = fmaxf(v, __shfl_xor(v, 1)); v = fmaxf(v, __shfl_xor(v, 2)); v = fmaxf(v, __shfl_xor(v, 4)); v = fmaxf(v, __shfl_xor(v, 8));
                if (fr == 0 && fq == 0) atomicMax(qk2 + region * 32 + (u.pn & 3) * 8 + bj * 4 + wc, __float_as_uint(v)); }
        }
    }
};

__device__ __forceinline__ void store_slab(unsigned short* slab, const pg8::f32x4 (&acc)[2][2][4][2], int wr, int wc, int fr, int fq) {
#pragma unroll
    for (int ai = 0; ai < 2; ++ai)
#pragma unroll
        for (int m = 0; m < 4; ++m)
#pragma unroll
            for (int bj = 0; bj < 2; ++bj) { unsigned short* o = slab + (size_t)(ai * 128 + wr * 64 + m * 16 + fr) * 256 + bj * 128 + wc * 32 + 8 * fq;
                const pg8::f32x4 a0 = acc[ai][bj][m][0], a1 = acc[ai][bj][m][1];
                v4u w; w.x = pk2(a0[0], a0[1]); w.y = pk2(a0[2], a0[3]); w.z = pk2(a1[0], a1[1]); w.w = pk2(a1[2], a1[3]); *(v4u*)o = w; }
}

struct EpiOutProj {
    static constexpr bool PERM = true, AFTER_DRAIN = false;
    const float* xp; const float* xs; float* out; bf16* x1b; float* rs; unsigned short* slabs;
    __device__ __forceinline__ void operator()(const pg8::f32x4 (&acc)[2][2][4][2], const pg8::Unit& u, int wr, int wc, int fr, int fq) const {
        if (u.slab >= 0) { store_slab(slabs + (size_t)u.slab * 65536, acc, wr, wc, fr, fq); return; }
        const int row0 = u.pm * 256 + wr * 64 + fr;
        const int c0 = u.pn * 256 + wc * 32 + 8 * fq;
#pragma unroll
        for (int ai = 0; ai < 2; ++ai)
#pragma unroll
        for (int mh = 0; mh < 2; ++mh) {
            f32x4 xr[2][2][2];
#pragma unroll
            for (int m = 0; m < 2; ++m) { const int row = row0 + ai * 128 + (2 * mh + m) * 16; const float* xrow = row < MP ? xp + (size_t)row * DM : xs + (size_t)(row - MP) * DM;
#pragma unroll
                for (int bj = 0; bj < 2; ++bj) { xr[m][bj][0] = *(const f32x4*)(xrow + c0 + bj * 128); xr[m][bj][1] = *(const f32x4*)(xrow + c0 + bj * 128 + 4); } }
            asm volatile("" ::: "memory");
#pragma unroll
            for (int m = 0; m < 2; ++m) {
                const int mm = 2 * mh + m, row = row0 + ai * 128 + mm * 16;
                float ss = 0.f;
#pragma unroll
                for (int bj = 0; bj < 2; ++bj) {
                    const int c = c0 + bj * 128;
                    const f32x4 v0 = acc[ai][bj][mm][0] + xr[m][bj][0], v1 = acc[ai][bj][mm][1] + xr[m][bj][1];
                    v4u w; w.x = pk2(v0[0], v0[1]); w.y = pk2(v0[2], v0[3]); w.z = pk2(v1[0], v1[1]); w.w = pk2(v1[2], v1[3]);
                    *(v4u*)(x1b + (size_t)row * DM + c) = w;
                    ss += (v0[0] * v0[0] + v0[1] * v0[1]) + (v0[2] * v0[2] + v0[3] * v0[3]) + (v1[0] * v1[0] + v1[1] * v1[1]) + (v1[2] * v1[2] + v1[3] * v1[3]);
                }
                ss += __shfl_xor(ss, 16); ss += __shfl_xor(ss, 32);
                if (fq == 0) rs[(size_t)row * 32 + u.pn * 4 + wc] = ss;
            }
        }
    }
};


constexpr int HALO_OFF = 131072;
struct EpiGateUp {
    static constexpr bool PERM = true, AFTER_DRAIN = false;
    bf16* HID; const float* rs; float* out; const float* fcw; const float* fcb; const float* sffn; float* frg; float* fru; float* lrg; LAS unsigned char* lds;
    __device__ __forceinline__ void operator()(const pg8::f32x4 (&acc)[2][2][4][2], const pg8::Unit& u, int wr, int wc, int fr, int fq) const {
        const int row0 = u.pm * 256 + wr * 64 + fr;
        const int cl = wc * 32 + 8 * fq, c = u.pn * 128 + cl;
        const bool sample = u.pm >= MP / 256;
        f32x4 w0[2], w1[2], w2[2], bb[2];
#pragma unroll
        for (int n = 0; n < 2; ++n) { w0[n] = *(const f32x4*)(fcw + c + 4 * n); w1[n] = *(const f32x4*)(fcw + DFF + c + 4 * n); w2[n] = *(const f32x4*)(fcw + 2 * DFF + c + 4 * n); bb[n] = *(const f32x4*)(fcb + c + 4 * n); }
        float rstd8[2][4];
#pragma unroll
        for (int ai = 0; ai < 2; ++ai)
#pragma unroll
            for (int m = 0; m < 4; ++m) rstd8[ai][m] = rs[row0 + ai * 128 + m * 16];
        LAS float* halo = (LAS float*)(lds + HALO_OFF);
        if (!sample) {
#pragma unroll
            for (int ai = 0; ai < 2; ++ai) {
                const float r3 = rstd8[ai][3];
                if (fr >= 14) { LAS float* hp = halo + ((2 * ai + wr) * 2 + (fr - 14)) * 128 + cl; *(LAS f32x4*)hp = acc[ai][0][3][0] * r3; *(LAS f32x4*)(hp + 4) = acc[ai][0][3][1] * r3; }
            }
        }
        asm volatile("s_waitcnt lgkmcnt(0)" ::: "memory"); __builtin_amdgcn_s_barrier(); asm volatile("" ::: "memory");
#pragma unroll
        for (int ai = 0; ai < 2; ++ai) {
            f32x4 gprev[2] = {(f32x4){0.f, 0.f, 0.f, 0.f}, (f32x4){0.f, 0.f, 0.f, 0.f}};
#pragma unroll
            for (int m = 0; m < 4; ++m) {
                const int row = row0 + ai * 128 + m * 16;
                const float rstd = rstd8[ai][m];
                f32x4 gc[2] = {acc[ai][0][m][0] * rstd, acc[ai][0][m][1] * rstd};
                f32x4 pv[2];
                bool defer = false;
                if (sample) {
                    const int b = (row - fr - MP) >> 4;
                    const float* sp = sffn + ((size_t)b * 2 + (fr & 1)) * DFF + c;
                    pv[0] = *(const f32x4*)sp; pv[1] = *(const f32x4*)(sp + 4);
                } else if (m > 0) { pv[0] = gprev[0]; pv[1] = gprev[1]; }
                else {
                    const int gidx = 2 * ai + wr;
                    if (gidx > 0) { const LAS float* hp = halo + ((gidx - 1) * 2 + (fr & 1)) * 128 + cl; pv[0] = *(const LAS f32x4*)hp; pv[1] = *(const LAS f32x4*)(hp + 4); }
                    else { pv[0] = (f32x4){0.f, 0.f, 0.f, 0.f}; pv[1] = pv[0]; defer = u.pm > 0; }
                }
                const f32x4 u0 = acc[ai][1][m][0] * rstd, u1 = acc[ai][1][m][1] * rstd;
                f32x4 h[2];
#pragma unroll
                for (int n = 0; n < 2; ++n)
#pragma unroll
                    for (int e = 0; e < 4; ++e) {
                        const float cur = gc[n][e], pvv = pv[n][e];
                        const int ci = __float_as_int(cur), pi_ = __float_as_int(pvv);
                        const float g1 = __int_as_float(__builtin_amdgcn_update_dpp(__builtin_amdgcn_update_dpp(0, pi_, 0x121, 0xf, 0xf, false), ci, 0x111, 0xf, 0xf, false));
                        const float g2 = __int_as_float(__builtin_amdgcn_update_dpp(__builtin_amdgcn_update_dpp(0, pi_, 0x122, 0xf, 0xf, false), ci, 0x112, 0xf, 0xf, false));
                        const float y = bb[n][e] + w0[n][e] * g2 + w1[n][e] * g1 + w2[n][e] * cur;
                        h[n][e] = siluf(y) * (n == 0 ? u0[e] : u1[e]);
                    }
                if (defer && fr < 2) {
                    float* o = frg + ((size_t)u.pm * 2 + fr) * DFF + c; *(f32x4*)o = gc[0]; *(f32x4*)(o + 4) = gc[1];
                    o = fru + ((size_t)u.pm * 2 + fr) * DFF + c; *(f32x4*)o = u0; *(f32x4*)(o + 4) = u1;
                } else {
                    v4u w; w.x = pk2(h[0][0], h[0][1]); w.y = pk2(h[0][2], h[0][3]); w.z = pk2(h[1][0], h[1][1]); w.w = pk2(h[1][2], h[1][3]);
                    *(v4u*)(HID + (size_t)row * DFF + c) = w;
                }
                if (!sample && ai == 1 && m == 3 && wr == 1 && fr >= 14) { float* o = lrg + ((size_t)u.pm * 2 + (fr - 14)) * DFF + c; *(f32x4*)o = gc[0]; *(f32x4*)(o + 4) = gc[1]; }
                if (row >= MP - 2) {
                    float* o = nullptr;
                    if (row < MP) o = out + O_FP + (size_t)(row - (MP - 2)) * DFF + c;
                    else { const int rr = row - MP, i = rr & 15; if (i >= 14) o = out + O_FS + (size_t)((rr >> 4) * 2 + (i - 14)) * DFF + c; }
                    if (o) { *(f32x4*)o = gc[0]; *(f32x4*)(o + 4) = gc[1]; }
                }
                gprev[0] = gc[0]; gprev[1] = gc[1];
            }
        }
    }
};

struct EpiDown {
    static constexpr bool PERM = true, AFTER_DRAIN = false;
    float* out; float* rs; unsigned short* slabs; bf16* x2b;
    __device__ __forceinline__ void operator()(const pg8::f32x4 (&acc)[2][2][4][2], const pg8::Unit& u, int wr, int wc, int fr, int fq) const {
        if (u.slab >= 0) { store_slab(slabs + (size_t)u.slab * 65536, acc, wr, wc, fr, fq); return; }
        const int row0 = u.pm * 256 + wr * 64 + fr;
        const int c0 = u.pn * 256 + wc * 32 + 8 * fq;
#pragma unroll
        for (int ai = 0; ai < 2; ++ai)
#pragma unroll
        for (int mh = 0; mh < 2; ++mh) {
            f32x4 xr[2][2][2];
#pragma unroll
            for (int m = 0; m < 2; ++m) { const bf16* xrow = x2b + (size_t)(row0 + ai * 128 + (2 * mh + m) * 16) * DM;
#pragma unroll
                for (int bj = 0; bj < 2; ++bj) { const v4u w = *(const v4u*)(xrow + c0 + bj * 128);
                    xr[m][bj][0] = (f32x4){bflo(w.x), bfhi(w.x), bflo(w.y), bfhi(w.y)}; xr[m][bj][1] = (f32x4){bflo(w.z), bfhi(w.z), bflo(w.w), bfhi(w.w)}; } }
            asm volatile("" ::: "memory");
#pragma unroll
            for (int m = 0; m < 2; ++m) {
                const int mm = 2 * mh + m, row = row0 + ai * 128 + mm * 16;
                float ss = 0.f;
#pragma unroll
                for (int bj = 0; bj < 2; ++bj) {
                    const f32x4 v0 = acc[ai][bj][mm][0] + xr[m][bj][0], v1 = acc[ai][bj][mm][1] + xr[m][bj][1];
                    v4u w; w.x = pk2(v0[0], v0[1]); w.y = pk2(v0[2], v0[3]); w.z = pk2(v1[0], v1[1]); w.w = pk2(v1[2], v1[3]);
                    *(v4u*)(x2b + (size_t)row * DM + c0 + bj * 128) = w;
                    ss += (v0[0] * v0[0] + v0[1] * v0[1]) + (v0[2] * v0[2] + v0[3] * v0[3]) + (v1[0] * v1[0] + v1[1] * v1[1]) + (v1[2] * v1[2] + v1[3] * v1[3]);
                }
                ss += __shfl_xor(ss, 16); ss += __shfl_xor(ss, 32);
                if (fq == 0) rs[(size_t)row * 32 + u.pn * 4 + wc] = ss;
            }
        }
    }
};

__device__ __forceinline__ int crow(int r, int hi) { return (r & 3) + 8 * (r >> 2) + 4 * hi; }
#define MFMA32(a, b, c) __builtin_amdgcn_mfma_f32_32x32x16_bf16((a), (b), (c), 0, 0, 0)

constexpr int SL_XT = 0, SL_XT_ROW = 144, SL_XT_HEAD = 64 * 144;
constexpr int SL_BN = 73728, SL_N_ROW = 272;
constexpr int SL_CN = SL_BN + 64 * 272;
constexpr int SL_BT = SL_CN + 64 * 272, SL_BT_ROW = 144;
constexpr int SL_DT = SL_BT + 128 * 144;
constexpr int SL_AC = SL_DT + 2048;
constexpr int SL_W = SL_AC + 2048;
constexpr int SL_END = SL_W + 2048;
static_assert(SL_END <= LDSCTL_OFF, "ssd lds");

struct SsdUnit { int cid, g, T, rbase, batch; };
__device__ __forceinline__ SsdUnit ssd_unit(int u) {
    SsdUnit s;
    if (u < 256) { s.cid = u >> 1; s.g = u & 1; s.T = 64; s.rbase = 64 * s.cid; s.batch = -1; }
    else { const int v = u - 256; s.batch = v >> 1; s.g = v & 1; s.cid = 128 + s.batch; s.T = 16; s.rbase = MP + 16 * s.batch; }
    return s;
}

__device__ __forceinline__ void ssd_local(const Args& A, LAS unsigned char* lds, int u) {
    const SsdUnit su = ssd_unit(u);
    int tid_ = threadIdx.x; asm volatile("" : "+v"(tid_));
    const int tid = tid_, lane = tid & 63, wid = __builtin_amdgcn_readfirstlane(tid >> 6), r32 = lane & 31, hi = lane >> 5;
    unsigned char* ws = A.ws;
    const bf16* XBC = (const bf16*)(ws + WS_XBC);
    const float* DT = (const float*)(ws + WS_DT);
    if (tid < 384) {
        const int tq = tid & 3, cgi = tid >> 2, t0 = 16 * tq;
        int col; if (cgi < 64) col = 512 * su.g + 8 * cgi; else if (cgi < 80) col = 1024 + 128 * su.g + 8 * (cgi - 64); else col = 1280 + 128 * su.g + 8 * (cgi - 80);
        unsigned ow[8][8];
        if (t0 < su.T) {
            const float* cw = A.in[I_CONVW]; const float* cbias = A.in[I_CONVB];
            f32x4 wv[4][2], bb[2];
#pragma unroll
            for (int n = 0; n < 2; ++n) { bb[n] = *(const f32x4*)(cbias + col + 4 * n);
#pragma unroll
                for (int k = 0; k < 4; ++k) wv[k][n] = *(const f32x4*)(cw + k * 1536 + col + 4 * n); }
            float hist[3][8];
#pragma unroll
            for (int k = 0; k < 3; ++k) {
                const int t = t0 - 3 + k;
                if (t >= 0 || (su.batch < 0 && su.cid > 0)) {
                    const v4u raw = *(const v4u*)(XBC + (size_t)(su.rbase + t) * 1536 + col);
                    hist[k][0] = bflo(raw.x); hist[k][1] = bfhi(raw.x); hist[k][2] = bflo(raw.y); hist[k][3] = bfhi(raw.y); hist[k][4] = bflo(raw.z); hist[k][5] = bfhi(raw.z); hist[k][6] = bflo(raw.w); hist[k][7] = bfhi(raw.w);
                } else if (su.batch >= 0) {
                    const float* sp = A.in[I_SCONV] + ((size_t)su.batch * 3 + (3 + t)) * 1536 + col;
                    const f32x4 a = *(const f32x4*)sp, b = *(const f32x4*)(sp + 4);
                    hist[k][0] = a[0]; hist[k][1] = a[1]; hist[k][2] = a[2]; hist[k][3] = a[3]; hist[k][4] = b[0]; hist[k][5] = b[1]; hist[k][6] = b[2]; hist[k][7] = b[3];
                } else {
#pragma unroll
                    for (int e = 0; e < 8; ++e) hist[k][e] = 0.f;
                }
            }
            v4u rawv[16];
#pragma unroll
            for (int tt = 0; tt < 16; ++tt) rawv[tt] = *(const v4u*)(XBC + (size_t)(su.rbase + t0 + tt) * 1536 + col);
            float prev[8];
#pragma unroll
            for (int tt = 0; tt < 16; ++tt) {
                const v4u raw = rawv[tt];
                float v[8], o[8]; v[0] = bflo(raw.x); v[1] = bfhi(raw.x); v[2] = bflo(raw.y); v[3] = bfhi(raw.y); v[4] = bflo(raw.z); v[5] = bfhi(raw.z); v[6] = bflo(raw.w); v[7] = bfhi(raw.w);
#pragma unroll
                for (int e = 0; e < 8; ++e) { const float y = bb[e >> 2][e & 3] + wv[0][e >> 2][e & 3] * hist[0][e] + wv[1][e >> 2][e & 3] * hist[1][e] + wv[2][e >> 2][e & 3] * hist[2][e] + wv[3][e >> 2][e & 3] * v[e];
                    o[e] = siluf(y); hist[0][e] = hist[1][e]; hist[1][e] = hist[2][e]; hist[2][e] = v[e]; }
                if (cgi >= 64) {
                    v4u w; w.x = pk2(o[0], o[1]); w.y = pk2(o[2], o[3]); w.z = pk2(o[4], o[5]); w.w = pk2(o[6], o[7]);
                    const int n0 = 8 * ((cgi - 64) & 15), t = t0 + tt;
                    if (cgi < 80) *(LAS v4u*)(lds + SL_BN + t * SL_N_ROW + n0 * 2) = w;
                    else { *(LAS v4u*)(lds + SL_CN + t * SL_N_ROW + n0 * 2) = w; *(v4u*)((bf16*)(ws + WS_CB) + ((size_t)su.cid * 64 + t) * 256 + su.g * 128 + n0) = w; }
                }
                if (tt & 1) {
#pragma unroll
                    for (int e = 0; e < 8; ++e) ow[e][tt >> 1] = pk2(prev[e], o[e]);
                } else {
#pragma unroll
                    for (int e = 0; e < 8; ++e) prev[e] = o[e];
                }
            }
        } else {
#pragma unroll
            for (int e = 0; e < 8; ++e)
#pragma unroll
                for (int k = 0; k < 8; ++k) ow[e][k] = 0u;
            { unsigned z1 = 0u; asm volatile("" : "+v"(z1)); ow[0][0] = z1; }
            if (cgi >= 64) {
                const int n0 = 8 * ((cgi - 64) & 15); unsigned z0 = 0u; asm volatile("" : "+v"(z0)); const v4u z = {z0, z0, z0, z0};
#pragma unroll
                for (int tt = 0; tt < 16; ++tt) { const int t = t0 + tt;
                    if (cgi < 80) *(LAS v4u*)(lds + SL_BN + t * SL_N_ROW + n0 * 2) = z;
                    else { *(LAS v4u*)(lds + SL_CN + t * SL_N_ROW + n0 * 2) = z; *(v4u*)((bf16*)(ws + WS_CB) + ((size_t)su.cid * 64 + t) * 256 + su.g * 128 + n0) = z; } }
            }
        }
        if (cgi < 80) {
            LAS unsigned char* tb_ = cgi < 64 ? lds + SL_XT + (cgi >> 3) * SL_XT_HEAD + (8 * (cgi & 7)) * SL_XT_ROW + t0 * 2 : lds + SL_BT + (8 * (cgi - 64)) * SL_BT_ROW + t0 * 2;
#pragma unroll
            for (int e = 0; e < 8; ++e) { const v4u a = {ow[e][0], ow[e][1], ow[e][2], ow[e][3]}, b = {ow[e][4], ow[e][5], ow[e][6], ow[e][7]};
                *(LAS v4u*)(tb_ + e * SL_XT_ROW) = a; *(LAS v4u*)(tb_ + e * SL_XT_ROW + 16) = b; }
        }
    }
    {
        const int h = 8 * su.g + wid;
        const float dt = lane < su.T ? DT[(size_t)(su.rbase + lane) * 16 + h] : 0.f;
        const float a = -__expf(A.in[I_ALOG][h]);
        float x = dt * a;
#pragma unroll
        for (int off = 1; off < 64; off <<= 1) { const float v = __shfl_up(x, off); if (lane >= off) x += v; }
        const float tot = __shfl(x, 63);
        LAS float* dl = (LAS float*)(lds + SL_DT) + wid * 64; LAS float* al = (LAS float*)(lds + SL_AC) + wid * 64; LAS float* wl = (LAS float*)(lds + SL_W) + wid * 64;
        dl[lane] = dt; al[lane] = x; wl[lane] = __expf(tot - x) * dt;
        ((float*)(ws + WS_ACUM))[((size_t)su.cid * 16 + h) * 64 + lane] = x;
        if (lane == 63) ((float*)(ws + WS_CD))[su.cid * 16 + h] = __expf(tot);
    }
    __syncthreads();
    {
        const int h = 8 * su.g + wid;
        const float dskip = A.in[I_DSKIP][h];
        const LAS unsigned char* bn = lds + SL_BN; const LAS unsigned char* cn = lds + SL_CN; const LAS unsigned char* bt = lds + SL_BT;
        const LAS unsigned char* xt = lds + SL_XT + wid * SL_XT_HEAD;
        const LAS float* dl = (const LAS float*)(lds + SL_DT) + wid * 64; const LAS float* al = (const LAS float*)(lds + SL_AC) + wid * 64; const LAS float* wl = (const LAS float*)(lds + SL_W) + wid * 64;
        f32x16 cb00 = {}, cb01 = {}, cb11 = {};
#pragma unroll
        for (int ks = 0; ks < 8; ++ks) {
            const int kb = (16 * ks + 8 * hi) * 2;
            const bf16x8 b0 = *(const LAS bf16x8*)(bn + r32 * SL_N_ROW + kb), b1 = *(const LAS bf16x8*)(bn + (32 + r32) * SL_N_ROW + kb);
            const bf16x8 c0 = *(const LAS bf16x8*)(cn + r32 * SL_N_ROW + kb), c1 = *(const LAS bf16x8*)(cn + (32 + r32) * SL_N_ROW + kb);
            cb00 = MFMA32(b0, c0, cb00); cb01 = MFMA32(b0, c1, cb01); cb11 = MFMA32(b1, c1, cb11);
        }
        const float at0 = al[r32], at1 = al[32 + r32];
        bf16x8 X00[2], X01[2], X11[2];
        {
            float m00[16], m01[16], m11[16];
#pragma unroll
            for (int r = 0; r < 16; ++r) {
                const int s0 = crow(r, hi), s1 = 32 + s0;
                const float as0 = al[s0], as1 = al[s1], ds0 = dl[s0], ds1 = dl[s1];
                float v = (s0 <= r32) ? cb00[r] * __expf(at0 - as0) * ds0 : 0.f; if (s0 == r32) v += dskip; m00[r] = v;
                m01[r] = cb01[r] * __expf(at1 - as0) * ds0;
                v = (s0 <= r32) ? cb11[r] * __expf(at1 - as1) * ds1 : 0.f; if (s0 == r32) v += dskip; m11[r] = v;
            }
#pragma unroll
            for (int sp = 0; sp < 2; ++sp) {
                v4u w;
                w.x = pk2(m00[8 * sp + 0], m00[8 * sp + 1]); w.y = pk2(m00[8 * sp + 2], m00[8 * sp + 3]); w.z = pk2(m00[8 * sp + 4], m00[8 * sp + 5]); w.w = pk2(m00[8 * sp + 6], m00[8 * sp + 7]); X00[sp] = __builtin_bit_cast(bf16x8, w);
                w.x = pk2(m01[8 * sp + 0], m01[8 * sp + 1]); w.y = pk2(m01[8 * sp + 2], m01[8 * sp + 3]); w.z = pk2(m01[8 * sp + 4], m01[8 * sp + 5]); w.w = pk2(m01[8 * sp + 6], m01[8 * sp + 7]); X01[sp] = __builtin_bit_cast(bf16x8, w);
                w.x = pk2(m11[8 * sp + 0], m11[8 * sp + 1]); w.y = pk2(m11[8 * sp + 2], m11[8 * sp + 3]); w.z = pk2(m11[8 * sp + 4], m11[8 * sp + 5]); w.w = pk2(m11[8 * sp + 6], m11[8 * sp + 7]); X11[sp] = __builtin_bit_cast(bf16x8, w);
            }
        }
        v4u* yp = (v4u*)(ws + WS_YP) + ((size_t)su.cid * 16 + h) * 512 + lane;
#pragma unroll
        for (int pi = 0; pi < 2; ++pi) {
            f32x16 y0 = {}, y1 = {};
#pragma unroll
            for (int i = 0; i < 2; ++i)
#pragma unroll
                for (int sp = 0; sp < 2; ++sp) {
                    const LAS unsigned char* ap = xt + (32 * pi + r32) * SL_XT_ROW + (32 * i + 16 * sp + 4 * hi) * 2;
                    const v2u lo = *(const LAS v2u*)ap, hh = *(const LAS v2u*)(ap + 16);
                    const v4u aw = {lo.x, lo.y, hh.x, hh.y}; const bf16x8 af = __builtin_bit_cast(bf16x8, aw);
                    if (i == 0) { y0 = MFMA32(af, X00[sp], y0); y1 = MFMA32(af, X01[sp], y1); }
                    else y1 = MFMA32(af, X11[sp], y1);
                }
#pragma unroll
            for (int hf = 0; hf < 2; ++hf) {
                const v4u w0 = {pk2(y0[8 * hf + 0], y0[8 * hf + 1]), pk2(y0[8 * hf + 2], y0[8 * hf + 3]), pk2(y0[8 * hf + 4], y0[8 * hf + 5]), pk2(y0[8 * hf + 6], y0[8 * hf + 7])};
                const v4u w1 = {pk2(y1[8 * hf + 0], y1[8 * hf + 1]), pk2(y1[8 * hf + 2], y1[8 * hf + 3]), pk2(y1[8 * hf + 4], y1[8 * hf + 5]), pk2(y1[8 * hf + 6], y1[8 * hf + 7])};
                yp[(((pi * 2 + 0) * 2) + hf) * 64] = w0; yp[(((pi * 2 + 1) * 2) + hf) * 64] = w1; }
        }
        bf16* sch = (bf16*)(ws + WS_SCH) + ((size_t)su.cid * 16 + h) * 8192;
#pragma unroll
        for (int pi = 0; pi < 2; ++pi) {
            f32x16 s0 = {}, s1 = {}, s2 = {}, s3 = {};
#pragma unroll
            for (int ks = 0; ks < 4; ++ks) {
                const int sb = 16 * ks + 8 * hi;
                const v4u raw = *(const LAS v4u*)(xt + (32 * pi + r32) * SL_XT_ROW + sb * 2);
                const f32x4 wa = *(const LAS f32x4*)(wl + sb), wb = *(const LAS f32x4*)(wl + sb + 4);
                v4u aw; aw.x = pk2(bflo(raw.x) * wa[0], bfhi(raw.x) * wa[1]); aw.y = pk2(bflo(raw.y) * wa[2], bfhi(raw.y) * wa[3]);
                aw.z = pk2(bflo(raw.z) * wb[0], bfhi(raw.z) * wb[1]); aw.w = pk2(bflo(raw.w) * wb[2], bfhi(raw.w) * wb[3]);
                const bf16x8 xf = __builtin_bit_cast(bf16x8, aw);
                const bf16x8 q0 = *(const LAS bf16x8*)(bt + (0 + r32) * SL_BT_ROW + sb * 2), q1 = *(const LAS bf16x8*)(bt + (32 + r32) * SL_BT_ROW + sb * 2);
                const bf16x8 q2 = *(const LAS bf16x8*)(bt + (64 + r32) * SL_BT_ROW + sb * 2), q3 = *(const LAS bf16x8*)(bt + (96 + r32) * SL_BT_ROW + sb * 2);
                s0 = MFMA32(q0, xf, s0); s1 = MFMA32(q1, xf, s1); s2 = MFMA32(q2, xf, s2); s3 = MFMA32(q3, xf, s3);
            }
            bf16* orow = sch + (size_t)(32 * pi + r32) * 128 + 8 * hi;
#define SCH_ST(SB, col) do { _Pragma("unroll") for (int qp = 0; qp < 4; qp += 2) { \
                const unsigned a0_ = pk2(SB[4 * qp], SB[4 * qp + 1]), a1_ = pk2(SB[4 * qp + 2], SB[4 * qp + 3]), b0_ = pk2(SB[4 * qp + 4], SB[4 * qp + 5]), b1_ = pk2(SB[4 * qp + 6], SB[4 * qp + 7]); \
                auto r0_ = __builtin_amdgcn_permlane32_swap(a0_, b0_, false, false); auto r1_ = __builtin_amdgcn_permlane32_swap(a1_, b1_, false, false); \
                const v4u w_ = {r0_[0], r1_[0], r0_[1], r1_[1]}; *(v4u*)(orow + (col) + 8 * qp) = w_; } } while (0)
            SCH_ST(s0, 0); SCH_ST(s1, 32); SCH_ST(s2, 64); SCH_ST(s3, 96);
#undef SCH_ST
        }
    }
    __syncthreads();
}

__device__ __forceinline__ void ssd_scan(const Args& A, int item, int tid) {
    unsigned char* ws = A.ws;
    const int e4 = item * 2048 + 4 * tid, h = __builtin_amdgcn_readfirstlane(e4 >> 13);
    const v2u* SCH = (const v2u*)(ws + WS_SCH) + (e4 >> 2); const float* CD = (const float*)(ws + WS_CD) + h; v2u* HP = (v2u*)(ws + WS_HPREV) + (e4 >> 2);
    float st0 = 0.f, st1 = 0.f, st2 = 0.f, st3 = 0.f;
    for (int c0 = 0; c0 < 128; c0 += 32) {
        v2u sv[32]; float d[32];
#pragma unroll
        for (int k = 0; k < 32; ++k) { sv[k] = SCH[(size_t)(c0 + k) * 32768]; d[k] = CD[(c0 + k) * 16]; }
#pragma unroll
        for (int k = 0; k < 32; ++k) { v2u o; o.x = pk2(st0, st1); o.y = pk2(st2, st3); HP[(size_t)(c0 + k) * 32768] = o;
            st0 = d[k] * st0 + bflo(sv[k].x); st1 = d[k] * st1 + bfhi(sv[k].x); st2 = d[k] * st2 + bflo(sv[k].y); st3 = d[k] * st3 + bfhi(sv[k].y); }
    }
    { f32x4 o = {st0, st1, st2, st3}; *(f32x4*)(A.out + O_SP + e4) = o; }
    for (int b0 = 0; b0 < 32; b0 += 16) {
        v2u sv[16]; float d[16]; f32x4 h0[16];
#pragma unroll
        for (int k = 0; k < 16; ++k) { sv[k] = SCH[(size_t)(128 + b0 + k) * 32768]; d[k] = CD[(128 + b0 + k) * 16]; h0[k] = *(const f32x4*)(A.in[I_SSM] + (size_t)(b0 + k) * 131072 + e4); }
#pragma unroll
        for (int k = 0; k < 16; ++k) { v2u o; o.x = pk2(h0[k][0], h0[k][1]); o.y = pk2(h0[k][2], h0[k][3]); HP[(size_t)(128 + b0 + k) * 32768] = o;
            f32x4 r = {d[k] * h0[k][0] + bflo(sv[k].x), d[k] * h0[k][1] + bfhi(sv[k].x), d[k] * h0[k][2] + bflo(sv[k].y), d[k] * h0[k][3] + bfhi(sv[k].y)};
            *(f32x4*)(A.out + O_SS + (size_t)(b0 + k) * 131072 + e4) = r; }
    }
}

__device__ __forceinline__ void ssd_out(const Args& A, LAS unsigned char* lds, int u) {
    const SsdUnit su = ssd_unit(u);
    int tid_ = threadIdx.x; asm volatile("" : "+v"(tid_));
    const int tid = tid_, lane = tid & 63, wid = __builtin_amdgcn_readfirstlane(tid >> 6), r32 = lane & 31, hi = lane >> 5;
    unsigned char* ws = A.ws;
    const int h = 8 * su.g + wid;
    const bf16* HP = (const bf16*)(ws + WS_HPREV) + ((size_t)su.cid * 16 + h) * 8192;
    const bf16* CB = (const bf16*)(ws + WS_CB) + (size_t)su.cid * 64 * 256 + su.g * 128;
    const float* acum = (const float*)(ws + WS_ACUM) + ((size_t)su.cid * 16 + h) * 64;
    const v4u* yp = (const v4u*)(ws + WS_YP) + ((size_t)su.cid * 16 + h) * 512 + lane;
    const bf16* Z = (const bf16*)(ws + WS_Z);
    float ac_[2]; v2u zz_[2][2][4]; v4u yv_[2][2][2]; f32x4 gg_[2][4];
    { const float* gn0 = A.in[I_GSSM] + 512 * su.g + 64 * wid + 4 * hi;
#pragma unroll
      for (int pi = 0; pi < 2; ++pi)
#pragma unroll
        for (int q = 0; q < 4; ++q) gg_[pi][q] = *(const f32x4*)(gn0 + 32 * pi + 8 * q); }
#pragma unroll
    for (int j = 0; j < 2; ++j) {
        const int t = 32 * j + r32;
        ac_[j] = acum[t];
        const bf16* zr = Z + (size_t)(su.rbase + (t < su.T ? t : 0)) * 1024 + 512 * su.g + 64 * wid;
#pragma unroll
        for (int pi = 0; pi < 2; ++pi)
#pragma unroll
            for (int q = 0; q < 4; ++q) { zz_[j][pi][q] = *(const v2u*)(zr + 32 * pi + 8 * q + 4 * hi);
                if ((q & 1) == 0) yv_[j][pi][q >> 1] = yp[((pi * 2 + j) * 2 + (q >> 1)) * 64]; }
    }
    f32x16 acc[2][2] = {};
#pragma unroll
    for (int kh = 0; kh < 2; ++kh) {
        bf16x8 fa0[4], fa1[4], fb0[4], fb1[4];
#pragma unroll
        for (int k = 0; k < 4; ++k) { const int kb = 16 * (4 * kh + k) + 8 * hi;
            fa0[k] = *(const bf16x8*)(HP + (size_t)r32 * 128 + kb); fa1[k] = *(const bf16x8*)(HP + (size_t)(32 + r32) * 128 + kb);
            fb0[k] = *(const bf16x8*)(CB + (size_t)r32 * 256 + kb); fb1[k] = *(const bf16x8*)(CB + (size_t)(32 + r32) * 256 + kb); }
#pragma unroll
        for (int k = 0; k < 4; ++k) { acc[0][0] = MFMA32(fa0[k], fb0[k], acc[0][0]); acc[0][1] = MFMA32(fa0[k], fb1[k], acc[0][1]); acc[1][0] = MFMA32(fa1[k], fb0[k], acc[1][0]); acc[1][1] = MFMA32(fa1[k], fb1[k], acc[1][1]); }
    }
    float ssq[2] = {0.f, 0.f};
#pragma unroll
    for (int j = 0; j < 2; ++j) {
        const float ea = __expf(ac_[j]);
#pragma unroll
        for (int pi = 0; pi < 2; ++pi)
#pragma unroll
            for (int q = 0; q < 4; ++q) {
                const v2u zz = zz_[j][pi][q];
                const float z0 = bflo(zz.x), z1 = bfhi(zz.x), z2 = bflo(zz.y), z3 = bfhi(zz.y);
                const unsigned ya = yv_[j][pi][q >> 1][2 * (q & 1)], yb = yv_[j][pi][q >> 1][2 * (q & 1) + 1];
                float y;
                y = (bflo(ya) + ea * acc[pi][j][4 * q + 0]) * siluf(z0); acc[pi][j][4 * q + 0] = y; ssq[j] += y * y;
                y = (bfhi(ya) + ea * acc[pi][j][4 * q + 1]) * siluf(z1); acc[pi][j][4 * q + 1] = y; ssq[j] += y * y;
                y = (bflo(yb) + ea * acc[pi][j][4 * q + 2]) * siluf(z2); acc[pi][j][4 * q + 2] = y; ssq[j] += y * y;
                y = (bfhi(yb) + ea * acc[pi][j][4 * q + 3]) * siluf(z3); acc[pi][j][4 * q + 3] = y; ssq[j] += y * y;
            }
        ssq[j] += __shfl_xor(ssq[j], 32);
    }
    LAS float* red = (LAS float*)lds;
    if (hi == 0) { red[wid * 64 + r32] = ssq[0]; red[wid * 64 + 32 + r32] = ssq[1]; }
    __syncthreads();
    bf16* A2 = (bf16*)(ws + WS_A2);
#pragma unroll
    for (int j = 0; j < 2; ++j) {
        const int t = 32 * j + r32;
        float tot = 0.f;
#pragma unroll
        for (int w = 0; w < 8; ++w) tot += red[w * 64 + t];
        const float rstd = 1.0f / sqrtf(tot * (1.0f / 512.f) + EPS);
        {
            bf16* orow = A2 + (size_t)(su.rbase + t) * 2048 + 1024 + 512 * su.g + 64 * wid;
#pragma unroll
            for (int pi = 0; pi < 2; ++pi)
#pragma unroll
                for (int q = 0; q < 4; q += 2) {
                    const f32x4 g0 = gg_[pi][q], g1 = gg_[pi][q + 1];
                    const unsigned a0 = pk2(acc[pi][j][4 * q + 0] * rstd * g0[0], acc[pi][j][4 * q + 1] * rstd * g0[1]), a1 = pk2(acc[pi][j][4 * q + 2] * rstd * g0[2], acc[pi][j][4 * q + 3] * rstd * g0[3]);
                    const unsigned b0 = pk2(acc[pi][j][4 * q + 4] * rstd * g1[0], acc[pi][j][4 * q + 5] * rstd * g1[1]), b1 = pk2(acc[pi][j][4 * q + 6] * rstd * g1[2], acc[pi][j][4 * q + 7] * rstd * g1[3]);
                    auto r0 = __builtin_amdgcn_permlane32_swap(a0, b0, false, false); auto r1 = __builtin_amdgcn_permlane32_swap(a1, b1, false, false);
                    const v4u w = {r0[0], r1[0], r0[1], r1[1]};
                    if (t < su.T) *(v4u*)(orow + 32 * pi + 8 * (q + hi)) = w;
                }
        }
    }
    __syncthreads();
}

namespace att {
constexpr int KVBLK = 64;
constexpr int SHM_V = 64 * 128 * 2, SHM_K = 64 * 128 * 2;
constexpr int NSLOT = 3;
constexpr int L_V = 0, L_K = NSLOT * SHM_V, L_WS = L_K + NSLOT * SHM_K, L_EX = 0  , L_END = L_WS + NWAVES * 128 * 4;
static_assert(4 * 16384 <= L_WS, "exchange slots fit under the rings");
static_assert(L_END <= LDSCTL_OFF, "attn lds");
constexpr float THR = 6.f;
#define KSWZ(row, colB) ((row) * 256 + ((colB) ^ (((row) & 15) << 4)))
#define SBAR() __builtin_amdgcn_sched_barrier(0)
__device__ __forceinline__ unsigned cvtpk(float lo, float hi) { return pg8::cvt_pk_bf16(lo, hi); }
template <typename TIn> struct Stage;
template <> struct Stage<bf16>  { using T = bf16x8;
  __device__ static __forceinline__ T ld8(const bf16* p) { return *reinterpret_cast<const bf16x8*>(p); }
  __device__ static __forceinline__ bf16x8 tobf(T x) { return x; } };
template <> struct Stage<float> { using T = f32x8;
  __device__ static __forceinline__ T ld8(const float* p) { return *reinterpret_cast<const f32x8*>(p); }
  __device__ static __forceinline__ bf16x8 tobf(T x) {
    v4u w = {cvtpk(x[0], x[1]), cvtpk(x[2], x[3]), cvtpk(x[4], x[5]), cvtpk(x[6], x[7])}; return __builtin_bit_cast(bf16x8, w); } };

__device__ __forceinline__ void partialSM(f32x16& p0, f32x16& p1, float& m_reg, float& mn, float& alpha, float base, float c32) {
  float pm0 = p0[0]; for (int r = 1; r < 16; ++r) pm0 = fmaxf(pm0, p0[r]);
  float pm1 = p1[0]; for (int r = 1; r < 16; ++r) pm1 = fmaxf(pm1, p1[r]);
  float pmax = fmaxf(pm0, pm1 + c32) + base;
  { auto rr = __builtin_amdgcn_permlane32_swap(__float_as_uint(pmax), __float_as_uint(pmax), false, false);
    pmax = fmaxf(__uint_as_float(rr[0]), __uint_as_float(rr[1])); }
  if (__builtin_expect(__all(pmax - m_reg <= THR), 1)) { mn = m_reg; alpha = 1.f; }
  else { mn = fmaxf(m_reg, pmax); alpha = __builtin_amdgcn_exp2f(m_reg - mn); m_reg = mn; }
  const float off0 = base - mn, off1 = off0 + c32;
  for (int r = 0; r < 16; ++r) p0[r] = __builtin_amdgcn_exp2f(p0[r] + off0);
  for (int r = 0; r < 16; ++r) p1[r] = p1[r] + off1;
}
__device__ __forceinline__ void finishSM(f32x16& p0, f32x16& p1, float alpha, float& l_reg, bf16x8& pa0, bf16x8& pa1, bf16x8& pa2, bf16x8& pa3) {
  for (int r = 0; r < 16; ++r) p1[r] = __builtin_amdgcn_exp2f(p1[r]);
  float ps = 0; for (int r = 0; r < 16; ++r) ps += p0[r]; for (int r = 0; r < 16; ++r) ps += p1[r];
  { auto rr = __builtin_amdgcn_permlane32_swap(__float_as_uint(ps), __float_as_uint(ps), false, false);
    ps = __uint_as_float(rr[0]) + __uint_as_float(rr[1]); }
  l_reg = l_reg * alpha + ps;
#define PK4(P, BASE, OUT) do { unsigned a0 = cvtpk(P[BASE + 0], P[BASE + 1]), a1 = cvtpk(P[BASE + 2], P[BASE + 3]);   \
    unsigned b0 = cvtpk(P[BASE + 4], P[BASE + 5]), b1 = cvtpk(P[BASE + 6], P[BASE + 7]);                              \
    auto r0 = __builtin_amdgcn_permlane32_swap(a0, b0, false, false); auto r1 = __builtin_amdgcn_permlane32_swap(a1, b1, false, false); \
    v4u w = {r0[0], r1[0], r0[1], r1[1]}; OUT = __builtin_bit_cast(bf16x8, w); } while (0)
  PK4(p0, 0, pa0); PK4(p0, 8, pa1); PK4(p1, 0, pa2); PK4(p1, 8, pa3);
#undef PK4
}
__device__ __forceinline__ void qkt(f32x16& p0, f32x16& p1, const char* Ks, const bf16x8* qr, const float* kc, int r32, int hi, int mapoff) {
  { const f32x4 k0 = *(const f32x4*)kc, k1 = *(const f32x4*)(kc + 4), k2 = *(const f32x4*)(kc + 8), k3 = *(const f32x4*)(kc + 12);
    p0 = (f32x16){k0[0], k0[1], k0[2], k0[3], k1[0], k1[1], k1[2], k1[3], k2[0], k2[1], k2[2], k2[3], k3[0], k3[1], k3[2], k3[3]}; p1 = p0; }
  bf16x8 bk[8];
#pragma unroll
  for (int d0 = 0; d0 < 4; ++d0) { const int cb = (mapoff + d0 * 16 + hi * 8) * 2;
    bk[2 * d0] = *reinterpret_cast<const bf16x8*>(Ks + KSWZ(r32, cb));
    bk[2 * d0 + 1] = *reinterpret_cast<const bf16x8*>(Ks + KSWZ(32 + r32, cb)); }
  asm volatile("s_waitcnt lgkmcnt(0)" ::: "memory"); SBAR();
#pragma unroll
  for (int d0 = 0; d0 < 4; ++d0) {
    p0 = __builtin_amdgcn_mfma_f32_32x32x16_bf16(bk[2 * d0], qr[d0], p0, 0, 0, 0);
    p1 = __builtin_amdgcn_mfma_f32_32x32x16_bf16(bk[2 * d0 + 1], qr[d0], p1, 0, 0, 0); }
}
__device__ __forceinline__ int v_st(int k, int c) { const int kk = (k & ~0xC) | ((k & 4) << 1) | ((k & 8) >> 1); return ((kk >> 3) * 4 + (c >> 5)) * 512 + ((kk & 7) * 32 + (c & 31)) * 2; }
__device__ __forceinline__ int v_rd_base(int lane) { return ((lane & 3) << 3) | (((lane >> 2) & 3) << 6) | (((lane >> 4) & 1) << 5) | (((lane >> 5) & 1) << 8); }
constexpr int v_rd_off(int d0, int ks, int half) { return d0 * 512 + ks * 4096 + half * 2048; }
template <int OFF> __device__ __forceinline__ s16x4 tr_read(int vb) {
  s16x4 r; asm volatile("ds_read_b64_tr_b16 %0, %1 offset:%2" : "=&v"(r) : "v"(vb), "i"(OFF) : "memory"); return r;
}
template <int D0> __device__ __forceinline__ void pv_one(f32x16& od, int vb, bf16x8 pa0, bf16x8 pa1, bf16x8 pa2, bf16x8 pa3) {
  const s16x4 l0 = tr_read<v_rd_off(D0, 0, 0)>(vb), h0 = tr_read<v_rd_off(D0, 0, 1)>(vb), l1 = tr_read<v_rd_off(D0, 1, 0)>(vb), h1 = tr_read<v_rd_off(D0, 1, 1)>(vb);
  const s16x4 l2 = tr_read<v_rd_off(D0, 2, 0)>(vb), h2 = tr_read<v_rd_off(D0, 2, 1)>(vb), l3 = tr_read<v_rd_off(D0, 3, 0)>(vb), h3 = tr_read<v_rd_off(D0, 3, 1)>(vb);
  asm volatile("s_waitcnt lgkmcnt(0)" ::: "memory"); SBAR();
#define PK(L, H) (bf16x8){L[0], L[1], L[2], L[3], H[0], H[1], H[2], H[3]}
  od = __builtin_amdgcn_mfma_f32_32x32x16_bf16(pa0, PK(l0, h0), od, 0, 0, 0);
  od = __builtin_amdgcn_mfma_f32_32x32x16_bf16(pa1, PK(l1, h1), od, 0, 0, 0);
  od = __builtin_amdgcn_mfma_f32_32x32x16_bf16(pa2, PK(l2, h2), od, 0, 0, 0);
  od = __builtin_amdgcn_mfma_f32_32x32x16_bf16(pa3, PK(l3, h3), od, 0, 0, 0);
#undef PK
}
__device__ __forceinline__ void pv_d0(f32x16* o, int vb, bf16x8 pa0, bf16x8 pa1, bf16x8 pa2, bf16x8 pa3) {
  pv_one<0>(o[0], vb, pa0, pa1, pa2, pa3); pv_one<1>(o[1], vb, pa0, pa1, pa2, pa3); pv_one<2>(o[2], vb, pa0, pa1, pa2, pa3); pv_one<3>(o[3], vb, pa0, pa1, pa2, pa3);
}

template <int H, int D0> __device__ __forceinline__ void pv_half_one(f32x16& od, int vb, bf16x8 pl, bf16x8 ph) {
  const s16x4 la = tr_read<v_rd_off(D0, 2 * H, 0)>(vb), ha = tr_read<v_rd_off(D0, 2 * H, 1)>(vb), lb = tr_read<v_rd_off(D0, 2 * H + 1, 0)>(vb), hb = tr_read<v_rd_off(D0, 2 * H + 1, 1)>(vb);
  asm volatile("s_waitcnt lgkmcnt(0)" ::: "memory"); SBAR();
#define PK(L, H_) (bf16x8){L[0], L[1], L[2], L[3], H_[0], H_[1], H_[2], H_[3]}
  od = __builtin_amdgcn_mfma_f32_32x32x16_bf16(pl, PK(la, ha), od, 0, 0, 0);
  od = __builtin_amdgcn_mfma_f32_32x32x16_bf16(ph, PK(lb, hb), od, 0, 0, 0);
#undef PK
}
template <int H> __device__ __forceinline__ void pv_half(f32x16* o, int vb, bf16x8 pl, bf16x8 ph) {
  pv_half_one<H, 0>(o[0], vb, pl, ph); pv_half_one<H, 1>(o[1], vb, pl, ph); pv_half_one<H, 2>(o[2], vb, pl, ph); pv_half_one<H, 3>(o[3], vb, pl, ph);
}

struct SrcPrompt {
  const bf16* Kh; const bf16* Vh;
  __device__ __forceinline__ const bf16* kp(int t) const { return Kh + (size_t)t * 64 * 1024; }
  __device__ __forceinline__ const bf16* vp(int t) const { return Vh + (size_t)t * 64 * 1024; }
  __device__ __forceinline__ int nvalid(int) const { return 64; }
};
struct SrcSample {
  const float* Kc; const float* Vc; const float* Kn; const float* Vn;
  __device__ __forceinline__ const float* kp(int t) const { return t < 16 ? Kc + (size_t)t * 64 * 1024 : Kn; }
  __device__ __forceinline__ const float* vp(int t) const { return t < 16 ? Vc + (size_t)t * 64 * 1024 : Vn; }
  __device__ __forceinline__ int nvalid(int t) const { return t < 16 ? 64 : 16; }
};

template <typename TKV, int SD, int nvd, bool FIX, class Src>
__device__ __forceinline__ void attn_core(f32x16 (&o)[4], const bf16* qrow, float qposf, float c, int cq, int t0, int NT, const Src& src, char* lds, LAS unsigned char* lds3, int mapoff, float kmaxn, bool cw, int kh) {
  using St = Stage<TKV>;
  int tid_ = threadIdx.x; asm volatile("" : "+v"(tid_));
  const int tid = tid_, wid = tid >> 6, lane = tid & 63, r32 = lane & 31, hi = lane >> 5;
  char* V_lds = lds + L_V; char* K_lds = lds + L_K;
  float* wsf = (float*)(lds + L_WS) + wid * 128; float* li_l = wsf; float* al_l = wsf + 32; float* kc = wsf + 64;
  float m_reg = -1e30f, l_reg = 0; bf16x8 qr[4];
#pragma unroll
  for (int d = 0; d < 4; ++d) o[d] = f32x16{};
#pragma unroll
  for (int d0 = 0; d0 < 4; ++d0) qr[d0] = *reinterpret_cast<const bf16x8*>(qrow + d0 * 16);
  if (lane < 16) kc[lane] = c * (float)((lane & 3) + 8 * (lane >> 2));
  asm volatile("s_waitcnt lgkmcnt(0)" ::: "memory");
  const float c32 = 32.f * c, c2 = 2.f * c;
  const float qrel = (float)(4 * hi) - qposf;
  const int sr = tid >> 4, sc = (tid & 15) * 8, vst0 = v_st(sr, sc), kst0 = KSWZ(sr, sc * 2);
  const int vb0 = (int)(uintptr_t)V_lds + v_rd_base(lane);
  struct { typename St::T vs0, vs1, ks0, ks1; } sr_[SD];
#define SLOAD(i, t) do { const int nv_ = src.nvalid(t); const int r0_ = sr < nv_ ? sr : nv_ - 1, r1_ = 32 + sr < nv_ ? 32 + sr : nv_ - 1; \
    const TKV* kp_ = src.kp(t); const TKV* vp_ = src.vp(t); \
    sr_[i].vs0 = St::ld8(vp_ + (size_t)r0_ * 1024 + sc); sr_[i].vs1 = St::ld8(vp_ + (size_t)r1_ * 1024 + sc); \
    sr_[i].ks0 = St::ld8(kp_ + (size_t)r0_ * 1024 + sc); sr_[i].ks1 = St::ld8(kp_ + (size_t)r1_ * 1024 + sc); } while (0)
#define SWRITE(b, i) do { *(bf16x8*)(V_lds + (b) * SHM_V + vst0) = St::tobf(sr_[i].vs0);          \
    *(bf16x8*)(V_lds + (b) * SHM_V + vst0 + 8192) = St::tobf(sr_[i].vs1);               \
    *(bf16x8*)(K_lds + (b) * SHM_K + kst0) = St::tobf(sr_[i].ks0);                       \
    *(bf16x8*)(K_lds + (b) * SHM_K + kst0 + 8192) = St::tobf(sr_[i].ks1); } while (0)
#define SWRITE3(off, i) do { *(bf16x8*)(V_lds + (off) + vst0) = St::tobf(sr_[i].vs0);          \
    *(bf16x8*)(V_lds + (off) + vst0 + 8192) = St::tobf(sr_[i].vs1);               \
    *(bf16x8*)(K_lds + (off) + kst0) = St::tobf(sr_[i].ks0);                       \
    *(bf16x8*)(K_lds + (off) + kst0 + 8192) = St::tobf(sr_[i].ks1); } while (0)
#define SWAIT() do { if constexpr (SD == 2) asm volatile("s_waitcnt vmcnt(4)" ::: "memory"); else asm volatile("s_waitcnt vmcnt(0)" ::: "memory"); } while (0)
#define RESC(a) do { if (__any((a) < 1.f)) { int tl_ = threadIdx.x; asm volatile("" : "+v"(tl_)); const int hi_ = (tl_ >> 5) & 1; if (hi_ == 0) al_l[tl_ & 31] = (a); asm volatile("s_waitcnt lgkmcnt(0)" ::: "memory"); \
    for (int d = 0; d < 4; ++d) for (int r = 0; r < 16; ++r) o[d][r] *= al_l[crow(r, hi_)]; } } while (0)
#define POST(P0, P1, t) do { if ((t) == cq) { const float d0_ = (float)(64 * (t)) + qrel; \
      for (int r = 0; r < 16; ++r) { const float d_ = d0_ + (float)((r & 3) + 8 * (r >> 2)); P0[r] -= c2 * fmaxf(d_, 0.f); P1[r] -= c2 * fmaxf(d_ + 32.f, 0.f); } \
      if (nvd < 64) { for (int r = 0; r < 16; ++r) { const int kk_ = crow(r, hi); if (kk_ >= nvd) P0[r] = -1e30f; if (kk_ + 32 >= nvd) P1[r] = -1e30f; } } } } while (0)
#define BASE(t) ((t) > cq ? -1e30f : c * ((float)(64 * (t)) + qrel))
  if constexpr (SD == 2) {
  float mn, al;
  SLOAD(0, t0); SLOAD(1, t0 + 1); SWRITE(0, 0); __syncthreads();
#define HPK(L, H_) (bf16x8){L[0], L[1], L[2], L[3], H_[0], H_[1], H_[2], H_[3]}
#define HSTEP(t, bsel) do { \
    f32x16 ph; \
    { const f32x4 k0 = *(const f32x4*)kc, k1 = *(const f32x4*)(kc + 4), k2 = *(const f32x4*)(kc + 8), k3 = *(const f32x4*)(kc + 12); \
      ph = (f32x16){k0[0], k0[1], k0[2], k0[3], k1[0], k1[1], k1[2], k1[3], k2[0], k2[1], k2[2], k2[3], k3[0], k3[1], k3[2], k3[3]}; } \
    const int vbh_ = vb0 + (bsel) * SHM_V + kh * 8192; \
    s16x4 vl0a, vh0a, vl0b, vh0b, vl1a, vh1a, vl1b, vh1b, vl2a, vh2a, vl2b, vh2b, vl3a, vh3a, vl3b, vh3b;        \
    { bf16x8 bk[4]; \
      _Pragma("unroll") for (int d0 = 0; d0 < 4; ++d0) { const int cb = (mapoff + d0 * 16 + hi * 8) * 2; bk[d0] = *reinterpret_cast<const bf16x8*>(K_lds + (bsel) * SHM_K + kh * 8192 + KSWZ(r32, cb)); } \
      vl0a = tr_read<v_rd_off(0, 0, 0)>(vbh_); vh0a = tr_read<v_rd_off(0, 0, 1)>(vbh_); vl0b = tr_read<v_rd_off(0, 1, 0)>(vbh_); vh0b = tr_read<v_rd_off(0, 1, 1)>(vbh_); \
      vl1a = tr_read<v_rd_off(1, 0, 0)>(vbh_); vh1a = tr_read<v_rd_off(1, 0, 1)>(vbh_); vl1b = tr_read<v_rd_off(1, 1, 0)>(vbh_); vh1b = tr_read<v_rd_off(1, 1, 1)>(vbh_); \
      vl2a = tr_read<v_rd_off(2, 0, 0)>(vbh_); vh2a = tr_read<v_rd_off(2, 0, 1)>(vbh_); vl2b = tr_read<v_rd_off(2, 1, 0)>(vbh_); vh2b = tr_read<v_rd_off(2, 1, 1)>(vbh_); \
      vl3a = tr_read<v_rd_off(3, 0, 0)>(vbh_); vh3a = tr_read<v_rd_off(3, 0, 1)>(vbh_); vl3b = tr_read<v_rd_off(3, 1, 0)>(vbh_); vh3b = tr_read<v_rd_off(3, 1, 1)>(vbh_); \
      asm volatile("s_waitcnt lgkmcnt(0)" ::: "memory"); SBAR(); \
      _Pragma("unroll") for (int d0 = 0; d0 < 4; ++d0) ph = __builtin_amdgcn_mfma_f32_32x32x16_bf16(bk[d0], qr[d0], ph, 0, 0, 0); } \
    if ((t) == cq) { const float d0_ = (float)(64 * (t) + 32 * kh) + qrel; \
      for (int r = 0; r < 16; ++r) { const float d_ = d0_ + (float)((r & 3) + 8 * (r >> 2)); ph[r] -= c2 * fmaxf(d_, 0.f); } \
      if (nvd < 64) { for (int r = 0; r < 16; ++r) { const int kk_ = crow(r, hi) + 32 * kh; if (kk_ >= nvd) ph[r] = -1e30f; } } } \
    const float base_ = (t) > cq ? -1e30f : c * ((float)(64 * (t) + 32 * kh) + qrel); \
    float pm_ = ph[0]; for (int r = 1; r < 16; ++r) pm_ = fmaxf(pm_, ph[r]); pm_ += base_; \
    { auto rr = __builtin_amdgcn_permlane32_swap(__float_as_uint(pm_), __float_as_uint(pm_), false, false); pm_ = fmaxf(__uint_as_float(rr[0]), __uint_as_float(rr[1])); } \
    if (__builtin_expect(__all(pm_ - m_reg <= THR), 1)) { mn = m_reg; al = 1.f; } else { mn = fmaxf(m_reg, pm_); al = __builtin_amdgcn_exp2f(m_reg - mn); m_reg = mn; } \
    { const float off_ = base_ - mn; for (int r = 0; r < 16; ++r) ph[r] = __builtin_amdgcn_exp2f(ph[r] + off_); } \
    RESC(al); \
    { float ps = 0; for (int r = 0; r < 16; ++r) ps += ph[r]; \
      auto rr = __builtin_amdgcn_permlane32_swap(__float_as_uint(ps), __float_as_uint(ps), false, false); ps = __uint_as_float(rr[0]) + __uint_as_float(rr[1]); l_reg = l_reg * al + ps; } \
    bf16x8 pl_, ph_; \
    { unsigned a0 = cvtpk(ph[0], ph[1]), a1 = cvtpk(ph[2], ph[3]), b0 = cvtpk(ph[4], ph[5]), b1 = cvtpk(ph[6], ph[7]); \
      auto r0 = __builtin_amdgcn_permlane32_swap(a0, b0, false, false); auto r1 = __builtin_amdgcn_permlane32_swap(a1, b1, false, false); v4u w = {r0[0], r1[0], r0[1], r1[1]}; pl_ = __builtin_bit_cast(bf16x8, w); } \
    { unsigned a0 = cvtpk(ph[8], ph[9]), a1 = cvtpk(ph[10], ph[11]), b0 = cvtpk(ph[12], ph[13]), b1 = cvtpk(ph[14], ph[15]); \
      auto r0 = __builtin_amdgcn_permlane32_swap(a0, b0, false, false); auto r1 = __builtin_amdgcn_permlane32_swap(a1, b1, false, false); v4u w = {r0[0], r1[0], r0[1], r1[1]}; ph_ = __builtin_bit_cast(bf16x8, w); } \
    SBAR(); \
    o[0] = __builtin_amdgcn_mfma_f32_32x32x16_bf16(pl_, HPK(vl0a, vh0a), o[0], 0, 0, 0); o[1] = __builtin_amdgcn_mfma_f32_32x32x16_bf16(pl_, HPK(vl1a, vh1a), o[1], 0, 0, 0); \
    o[2] = __builtin_amdgcn_mfma_f32_32x32x16_bf16(pl_, HPK(vl2a, vh2a), o[2], 0, 0, 0); o[3] = __builtin_amdgcn_mfma_f32_32x32x16_bf16(pl_, HPK(vl3a, vh3a), o[3], 0, 0, 0); \
    o[0] = __builtin_amdgcn_mfma_f32_32x32x16_bf16(ph_, HPK(vl0b, vh0b), o[0], 0, 0, 0); o[1] = __builtin_amdgcn_mfma_f32_32x32x16_bf16(ph_, HPK(vl1b, vh1b), o[1], 0, 0, 0); \
    o[2] = __builtin_amdgcn_mfma_f32_32x32x16_bf16(ph_, HPK(vl2b, vh2b), o[2], 0, 0, 0); o[3] = __builtin_amdgcn_mfma_f32_32x32x16_bf16(ph_, HPK(vl3b, vh3b), o[3], 0, 0, 0); } while (0)
#define STEP1(t, bsel, nset, cset, havenext, haveload) do { \
    { const int tl2_ = (t) + 2 < NT ? (t) + 2 : NT - 1; (void)(haveload); SLOAD(cset, tl2_); }        \
    SBAR(); if (cw) { HSTEP(t, bsel); } \
    if (havenext) { SWRITE((bsel) ^ 1, nset); } \
    __syncthreads(); } while (0)
  for (int t = t0; t < NT; t += 2) {
    STEP1(t, 0, 1, 0, true, t + 2 < NT);
    STEP1(t + 1, 1, 0, 1, t + 2 < NT, t + 3 < NT);
  }
#undef STEP1
#undef HSTEP
#undef HPK
  { float* mx = (float*)(lds + L_EX); float* lx = mx + 256; float* ox = mx + 1024;
    if (cw && lane < 32) mx[wid * 32 + lane] = m_reg;
    __syncthreads();
    if (cw) { const float mo = mx[(wid ^ 1) * 32 + r32]; const float sc = __builtin_amdgcn_exp2f(m_reg - fmaxf(m_reg, mo)); l_reg *= sc;
      RESC(sc);
      if (wid & 1) {
        const int mp = wid >> 2;
#pragma unroll
        for (int d = 0; d < 4; ++d)
#pragma unroll
          for (int r = 0; r < 16; ++r) ox[(mp * 64 + d * 16 + r) * 64 + lane] = o[d][r];
        if (lane < 32) lx[wid * 32 + lane] = l_reg; } }
    __syncthreads();
    if (cw && !(wid & 1)) { const int mp = wid >> 2;
#pragma unroll
      for (int d = 0; d < 4; ++d)
        { _Pragma("unroll") for (int r = 0; r < 16; ++r) o[d][r] += ox[(mp * 64 + d * 16 + r) * 64 + lane]; SBAR(); }
      l_reg += lx[(wid ^ 1) * 32 + r32]; }
    __syncthreads();
  }
  } else {
  f32x16 C0, C1; float mn = 0.f, al = 1.f; bf16x8 pa0, pa1, pa2, pa3;
  const int n_ = NT - t0;
  unsigned ksrc0, vsrc0;
  { const int L = tid * 16;
    { const int row = L >> 8, csw = (L >> 4) & 15; ksrc0 = (unsigned)(row * 1024 + ((csw ^ (row & 15)) * 8)) * 2u; }
    { const int st = L >> 9, within = (L & 511) >> 1, kk = (st >> 2) * 8 + (within >> 5), cc = (st & 3) * 32 + (within & 31), k = (kk & ~0xC) | ((kk & 4) << 1) | ((kk & 8) >> 1); vsrc0 = (unsigned)(k * 1024 + cc) * 2u; } }
  const unsigned ldsb = (unsigned)__builtin_amdgcn_readfirstlane((int)((unsigned)(uintptr_t)lds3 + (unsigned)wid * 1024u));
#define GLDS16(gp, la) do { unsigned sv_; asm volatile("s_mov_b32 %0, m0\n\ts_mov_b32 m0, %2\n\ts_nop 0\n\tglobal_load_lds_dwordx4 %1, off\n\ts_mov_b32 m0, %0" : "=&s"(sv_) : "v"(gp), "s"(la) : "memory"); } while (0)
#define DMA_K(off, t) do { const char* kp_ = (const char*)src.kp(t) + ksrc0; GLDS16(kp_, ldsb + (unsigned)(L_K + (off))); GLDS16(kp_ + 65536, ldsb + (unsigned)(L_K + 8192 + (off))); } while (0)
#define DMA_V(off, t) do { const char* vp_ = (const char*)src.vp(t) + vsrc0; GLDS16(vp_, ldsb + (unsigned)(L_V + (off))); GLDS16(vp_ + 65536, ldsb + (unsigned)(L_V + 8192 + (off))); } while (0)
#define WAIT_BAR(N) asm volatile("s_waitcnt vmcnt(" #N ") lgkmcnt(0)\n\ts_barrier" ::: "memory")
  float mref = 0.f;
  if constexpr (FIX) {
    float q2 = 0.f;
#pragma unroll
    for (int d0 = 0; d0 < 4; ++d0) { const v4u w = __builtin_bit_cast(v4u, qr[d0]);
      q2 += bflo(w.x) * bflo(w.x) + bfhi(w.x) * bfhi(w.x) + bflo(w.y) * bflo(w.y) + bfhi(w.y) * bfhi(w.y) + bflo(w.z) * bflo(w.z) + bfhi(w.z) * bfhi(w.z) + bflo(w.w) * bflo(w.w) + bfhi(w.w) * bfhi(w.w); }
    { auto rr = __builtin_amdgcn_permlane32_swap(__float_as_uint(q2), __float_as_uint(q2), false, false); q2 = __uint_as_float(rr[0]) + __uint_as_float(rr[1]); }
    mref = 1.02f * sqrtf(q2) * kmaxn + 0.5f;
  }
#define SOFTMAX(t_) do { POST(C0, C1, t_); \
    if constexpr (FIX) { const float off0_ = BASE(t_) - mref, off1_ = off0_ + c32; \
      for (int r = 0; r < 16; ++r) C0[r] = __builtin_amdgcn_exp2f(C0[r] + off0_); for (int r = 0; r < 16; ++r) C1[r] = C1[r] + off1_; } \
    else { partialSM(C0, C1, m_reg, mn, al, BASE(t_), c32); RESC(al); } \
    finishSM(C0, C1, al, l_reg, pa0, pa1, pa2, pa3); } while (0)
  int s_prev = 32768, s_cur = 0, s_next = 16384;
#define ROT3() do { s_prev = s_cur; s_cur = s_next; s_next = s_next == 32768 ? 0 : s_next + 16384; asm volatile("" : "+s"(s_prev), "+s"(s_cur), "+s"(s_next)); } while (0)
#define ISSUE(i_) do { if ((i_) + 2 < n_) { DMA_K(s_prev, t0 + (i_) + 2); } if ((i_) + 1 < n_) { DMA_V(s_next, t0 + (i_) + 1); } } while (0)
#define ENDW(i_) do { if ((i_) + 2 < n_) { WAIT_BAR(4); } else if ((i_) + 1 < n_) { WAIT_BAR(2); } else { WAIT_BAR(0); } } while (0)
  DMA_K(0, t0); DMA_K(16384, t0 + 1); DMA_V(0, t0); ISSUE(0);
  if (2 < n_) { WAIT_BAR(8); } else { WAIT_BAR(6); }
  if (wid < 4) {
    qkt(C0, C1, K_lds, qr, kc, r32, hi, mapoff); SOFTMAX(t0); SBAR();
    ENDW(0); ROT3();
    for (int i = 1; i < n_; ++i) { const int t_ = t0 + i;
      ISSUE(i);
      SBAR(); qkt(C0, C1, K_lds + s_cur, qr, kc, r32, hi, mapoff);
      pv_d0(o, vb0 + s_prev, pa0, pa1, pa2, pa3); SBAR();
      SOFTMAX(t_); SBAR();
      ENDW(i); ROT3(); }
    pv_d0(o, vb0 + s_prev, pa0, pa1, pa2, pa3);
  } else {
    qkt(C0, C1, K_lds, qr, kc, r32, hi, mapoff); SBAR();
    ENDW(0); ROT3();
    for (int i = 1; i < n_; ++i) { const int t_ = t0 + i;
      ISSUE(i);
      SBAR(); SOFTMAX(t_ - 1); SBAR();
      pv_d0(o, vb0 + s_prev, pa0, pa1, pa2, pa3);
      qkt(C0, C1, K_lds + s_cur, qr, kc, r32, hi, mapoff); SBAR();
      ENDW(i); ROT3(); }
    SOFTMAX(t0 + n_ - 1); SBAR();
    pv_d0(o, vb0 + s_prev, pa0, pa1, pa2, pa3);
  }
#undef ISSUE
#undef ENDW
#undef SOFTMAX
#undef ROT3
#undef GLDS16
#undef DMA_K
#undef DMA_V
#undef WAIT_BAR
  }
  { int tl_ = threadIdx.x; asm volatile("" : "+v"(tl_)); const int hi_ = (tl_ >> 5) & 1;
  if (hi_ == 0) li_l[tl_ & 31] = l_reg; asm volatile("s_waitcnt lgkmcnt(0)" ::: "memory");
#pragma unroll
  for (int r = 0; r < 16; ++r) { const float rl = __builtin_amdgcn_rcpf(li_l[crow(r, hi_)]);
#pragma unroll
    for (int d = 0; d < 4; ++d) o[d][r] *= rl; } }
#undef SLOAD
#undef SWRITE
#undef SWRITE3
#undef SWAIT
#undef RESC
#undef POST
#undef BASE
}

__device__ __forceinline__ void attn_finish(f32x16 (&o)[4], float lam, const float* gsub, bf16* A2h, int rowbase, int nrows, bool store, char* lds, int exslot, bool act) {
  int tid_ = threadIdx.x; asm volatile("" : "+v"(tid_));
  const int tid = tid_, wid = tid >> 6, lane = tid & 63, r32 = lane & 31, hi = lane >> 5;
  float* ex = (float*)(lds + L_EX) + (exslot < 0 ? (wid & 3) : exslot) * 4096 + lane;
  __syncthreads();
  if (wid >= 4 && act) {
#pragma unroll
    for (int d = 0; d < 4; ++d)
#pragma unroll
      for (int r = 0; r < 16; ++r) ex[(d * 16 + r) * 64] = lam * o[d][r];
  }
  __syncthreads();
  if (wid < 4 && act) {
    float g[4];
#pragma unroll
    for (int d = 0; d < 4; ++d) g[d] = gsub[32 * d + r32] * (1.0f - LAM_INIT);
#pragma unroll
    for (int r = 0; r < 16; ++r) {
      float ss = 0.f;
#pragma unroll
      for (int d = 0; d < 4; ++d) { const float a = o[d][r] - ex[(d * 16 + r) * 64]; o[d][r] = a; ss += a * a; }
      ss += __shfl_xor(ss, 1); ss += __shfl_xor(ss, 2); ss += __shfl_xor(ss, 4); ss += __shfl_xor(ss, 8); ss += __shfl_xor(ss, 16);
      const float rstd = 1.0f / sqrtf(ss * (1.0f / 128.f) + EPS);
#pragma unroll
      for (int d = 0; d < 4; ++d) o[d][r] *= rstd * g[d];
    }
    unsigned short* stg = (unsigned short*)(lds + L_EX) + (wid & 3) * 8192;
#pragma unroll
    for (int r = 0; r < 16; ++r) {
      const int row = crow(r, hi);
#pragma unroll
      for (int d = 0; d < 4; ++d) stg[row * 136 + 32 * d + r32] = (unsigned short)f2bf(o[d][r]);
    }
    asm volatile("s_waitcnt lgkmcnt(0)" ::: "memory");
    if (store) {
#pragma unroll
      for (int i = 0; i < 8; ++i) {
        const int id = lane + 64 * i, row = id >> 4, c16 = id & 15;
        if (row < nrows) *(v4u*)(A2h + (size_t)(rowbase + row) * 2048 + c16 * 8) = *(const v4u*)(stg + row * 136 + c16 * 8);
      }
    }
  }
  __syncthreads();
}
#undef SBAR
}

constexpr int N_PHASES = 8;
#ifndef WGM_P1
#define WGM_P1 2
#endif
#ifndef WGM_P3
#define WGM_P3 2
#endif
#ifndef WGM_P5
#define WGM_P5 2
#endif
#ifndef WGM_P6
#define WGM_P6 2
#endif
constexpr int NSL5 = 8, NSL9 = 11;
constexpr int N_LAUNCHES = MK_N_LAUNCHES;

__global__ void __launch_bounds__(NWAVES * 64, 2) hymba_fwd(Args args) {
    extern __shared__ __attribute__((aligned(16))) unsigned char lds_raw[];
    LAS unsigned char* lds = (LAS unsigned char*)lds_raw;
    volatile LAS unsigned* MISC = (volatile LAS unsigned*)(lds + LDSCTL_OFF);
    const int tid = threadIdx.x, lane = tid & 63, wave = __builtin_amdgcn_readfirstlane(tid >> 6);
    const int G = gridDim.x; const int bx = blockIdx.x;
    const int vcu = (G % 8 == 0) ? (bx % 8) * (G / 8) + bx / 8 : bx;
    unsigned char* ws = args.ws;
    gu32* ctl = (gu32*)(ws + WS_CTL);
    for (int u = tid; u < (LDS_BYTES - LDSCTL_OFF) / 4; u += NWAVES * 64) ((LAS unsigned*)(lds + LDSCTL_OFF))[u] = 0u;
    __syncthreads();
    XcdBarrier bar; bar.bar = (unsigned*)(ctl + CW_BAR); bar.x = 0; bar.st = nullptr;
    if (N_LAUNCHES == 1) bar = xcd_barrier_post((unsigned*)(ctl + CW_BAR), MISC + 8);
    const int lo = args.ph_lo, hi_ph = args.ph_hi;
    const int nwg1_ = (MT / 256) * (NPROJ / 256), nfull1 = nwg1_ - ((nwg1_ + G - 1) / G - 1) * G, cv1 = nfull1 < G ? ((G - nfull1) * 3 < 416 ? (G - nfull1) * 3 : 416) : 0;
    const int nwg5_ = (MT / 256) * (2 * DFF / 256), nfull5 = nwg5_ - ((nwg5_ + G - 1) / G - 1) * G, cv5 = nfull5 < G ? ((G - nfull5) * 4 < 176 ? (G - nfull5) * 4 : 176) : 0;
#ifndef PHASE_MASK
#define PHASE_MASK 0xff
#endif
#define IN(k) (((PHASE_MASK >> (k)) & 1) && lo <= (k) && (k) < hi_ph)
#ifdef PROBE_PHASE
    unsigned long long pr_a = 0, pr_b = 0;
#define PSTART(k) do { if ((k) == PROBE_PHASE) pr_a = __builtin_amdgcn_s_memrealtime(); } while (0)
#define PEND(k) do { if ((k) == PROBE_PHASE) pr_b = __builtin_amdgcn_s_memrealtime(); } while (0)
#else
#define PSTART(k) do {} while (0)
#define PEND(k) do {} while (0)
#endif
#define SEAM(k) do { if (IN(k) && IN((k) + 1)) xcd_barrier(bar); PEND(k); PSTART((k) + 1); } while (0)

    bf16* WIN = (bf16*)(ws + WS_WIN); bf16* WOUT = (bf16*)(ws + WS_WOUT); bf16* WGU = (bf16*)(ws + WS_WGU); bf16* WDN = (bf16*)(ws + WS_WDN);
    bf16* XN = (bf16*)(ws + WS_XN);

    PSTART(0);
    if (IN(0)) {
        {
            LAS float* scr = (LAS float*)(lds + wave * 16896);
            const int gw = vcu * NWAVES + wave, NGW = G * NWAVES;
            constexpr int NITEM = 32 * 88;
            f32x4 v[16];
            int itn = gw;
            P0Item cur{};
            if (itn < NITEM) { cur = p0_item(args, ws, itn); p0_load(cur, v, lane); }
            while (itn < NITEM) {
                p0_to_lds(cur, v, scr, lane);
                const P0Item done = cur;
                itn += NGW;
                if (itn < NITEM) { cur = p0_item(args, ws, itn); p0_load(cur, v, lane); }
                p0_store(done, scr, lane);
            }
        }
        __syncthreads();
        {
            int tp_ = threadIdx.x; asm volatile("" : "+v"(tp_));
            const int ln = tp_ & 63, wv = __builtin_amdgcn_readfirstlane(tp_ >> 6), i16 = ln & 15, kg = ln >> 4;
            bf16x8 bw[8];
            { const float* wsrc = args.in[I_WIN] + (size_t)(256 * wv + 8 * kg) * DIN + NPROJ + i16;
#pragma unroll
              for (int sI = 0; sI < 8; ++sI) { float f[8];
#pragma unroll
                for (int e = 0; e < 8; ++e) f[e] = wsrc[(size_t)(32 * sI + e) * DIN];
                v4u w; w.x = pk2(f[0], f[1]); w.y = pk2(f[2], f[3]); w.z = pk2(f[4], f[5]); w.w = pk2(f[6], f[7]); bw[sI] = __builtin_bit_cast(bf16x8, w); } }
            const float* gmix = args.in[I_GMIX];
            float* DT = (float*)(ws + WS_DT);
            f32x4 gm[8];
#pragma unroll
            for (int j = 0; j < 8; ++j) gm[j] = *(const f32x4*)(gmix + 4 * ln + 256 * j);
            constexpr int RPITCH = 4112;
            LAS unsigned char* rowsl = lds; LAS float* part = (LAS float*)(lds + 8 * RPITCH);
            const int NG = MT / 8, nIter = (NG - vcu + G - 1) / G;
            f32x4 nx[8], ny[8];
#define XROW(it_) ([&]() { const int g_ = vcu + (it_) * G; const int m_ = g_ < NG ? 8 * g_ + wv : MT - 1; return m_ < MP ? args.in[I_XP] + (size_t)m_ * DM : args.in[I_XS] + (size_t)(m_ - MP) * DM; }())
#define XLOAD(buf, it_) do { const float* xr_ = XROW(it_); _Pragma("unroll") for (int j = 0; j < 8; ++j) buf[j] = __builtin_nontemporal_load((const f32x4*)(xr_ + 4 * ln + 256 * j)); } while (0)
#define XBODY(buf, it_) do { \
                const int m = 8 * (vcu + (it_) * G) + wv; \
                f32x4 v[8]; float sq = 0.f; \
                _Pragma("unroll") for (int j = 0; j < 8; ++j) { v[j] = buf[j]; sq += (v[j][0] * v[j][0] + v[j][1] * v[j][1]) + (v[j][2] * v[j][2] + v[j][3] * v[j][3]); } \
                XLOAD(buf, (it_) + 2);                  \
                const float rstd = 1.0f / sqrtf(wave_sum(sq) * (1.0f / DM) + EPS); \
                _Pragma("unroll") for (int j = 0; j < 8; ++j) { v[j] = v[j] * rstd * gm[j]; \
                    v2u w; w.x = pk2(v[j][0], v[j][1]); w.y = pk2(v[j][2], v[j][3]); *(v2u*)(XN + (size_t)m * DM + 4 * ln + 256 * j) = w; \
                    *(LAS v2u*)(rowsl + wv * RPITCH + (4 * ln + 256 * j) * 2) = w; } \
                __syncthreads(); \
                f32x4 acc = {0.f, 0.f, 0.f, 0.f}; \
                { bf16x8 af[8]; const LAS unsigned char* ap = rowsl + (i16 & 7) * RPITCH + (256 * wv + 8 * kg) * 2; \
                  _Pragma("unroll") for (int sI = 0; sI < 8; ++sI) af[sI] = *(const LAS bf16x8*)(ap + sI * 64); \
                  _Pragma("unroll") for (int sI = 0; sI < 8; ++sI) acc = __builtin_amdgcn_mfma_f32_16x16x32_bf16(af[sI], bw[sI], acc, 0, 0, 0); } \
                if (kg < 2) { _Pragma("unroll") for (int r = 0; r < 4; ++r) part[(wv * 8 + 4 * kg + r) * 16 + i16] = acc[r]; } \
                __syncthreads(); \
                if (tp_ < 128) { float t = 0.f; _Pragma("unroll") for (int w8 = 0; w8 < 8; ++w8) t += part[w8 * 128 + tp_]; \
                    const float xx = t + args.in[I_DTB][tp_ & 15]; DT[(size_t)(8 * (vcu + (it_) * G) + (tp_ >> 4)) * 16 + (tp_ & 15)] = fmaxf(xx, 0.f) + log1pf(__expf(-fabsf(xx))); } \
            } while (0)
            XLOAD(nx, 0); XLOAD(ny, 1);
            for (int it = 0; it < nIter; it += 2) {
                XBODY(nx, it);
                if (it + 1 < nIter) XBODY(ny, it + 1);
            }
#undef XROW
#undef XLOAD
#undef XBODY
        }
        __syncthreads();
    }
    SEAM(0);

    if (IN(1)) {
        pg8::Gemm g{XN, WIN, MT, NPROJ, DM}; pg8::StaticOrder S; S.init(MT, NPROJ, DM, G, bx, WGM_P1);
        EpiInProj E{(bf16*)(ws + WS_Q), (bf16*)(ws + WS_K), (bf16*)(ws + WS_V), (bf16*)(ws + WS_Z), (bf16*)(ws + WS_XBC), args.out, (unsigned*)(ctl + CW_QK)};
        pg8::gemm_phase<EpiInProj, pg8::StaticOrder, false, true>(lds, g, S, E);
        if (bx >= nfull1) { __syncthreads(); for (int c = (bx - nfull1) * 3; c < (bx - nfull1) * 3 + 3 && c < cv1; ++c) conv_item(args, ws, lds, c); }
    }
    SEAM(1);

    if (IN(2)) {
        const bf16* Qb = (const bf16*)(ws + WS_Q); const bf16* Kb = (const bf16*)(ws + WS_K); const bf16* Vb = (const bf16*)(ws + WS_V);
        bf16* A2 = (bf16*)(ws + WS_A2);
        volatile LAS int* qslot = (volatile LAS int*)(lds + LDSCTL_OFF + 64);
        volatile LAS float* blkc = (volatile LAS float*)(lds + LDSCTL_OFF + 128);
        if (wave == 0) {
            const int l6 = tid & 63;
            const float a = args.in[I_LQ1][l6] * args.in[I_LK1][l6], b = args.in[I_LQ2][l6] * args.in[I_LK2][l6];
            const float lamv = __expf(wave_sum(a)) - __expf(wave_sum(b)) + LAM_INIT;
            if (l6 == 0) blkc[0] = lamv;
            if (l6 < 8) {
                float qkb = 0.f;
#pragma unroll
                for (int m = 0; m < 2; ++m) { const unsigned* w = (const unsigned*)(ctl + CW_QK) + 2 * (2 * l6 + m);
                    const float q2 = __uint_as_float(__hip_atomic_load(w, __ATOMIC_RELAXED, __HIP_MEMORY_SCOPE_AGENT)) + __uint_as_float(__hip_atomic_load(w + 1, __ATOMIC_RELAXED, __HIP_MEMORY_SCOPE_AGENT));
                    const float k2 = __uint_as_float(__hip_atomic_load(w + 32, __ATOMIC_RELAXED, __HIP_MEMORY_SCOPE_AGENT)) + __uint_as_float(__hip_atomic_load(w + 33, __ATOMIC_RELAXED, __HIP_MEMORY_SCOPE_AGENT));
                    qkb = fmaxf(qkb, sqrtf(q2 * k2)); blkc[16 + 2 * l6 + m] = sqrtf(k2); }
                const bool fixh = 2.f * 1.02f * qkb + 1.f <= 90.f;
                blkc[8 + l6] = (2.f * 1.02f * qkb + (fixh ? 1.f : att::THR) + 64.f) / (exp2f(-(float)(l6 + 1)) * LOG2E);
                blkc[32 + l6] = fixh ? 1.f : 0.f;
            }
        }
        __syncthreads();
        constexpr int NA1 = 256, NA2 = 128, NA3 = 128;
        constexpr int Q_A0 = 256, Q_LOC = Q_A0 + 320, Q_ATT1 = Q_LOC + NA1, Q_SCAN = Q_ATT1 + 64, Q_ATT2 = Q_SCAN + NA2, Q_OUT = Q_ATT2 + 320, Q_CONV = Q_OUT + (512 - NA1 - NA2); const int Q_END = Q_CONV + 592 - cv1 - cv5;
#define ITEM_DONE(word) do { asm volatile("s_waitcnt vmcnt(0)" ::: "memory"); __syncthreads(); \
            if (tid == 0) { __builtin_amdgcn_fence(__ATOMIC_RELEASE, "agent"); asm volatile("s_waitcnt vmcnt(0)" ::: "memory"); (void)atomicAdd((unsigned*)(ctl + (word)), 1u); } } while (0)
#define ITEM_WAIT(word, need) do { if (tid == 0) { unsigned sp_ = 0; while (__hip_atomic_load((unsigned*)(ctl + (word)), __ATOMIC_RELAXED, __HIP_MEMORY_SCOPE_AGENT) < (unsigned)(need)) { __builtin_amdgcn_s_sleep(8); if (++sp_ > (1u << 22)) break; } \
            __builtin_amdgcn_fence(__ATOMIC_ACQUIRE, "agent"); asm volatile("s_waitcnt vmcnt(0)" ::: "memory"); } __syncthreads(); } while (0)
#ifdef PROBE_CAT
        volatile LAS unsigned long long* pcs = (volatile LAS unsigned long long*)(lds + LDSCTL_OFF + 512);
        if (tid == 0) { pcs[0] = __builtin_amdgcn_s_memrealtime(); pcs[1] = 99; pcs[2] = pcs[0]; }
#define PC_MARK(nc) do { if (tid == 0) { const unsigned long long n_ = __builtin_amdgcn_s_memrealtime(); const unsigned long long c_ = pcs[1]; if (c_ < 8) (void)atomicAdd((unsigned long long*)(ctl + 8576) + c_, n_ - pcs[0]); pcs[0] = n_; pcs[1] = (unsigned long long)(nc); } } while (0)
#else
#define PC_MARK(nc) do {} while (0)
#endif
        for (;;) {
            __syncthreads();
            if (tid == 0) *qslot = (int)atomicAdd((unsigned*)(ctl + CW_QUEUE), 1u);
            __syncthreads();
            const int p = *qslot;
            PC_MARK(p >= Q_END ? 6 : p >= Q_CONV ? 5 : (p >= Q_A0 && p < Q_LOC) ? 2 : (p >= Q_ATT1 && p < Q_SCAN) ? 3 : (p >= Q_ATT2 && p < Q_OUT) ? 4 : ((p < Q_A0 ? p : (p < Q_ATT1 ? p - Q_LOC + 256 : (p < Q_ATT2 ? p - Q_SCAN + 256 + NA1 : p - Q_OUT + 256 + NA1 + NA2))) % 3 == 1) ? 1 : 0);
#ifdef PROBE_CAT
            if (p >= Q_END && tid == 0) (void)atomicAdd((unsigned long long*)(ctl + 8576) + 7, __builtin_amdgcn_s_memrealtime() - pcs[2]);
#endif
            if (p >= Q_END) break;
            if (p >= Q_CONV) { conv_item(args, ws, lds, cv1 + (p - Q_CONV)); continue; }
            if (p >= Q_A0 && p < Q_LOC) { ssd_local(args, lds, p - Q_A0); ITEM_DONE(CW_LDONE); continue; }
            if (p >= Q_ATT1 && p < Q_SCAN) { ITEM_WAIT(CW_LDONE, 320); { int te_ = tid; asm volatile("" : "+v"(te_)); ssd_scan(args, p - Q_ATT1, te_); } ITEM_DONE(CW_SDONE); continue; }
            if (p >= Q_ATT2 && p < Q_OUT) { ITEM_WAIT(CW_SDONE, 64); ssd_out(args, lds, p - Q_ATT2); continue; }
            const int ap = p < Q_A0 ? p : (p < Q_ATT1 ? p - Q_LOC + 256 : (p < Q_ATT2 ? p - Q_SCAN + 256 + NA1 : p - Q_OUT + 256 + NA1 + NA2));
            const int per5 = ap / 5, sl5 = ap - 5 * per5;
            const bool samp = ap < 640 && (sl5 == 1 || sl5 == 3);
            const int grp = 2 * per5 + (sl5 == 3 ? 1 : 0);
            const int qidx = ap < 640 ? 3 * per5 + (sl5 >> 1) : ap - 256;
            int tl_ = threadIdx.x; asm volatile("" : "+v"(tl_));
            const int r32 = tl_ & 31, hi = (tl_ >> 5) & 1, wv_ = __builtin_amdgcn_readfirstlane(tl_ >> 6), map = wv_ >> 2, w4 = wv_ & 3;
            const float lam = blkc[0];
            f32x16 o[4];
            if (samp) {
                const int b = grp & 31, h = grp >> 5;
                const float cs = exp2f(-(float)(h + 1)) * LOG2E;
                const int qi = r32 < 16 ? r32 : 15;
                const bf16* qrow = Qb + (size_t)(MP + 16 * b + qi) * 1024 + h * 128 + map * 64 + hi * 8;
                att::SrcSample src{args.in[I_CK] + ((size_t)b * 1024 * 8 + h) * 128, args.in[I_CV] + ((size_t)b * 1024 * 8 + h) * 128,
                                   args.out + O_KS + (size_t)(16 * b) * 1024 + h * 128, args.out + O_VS + (size_t)(16 * b) * 1024 + h * 128};
                att::attn_core<float, 2, 16, false, att::SrcSample>(o, qrow, (float)(1024 + qi), cs, 16, 0, 18, src, (char*)lds_raw, lds, map * 64, 0.f, wv_ < 2 || wv_ >= 6, wv_ & 1);
                att::attn_finish(o, lam, args.in[I_GSUB], A2 + h * 128, MP + 16 * b, 16, w4 == 0, (char*)lds_raw, 1, wv_ == 0 || wv_ == 6);
            } else {
                const int q = qidx, j = 63 - (q >> 3), h = 7 - (q & 7);
                const float cs = exp2f(-(float)(h + 1)) * LOG2E;
                const float wv = blkc[8 + h];
                int t0 = (int)ceilf(((float)(128 * j - 63) - wv) * (1.0f / 64.f)); t0 = t0 < 0 ? 0 : (t0 & ~1);
                const int row = 128 * j + 32 * w4 + r32;
                const bf16* qrow = Qb + (size_t)row * 1024 + h * 128 + map * 64 + hi * 8;
                att::SrcPrompt src{Kb + h * 128, Vb + h * 128};
                const float kmx = blkc[16 + 2 * h + map];
                if (blkc[32 + h] != 0.f) att::attn_core<bf16, 1, 64, true, att::SrcPrompt>(o, qrow, (float)row, cs, 2 * j + (w4 >> 1), t0, 2 * j + 2, src, (char*)lds_raw, lds, map * 64, kmx, true, 0);
                else att::attn_core<bf16, 1, 64, false, att::SrcPrompt>(o, qrow, (float)row, cs, 2 * j + (w4 >> 1), t0, 2 * j + 2, src, (char*)lds_raw, lds, map * 64, kmx, true, 0);
                att::attn_finish(o, lam, args.in[I_GSUB], A2 + h * 128, 128 * j + 32 * w4, 32, true, (char*)lds_raw, -1, true);
            }
        }
#undef ITEM_DONE
#undef ITEM_WAIT
    }
    SEAM(2);
#ifdef PROBE_CAT
    if (tid == 0) { const unsigned long long n_ = __builtin_amdgcn_s_memrealtime(); (void)atomicAdd((unsigned long long*)(ctl + 8576) + 6, n_ - *(volatile LAS unsigned long long*)(lds + LDSCTL_OFF + 512)); }
#endif

    if (IN(3)) {
        pg8::Gemm g{(const bf16*)(ws + WS_A2), WOUT, MT, DM, DM}; pg8::SplitOrder S; S.init(MP, MT, DM, DM, G, bx, NSL5, WGM_P3);
        EpiOutProj E{args.in[I_XP], args.in[I_XS], args.out + O_Y, XN, (float*)(ws + WS_RS1), (unsigned short*)(ws + WS_SLAB5)};
        pg8::gemm_phase<EpiOutProj, pg8::SplitOrder, true, true>(lds, g, S, E);
    }
    SEAM(3);

    if (IN(4)) {
        int tq_ = threadIdx.x; asm volatile("" : "+v"(tq_)); const int lane = tq_ & 63;
        const int gw = vcu * NWAVES + wave, NGW = G * NWAVES;
        const unsigned short* slabs = (const unsigned short*)(ws + WS_SLAB5); const float* rs = (const float*)(ws + WS_RS1); float* rstd1 = (float*)(ws + WS_RSTD1);
        for (int rr = (gw & 3) == 0 ? (gw >> 2) : MS; rr < MS; rr += NGW / 4) {
            const int row = MP + rr, pms = rr >> 8, rl = rr & 255;
            const float* xr = args.in[I_XS] + (size_t)rr * DM; float ss = 0.f;
            f32x4 vv[8];
#pragma unroll
            for (int jh = 0; jh < 8; jh += 4) {
                f32x4 lx[4]; v2u ld[4][NSL5];
#pragma unroll
                for (int jj = 0; jj < 4; ++jj) { const int j = jh + jj; lx[jj] = *(const f32x4*)(xr + 4 * lane + 256 * j);
                    const unsigned short* sp = slabs + ((size_t)(pms * 8 + j) * NSL5) * 65536 + (size_t)rl * 256 + 4 * lane;
#pragma unroll
                    for (int q = 0; q < NSL5; ++q) ld[jj][q] = *(const v2u*)(sp + (size_t)q * 65536); }
                asm volatile("" ::: "memory");
#pragma unroll
                for (int jj = 0; jj < 4; ++jj) { f32x4 a = lx[jj];
#pragma unroll
                    for (int q = 0; q < NSL5; ++q) { const v2u w = ld[jj][q]; a = a + (f32x4){bflo(w.x), bfhi(w.x), bflo(w.y), bfhi(w.y)}; }
                    vv[jh + jj] = a; }
            }
#pragma unroll
            for (int j = 0; j < 8; ++j) {
                const f32x4 v = vv[j];
                *(f32x4*)(args.out + O_Y + (size_t)row * DM + 4 * lane + 256 * j) = v;
                v2u w; w.x = pk2(v[0], v[1]); w.y = pk2(v[2], v[3]); *(v2u*)(XN + (size_t)row * DM + 4 * lane + 256 * j) = w;
                ss += (v[0] * v[0] + v[1] * v[1]) + (v[2] * v[2] + v[3] * v[3]);
            }
            ss = wave_sum(ss);
            if (lane == 0) rstd1[row] = 1.0f / sqrtf(ss * (1.0f / DM) + EPS);
        }
        { const int RPB = (MP + G - 1) / G;
          for (int i = tid; i < RPB; i += NWAVES * 64) { const int row = bx * RPB + i; if (row >= MP) break;
            const float* p = rs + (size_t)row * 32; float t = 0.f;
#pragma unroll
            for (int q = 0; q < 8; ++q) { const f32x4 a = *(const f32x4*)(p + 4 * q); t += (a[0] + a[1]) + (a[2] + a[3]); }
            rstd1[row] = 1.0f / sqrtf(t * (1.0f / DM) + EPS);
        } }
    }
    SEAM(4);

    if (IN(5)) {
        pg8::Gemm g{XN, WGU, MT, 2 * DFF, DM}; pg8::StaticOrder S; S.init(MT, 2 * DFF, DM, G, bx, WGM_P5);
        EpiGateUp E{(bf16*)(ws + WS_HID), (const float*)(ws + WS_RSTD1), args.out, args.in[I_FCW], args.in[I_FCB], args.in[I_SFFN], (float*)(ws + WS_FRG), (float*)(ws + WS_FRU), (float*)(ws + WS_LRG), lds};
        pg8::gemm_phase<EpiGateUp, pg8::StaticOrder, true, true>(lds, g, S, E);
        if (bx >= nfull5) { __syncthreads(); for (int c = (bx - nfull5) * 4; c < (bx - nfull5) * 4 + 4 && c < cv5; ++c) conv_item(args, ws, lds, 592 - cv5 + c); }
    }
    SEAM(5);

    if (IN(6)) {
        pg8::Gemm g{(const bf16*)(ws + WS_HID), WDN, MT, DM, DFF}; pg8::SplitOrder S; S.init(MP, MT, DM, DFF, G, bx, NSL9, WGM_P6);
        {
            pg8::Unit u0;
            if (S.next(0, u0) && u0.slab < 0 && u0.pm > 0) {
                const float* frg = (const float*)(ws + WS_FRG) + (size_t)u0.pm * 2 * DFF; const float* fru = (const float*)(ws + WS_FRU) + (size_t)u0.pm * 2 * DFF;
                const float* lrg = (const float*)(ws + WS_LRG) + (size_t)(u0.pm - 1) * 2 * DFF; bf16* HID = (bf16*)(ws + WS_HID);
                const float* fw = args.in[I_FCW]; const float* fb = args.in[I_FCB];
                constexpr int NTASK = 2 * (DFF / 8), NROUND = (NTASK + NWAVES * 64 - 1) / (NWAVES * 64);
                f32x4 q2[NROUND][2], q1[NROUND][2], q0[NROUND][2], qu[NROUND][2], w0[NROUND][2], w1[NROUND][2], w2[NROUND][2], bb[NROUND][2];
#pragma unroll
                for (int it = 0; it < NROUND; ++it) { const int task_ = tid + it * NWAVES * 64, task = task_ < NTASK ? task_ : NTASK - 1;
                    const int r = task / (DFF / 8), col = 8 * (task % (DFF / 8));
                    const float* p2 = r == 0 ? lrg + col : lrg + DFF + col; const float* p1 = r == 0 ? lrg + DFF + col : frg + col; const float* p0 = frg + (size_t)r * DFF + col; const float* pu = fru + (size_t)r * DFF + col;
#pragma unroll
                    for (int n = 0; n < 2; ++n) { q2[it][n] = *(const f32x4*)(p2 + 4 * n); q1[it][n] = *(const f32x4*)(p1 + 4 * n); q0[it][n] = *(const f32x4*)(p0 + 4 * n); qu[it][n] = *(const f32x4*)(pu + 4 * n);
                        w0[it][n] = *(const f32x4*)(fw + col + 4 * n); w1[it][n] = *(const f32x4*)(fw + DFF + col + 4 * n); w2[it][n] = *(const f32x4*)(fw + 2 * DFF + col + 4 * n); bb[it][n] = *(const f32x4*)(fb + col + 4 * n); } }
#pragma unroll
                for (int it = 0; it < NROUND; ++it) { const int task = tid + it * NWAVES * 64;
                    if (task < NTASK) { const int r = task / (DFF / 8), col = 8 * (task % (DFF / 8));
                        float o[8];
#pragma unroll
                        for (int e = 0; e < 8; ++e) { const int n = e >> 2, k = e & 3; const float y = bb[it][n][k] + w0[it][n][k] * q2[it][n][k] + w1[it][n][k] * q1[it][n][k] + w2[it][n][k] * q0[it][n][k]; o[e] = siluf(y) * qu[it][n][k]; }
                        v4u w; w.x = pk2(o[0], o[1]); w.y = pk2(o[2], o[3]); w.z = pk2(o[4], o[5]); w.w = pk2(o[6], o[7]);
                        *(v4u*)(HID + (size_t)(256 * u0.pm + r) * DFF + col) = w; } }
                asm volatile("s_waitcnt vmcnt(0)" ::: "memory");
            }
            __syncthreads();
        }
        EpiDown E{args.out + O_Y, (float*)(ws + WS_RS2), (unsigned short*)(ws + WS_SLAB9), XN  };
        pg8::gemm_phase<EpiDown, pg8::SplitOrder, true, true>(lds, g, S, E);
    }
    SEAM(6);

    if (IN(7)) {
        int tq_ = threadIdx.x; asm volatile("" : "+v"(tq_)); const int lane = tq_ & 63;
        const int gw = vcu * NWAVES + wave, NGW = G * NWAVES;
        const float* rs = (const float*)(ws + WS_RS2); const float* gf = args.in[I_GFIN]; const unsigned short* slabs = (const unsigned short*)(ws + WS_SLAB9);
        f32x4 gfv[8];
#pragma unroll
        for (int j = 0; j < 8; ++j) gfv[j] = *(const f32x4*)(gf + 4 * lane + 256 * j);
        const int nprompt = (MP - gw + NGW - 1) / NGW, nsample = (gw & 3) == 0 ? (MS - (gw >> 2) + NGW / 4 - 1) / (NGW / 4) : 0;
        for (int st = 0; st < nprompt + nsample; ++st) {
            const int m = st < nprompt ? gw + st * NGW : MP + (gw >> 2) + (st - nprompt) * (NGW / 4);
            float* row = args.out + O_Y + (size_t)m * DM;
            f32x4 v[8]; float t;
            if (m < MP) {
                t = lane < 32 ? rs[(size_t)m * 32 + lane] : 0.f;
#pragma unroll
                for (int j = 0; j < 8; ++j) { const v2u w = *(const v2u*)(XN + (size_t)m * DM + 4 * lane + 256 * j); v[j] = (f32x4){bflo(w.x), bfhi(w.x), bflo(w.y), bfhi(w.y)}; }
            } else {
                const int rr = m - MP, pms = rr >> 8, rl = rr & 255; t = 0.f;
#pragma unroll
                for (int jh = 0; jh < 8; jh += 2) {
                    f32x4 lx[2]; v2u ld[2][NSL9];
#pragma unroll
                    for (int jj = 0; jj < 2; ++jj) { const int j = jh + jj; lx[jj] = *(const f32x4*)(row + 4 * lane + 256 * j);
                        const unsigned short* sp = slabs + ((size_t)(pms * 8 + j) * NSL9) * 65536 + (size_t)rl * 256 + 4 * lane;
#pragma unroll
                        for (int q = 0; q < NSL9; ++q) ld[jj][q] = *(const v2u*)(sp + (size_t)q * 65536); }
                    asm volatile("" ::: "memory");
#pragma unroll
                    for (int jj = 0; jj < 2; ++jj) { f32x4 a = lx[jj];
#pragma unroll
                        for (int q = 0; q < NSL9; ++q) { const v2u w = ld[jj][q]; a = a + (f32x4){bflo(w.x), bfhi(w.x), bflo(w.y), bfhi(w.y)}; }
                        v[jh + jj] = a; t += (a[0] * a[0] + a[1] * a[1]) + (a[2] * a[2] + a[3] * a[3]); }
                }
            }
            t = wave_sum(t);
            const float rstd = 1.0f / sqrtf(t * (1.0f / DM) + EPS);
#pragma unroll
            for (int j = 0; j < 8; ++j) *(f32x4*)(row + 4 * lane + 256 * j) = v[j] * rstd * gfv[j];
        }
    }
    PEND(N_PHASES - 1);
#ifdef PROBE_CAT
    if (blockIdx.x == 0 && tid == 0) { const unsigned long long d = __hip_atomic_load((unsigned long long*)(ctl + 8576) + PROBE_CAT, __ATOMIC_RELAXED, __HIP_MEMORY_SCOPE_AGENT) * PROBE_SCALE / G, t0 = __builtin_amdgcn_s_memrealtime(); while (__builtin_amdgcn_s_memrealtime() - t0 < d) __builtin_amdgcn_s_sleep(16); }
#endif
#ifdef PROBE_PHASE
    if (blockIdx.x == 0 && tid == 0) { const unsigned long long d = (pr_b - pr_a) * PROBE_SCALE, t0 = __builtin_amdgcn_s_memrealtime(); while (__builtin_amdgcn_s_memrealtime() - t0 < d) __builtin_amdgcn_s_sleep(16); }
#endif
#undef IN
#undef SEAM
}

extern "C" void kernel_launch(void* const* d_in, const int* in_sizes, int n_in, void* d_out, int out_size, void* d_ws, size_t ws_size, hipStream_t stream) {
    static int grid = 0;
    if (grid == 0) {
        if (n_in != 28 || out_size != (int)O_END || ws_size < WS_END) { fprintf(stderr, "kernel_launch: unexpected shapes: n_in %d out %d ws %zu (need %zu)\n", n_in, out_size, ws_size, (size_t)WS_END); grid = -1; return; }
        int dev = 0, cus = 0;
        if (hipGetDevice(&dev) != hipSuccess || hipDeviceGetAttribute(&cus, hipDeviceAttributeMultiprocessorCount, dev) != hipSuccess) { grid = -1; return; }
        if (hipFuncSetAttribute((const void*)hymba_fwd, hipFuncAttributeMaxDynamicSharedMemorySize, LDS_BYTES) != hipSuccess) { fprintf(stderr, "kernel_launch: hipFuncSetAttribute failed\n"); grid = -1; return; }
        (void)hipGetLastError();
        grid = cus;
    }
    if (grid < 0) return;
    (void)hipMemsetAsync((char*)d_ws + WS_CTL, 0, CTL_ZERO_BYTES, stream);
    Args a{};
    for (int i = 0; i < 28; ++i) a.in[i] = (const float*)d_in[i];
    a.out = (float*)d_out; a.ws = (unsigned char*)d_ws;
    if (N_LAUNCHES == 1) {
        a.ph_lo = 0; a.ph_hi = N_PHASES; a.li = 0;
        hipLaunchKernelGGL(hymba_fwd, dim3(grid), dim3(NWAVES * 64), LDS_BYTES, stream, a);
    } else {
        for (int li = 0; li < N_PHASES; ++li) { a.ph_lo = li; a.ph_hi = li + 1; a.li = li; hipLaunchKernelGGL(hymba_fwd, dim3(grid), dim3(NWAVES * 64), LDS_BYTES, stream, a); }
    }
    const hipError_t le = hipPeekAtLastError();
    if (le != hipSuccess) fprintf(stderr, "kernel_launch: launch failed: %s\n", hipGetErrorName(le));
}
```
